# Optimizing an MI355X kernel written in HIP

```python
import jax, jax.numpy as jnp
from jax import lax
import numpy as np

D_MODEL = 1024
BATCH = 8
SEQ = 8192
DEPTH = 1

N_HEADS = 8
QK_NOPE_DIM = 64
QK_ROPE_DIM = 32
V_HEAD_DIM = 64
Q_LORA_RANK = 256
KV_LORA_RANK = 256
ROPE_THETA = 10000.0
ATTN_WIDTH = N_HEADS * V_HEAD_DIM
Q_BLOCK = 128
FOURIER_GROUPS = 8
FOURIER_GROUP_DIM = 64
FOURIER_WIDTH = FOURIER_GROUPS * FOURIER_GROUP_DIM
N_BRANCHES = 2
N_EXPERT_GROUPS = 4
EXPERTS_PER_GROUP = 8
N_EXPERTS = N_EXPERT_GROUPS * EXPERTS_PER_GROUP
TOP_K_INNER = 2
D_EXPERT = 256
N_ADA = 6
EPS = 1e-6

IN_SIZES = (Q_LORA_RANK, KV_LORA_RANK, QK_ROPE_DIM, FOURIER_WIDTH, N_BRANCHES * D_MODEL)
IN_SPLITS = tuple(int(v) for v in np.cumsum(IN_SIZES)[:-1])
IN_COLS = int(sum(IN_SIZES))

kernel_name = "hybrid_mla_fnet_hmoe_adaln_encoder"


def rmsnorm(x, g):
    xf = x.astype(jnp.float32)
    r = lax.rsqrt(jnp.mean(xf * xf, axis=-1, keepdims=True) + EPS)
    return (xf * r * g.astype(jnp.float32)).astype(x.dtype)


def modulate(h, shift, scale):
    return h * (1.0 + scale[:, None, :]) + shift[:, None, :]


def rope_angles(positions):
    inv_freq = ROPE_THETA ** (-jnp.arange(0, QK_ROPE_DIM, 2, dtype=jnp.float32) / QK_ROPE_DIM)
    ang = positions.astype(jnp.float32)[..., None] * inv_freq
    return jnp.cos(ang), jnp.sin(ang)


def apply_rope(x, cos, sin):
    half = QK_ROPE_DIM // 2
    x1, x2 = x[..., :half], x[..., half:]
    cos = cos.astype(x.dtype)
    sin = sin.astype(x.dtype)
    return jnp.concatenate([x1 * cos - x2 * sin, x2 * cos + x1 * sin], axis=-1)


def mla_attention(q_lat, kv_lat, k_rope, positions, g_q, g_kv, w_uq, w_uk, w_uv):
    B, S, _ = q_lat.shape
    q_lat = rmsnorm(q_lat, g_q)
    kv_lat = rmsnorm(kv_lat, g_kv)
    q = jnp.einsum('bsr,rhd->bshd', q_lat, w_uq)
    q_nope, q_rope = q[..., :QK_NOPE_DIM], q[..., QK_NOPE_DIM:]
    k_nope = jnp.einsum('bsr,rhd->bshd', kv_lat, w_uk)
    v = jnp.einsum('bsr,rhd->bshd', kv_lat, w_uv)
    cos, sin = rope_angles(positions)
    q_rope = apply_rope(q_rope, cos[:, :, None, :], sin[:, :, None, :])
    k_rope = apply_rope(k_rope, cos, sin)
    scale = (QK_NOPE_DIM + QK_ROPE_DIM) ** -0.5
    nb = S // Q_BLOCK
    qn_blk = (q_nope * scale).reshape(B, nb, Q_BLOCK, N_HEADS, QK_NOPE_DIM).transpose(1, 0, 2, 3, 4)
    qr_blk = (q_rope * scale).reshape(B, nb, Q_BLOCK, N_HEADS, QK_ROPE_DIM).transpose(1, 0, 2, 3, 4)

    def attend(blk):
        qn, qr = blk
        s = (jnp.einsum('bqhd,bkhd->bhqk', qn, k_nope)
             + jnp.einsum('bqhd,bkd->bhqk', qr, k_rope))
        p = jax.nn.softmax(s.astype(jnp.float32), axis=-1).astype(v.dtype)
        return jnp.einsum('bhqk,bkhd->bqhd', p, v)

    o = lax.map(attend, (qn_blk, qr_blk))
    return o.transpose(1, 0, 2, 3, 4).reshape(B, S, ATTN_WIDTH)


def fourier_mix(u):
    B, S, _ = u.shape
    ug = u.astype(jnp.float32).reshape(B, S, FOURIER_GROUPS, FOURIER_GROUP_DIM)
    f = jnp.fft.fft2(ug, axes=(1, 3), norm='ortho').real
    return f.reshape(B, S, FOURIER_WIDTH).astype(u.dtype)


def hierarchical_moe(h, w_rg, b_rg, w_re, b_re, w_gate, w_up, w_down):
    B, S, D = h.shape
    t = h.reshape(B * S, D)
    g_logits = (t @ w_rg).astype(jnp.float32) + b_rg.astype(jnp.float32)
    g_prob = jax.nn.softmax(g_logits, axis=-1)
    g_sel = jnp.argmax(g_prob, axis=-1)
    g_p = jnp.take_along_axis(g_prob, g_sel[:, None], axis=-1)[:, 0]
    e_logits = jnp.einsum('td,dge->tge', t, w_re).astype(jnp.float32) + b_re.astype(jnp.float32)
    e_logits = jnp.take_along_axis(e_logits, g_sel[:, None, None], axis=1)[:, 0]
    e_prob = jax.nn.softmax(e_logits, axis=-1)
    top_p, top_i = lax.top_k(e_prob, TOP_K_INNER)
    top_p = top_p / jnp.sum(top_p, axis=-1, keepdims=True)
    weights = g_p[:, None] * top_p
    global_idx = g_sel[:, None] * EXPERTS_PER_GROUP + top_i
    combine = jnp.sum(jax.nn.one_hot(global_idx, N_EXPERTS, dtype=jnp.float32)
                      * weights[..., None], axis=1).astype(t.dtype)
    out = jnp.zeros_like(t)
    for e in range(N_EXPERTS):
        hid = jax.nn.silu(t @ w_gate[e]) * (t @ w_up[e])
        out = out + combine[:, e:e + 1] * (hid @ w_down[e])
    return out.reshape(B, S, D)


def setup_inputs(seed: int = 0) -> dict:
    key = jax.random.key(seed)
    ks = jax.random.split(key, 32)
    f32 = jnp.float32
    L, D = DEPTH, D_MODEL

    def nrm(k, shape, fan_in, mult=1.0):
        return jax.random.normal(k, shape, f32) * (mult * fan_in ** -0.5)

    def gain(k, shape):
        return 1.0 + 0.02 * jax.random.normal(k, shape, f32)

    x = jax.random.normal(ks[0], (BATCH, SEQ, D), f32)
    c = jax.random.normal(ks[1], (BATCH, D), f32)
    positions = jnp.sort(jax.random.randint(ks[2], (BATCH, SEQ), 0, 4 * SEQ), axis=-1).astype(jnp.int32)
    return {
        "x": x,
        "c": c,
        "positions": positions,
        "w_ada": nrm(ks[3], (L, D, N_ADA * D), D, 0.5),
        "b_ada": 0.02 * jax.random.normal(ks[4], (L, N_ADA * D), f32),
        "g_norm_mix": gain(ks[5], (L, D)),
        "w_in": nrm(ks[6], (L, D, IN_COLS), D),
        "g_q_lat": gain(ks[7], (L, Q_LORA_RANK)),
        "g_kv_lat": gain(ks[8], (L, KV_LORA_RANK)),
        "w_uq": nrm(ks[9], (L, Q_LORA_RANK, N_HEADS, QK_NOPE_DIM + QK_ROPE_DIM), Q_LORA_RANK),
        "w_uk": nrm(ks[10], (L, KV_LORA_RANK, N_HEADS, QK_NOPE_DIM), KV_LORA_RANK),
        "w_uv": nrm(ks[11], (L, KV_LORA_RANK, N_HEADS, V_HEAD_DIM), KV_LORA_RANK),
        "w_branch_attn": nrm(ks[12], (L, ATTN_WIDTH, D), ATTN_WIDTH),
        "w_branch_fourier": nrm(ks[13], (L, FOURIER_WIDTH, D), FOURIER_WIDTH),
        "b_gates": 0.02 * jax.random.normal(ks[14], (L, N_BRANCHES * D), f32),
        "w_out": nrm(ks[15], (L, D, D), D),
        "g_norm_ffn": gain(ks[16], (L, D)),
        "w_router_group": nrm(ks[17], (L, D, N_EXPERT_GROUPS), D),
        "b_router_group": 0.01 * jax.random.normal(ks[18], (L, N_EXPERT_GROUPS), f32),
        "w_router_expert": nrm(ks[19], (L, D, N_EXPERT_GROUPS, EXPERTS_PER_GROUP), D),
        "b_router_expert": 0.01 * jax.random.normal(ks[20], (L, N_EXPERT_GROUPS, EXPERTS_PER_GROUP), f32),
        "w_expert_gate": nrm(ks[21], (L, N_EXPERTS, D, D_EXPERT), D),
        "w_expert_up": nrm(ks[22], (L, N_EXPERTS, D, D_EXPERT), D),
        "w_expert_down": nrm(ks[23], (L, N_EXPERTS, D_EXPERT, D), D_EXPERT),
        "w_ada_final": nrm(ks[24], (D, 2 * D), D, 0.5),
        "b_ada_final": 0.02 * jax.random.normal(ks[25], (2 * D,), f32),
        "g_norm_final": gain(ks[26], (D,)),
    }


def reference(x, c, positions, w_ada, b_ada, g_norm_mix, w_in, g_q_lat, g_kv_lat,
              w_uq, w_uk, w_uv, w_branch_attn, w_branch_fourier, b_gates, w_out,
              g_norm_ffn, w_router_group, b_router_group, w_router_expert, b_router_expert,
              w_expert_gate, w_expert_up, w_expert_down, w_ada_final, b_ada_final, g_norm_final):
    h = x
    c_act = jax.nn.silu(c)
    for l in range(DEPTH):
        mod = c_act @ w_ada[l] + b_ada[l]
        sh1, sc1, gt1, sh2, sc2, gt2 = jnp.split(mod, N_ADA, axis=-1)

        u = modulate(rmsnorm(h, g_norm_mix[l]), sh1, sc1)
        z = u @ w_in[l]
        q_lat, kv_lat, k_rope, f_in, gate_logits = jnp.split(z, IN_SPLITS, axis=-1)
        a = mla_attention(q_lat, kv_lat, k_rope, positions, g_q_lat[l], g_kv_lat[l],
                          w_uq[l], w_uk[l], w_uv[l]) @ w_branch_attn[l]
        fo = fourier_mix(f_in) @ w_branch_fourier[l]
        ga, gf = jnp.split(gate_logits + b_gates[l], N_BRANCHES, axis=-1)
        merged = jax.nn.sigmoid(ga) * a + jax.nn.sigmoid(gf) * fo
        h = h + gt1[:, None, :] * (merged @ w_out[l])

        v = modulate(rmsnorm(h, g_norm_ffn[l]), sh2, sc2)
        h = h + gt2[:, None, :] * hierarchical_moe(
            v, w_router_group[l], b_router_group[l], w_router_expert[l], b_router_expert[l],
            w_expert_gate[l], w_expert_up[l], w_expert_down[l])

    fmod = c_act @ w_ada_final + b_ada_final
    shf, scf = jnp.split(fmod, 2, axis=-1)
    return modulate(rmsnorm(h, g_norm_final), shf, scf)
```

```cpp
#include <hip/hip_runtime.h>
#include <cstdio>
#include <cstdint>

#ifndef MK_PER_PHASE
#define MK_PER_PHASE 0
#endif

#define LAS __attribute__((address_space(3)))
#define GAS __attribute__((address_space(1)))
typedef unsigned short bf16_t;
typedef short bf16x8 __attribute__((ext_vector_type(8)));
typedef short s16x4 __attribute__((ext_vector_type(4)));
typedef float f32x4 __attribute__((ext_vector_type(4)));
typedef float f32x16 __attribute__((ext_vector_type(16)));
typedef unsigned u32x4 __attribute__((ext_vector_type(4)));
typedef unsigned u32x2 __attribute__((ext_vector_type(2)));
typedef GAS unsigned gu32;
typedef int i32x4 __attribute__((ext_vector_type(4)));

constexpr int NB = 8, SEQ = 8192, T = NB * SEQ, D = 1024;
constexpr int NH = 8, DQK = 96, DV = 64, QC = NH * DQK;
constexpr float EPS = 1e-6f;
constexpr float C2 = 0.14724444602590306f;
constexpr float FNORM = 0.0013810679320049755f;
constexpr int NEXP = 32, DEXP = 256;
constexpr int NWAVES = 8;

constexpr size_t MiB = 1u << 20;
constexpr size_t WS_CTL = 0, CTL_ZERO_BYTES = 1 * MiB;
constexpr size_t WS_SSQQ = 1 * MiB, WS_SSQKV = 2 * MiB, WS_ROUTEW = 3 * MiB, WS_MODF = 4 * MiB;
constexpr size_t WS_ROPEC = 8 * MiB, WS_ROPES = 12 * MiB, WS_LIST = 16 * MiB;
constexpr size_t WS_WIN = 32 * MiB, WS_WFY = 38 * MiB, WS_WUQ = 40 * MiB, WS_WUKV = 40 * MiB + 512 * 1024, WS_WBA = 41 * MiB, WS_WBF = 42 * MiB, WS_WOUT = 43 * MiB;
constexpr size_t WS_DFTA = 45 * MiB, WS_TB2 = 46 * MiB, WS_WGU = 50 * MiB, WS_WDN = 82 * MiB;
constexpr size_t WS_R1 = 100 * MiB;
constexpr size_t WS_GATE = 228 * MiB;
constexpr size_t WS_QL = 484 * MiB, WS_KVL = 516 * MiB;
constexpr size_t WS_Q = 548 * MiB, WS_K = 644 * MiB, WS_V = 740 * MiB;
constexpr size_t WS_YT2 = 804 * MiB;
constexpr size_t WS_W8IN = 932 * MiB, WS_W8FY = 935 * MiB, WS_W8GU = 936 * MiB;
constexpr size_t WS_SU = 5 * MiB;
constexpr size_t WS_END = 1024 * MiB;
constexpr int CW_TMO = 0;
constexpr int CW_BAR = 4096;
constexpr int CW_CNT = 8192;
constexpr int CW_WMAX = 8256;
constexpr int CW_MOD = 16384;
constexpr int NWIN = 2816;

constexpr int LDS_BYTES = 163840;
constexpr int MISC_OFF = 163840 - 1024;
constexpr int RING_OFF = 0;

#define LDS_WAIT() asm volatile("s_waitcnt lgkmcnt(0)" ::: "memory")
#define VM_WAIT() asm volatile("s_waitcnt vmcnt(0)" ::: "memory")
typedef float f32x2_t __attribute__((ext_vector_type(2))); typedef __bf16 bf16x2_t __attribute__((ext_vector_type(2)));
__device__ __forceinline__ unsigned cvt_pk_bf16(float lo, float hi) { f32x2_t v = {lo, hi}; bf16x2_t b = __builtin_convertvector(v, bf16x2_t); return __builtin_bit_cast(unsigned, b); }
__device__ __forceinline__ float bf_lo(unsigned w) { return __uint_as_float(w << 16); }
__device__ __forceinline__ float bf_hi(unsigned w) { return __uint_as_float(w & 0xffff0000u); }
__device__ __forceinline__ u32x4 pack8(const f32x4 a, const f32x4 b) { u32x4 w; w.x = cvt_pk_bf16(a[0], a[1]); w.y = cvt_pk_bf16(a[2], a[3]); w.z = cvt_pk_bf16(b[0], b[1]); w.w = cvt_pk_bf16(b[2], b[3]); return w; }
__device__ __forceinline__ u32x2 pack4(const f32x4 a) { u32x2 w; w.x = cvt_pk_bf16(a[0], a[1]); w.y = cvt_pk_bf16(a[2], a[3]); return w; }
__device__ __forceinline__ float sigmoidf_(float x) { return __builtin_amdgcn_rcpf(1.0f + __builtin_amdgcn_exp2f(-1.4426950408889634f * x)); }
__device__ __forceinline__ float wave_sum(float v) {
#pragma unroll
    for (int o = 1; o < 64; o <<= 1) v += __shfl_xor(v, o);
    return v;
}

#define XB_TMO      128
#define XB_XCNT(j)  (256  + 64 * (j))
#define XB_XSUB(j)  (1280 + 64 * (j))
#define XB_XGEN(j)  (2304 + 64 * (j))
#define XB_TOP      3328
#define XB_TOPGEN   3392
#define XCD_BAR_WORDS 3456
#define XB_SPIN_CAP (1u << 18)
__device__ __forceinline__ unsigned xb_ld(unsigned* p)              { return __hip_atomic_load(p, __ATOMIC_RELAXED, __HIP_MEMORY_SCOPE_AGENT); }
__device__ __forceinline__ unsigned xb_add(unsigned* p, unsigned v) { return __hip_atomic_fetch_add(p, v, __ATOMIC_RELAXED, __HIP_MEMORY_SCOPE_AGENT); }
__device__ __forceinline__ unsigned xb_xcc_id() { return (unsigned)__builtin_amdgcn_s_getreg((3 << 11) | 20) & 0xFu; }
#define XB_SPIN(cond, bar) do { unsigned _sp = 0; while (cond) { __builtin_amdgcn_s_sleep(1); \
    if ((++_sp & 255u) == 0u) { if (xb_ld(&(bar)[XB_TMO])) break; if (_sp > XB_SPIN_CAP) { atomicAdd(&(bar)[XB_TMO], 1u); break; } } } } while (0)
struct XcdBarrier { unsigned* bar; unsigned x; volatile LAS unsigned* st; };
__device__ __forceinline__ XcdBarrier xcd_barrier_post(unsigned* bar, volatile LAS unsigned* st) {
    XcdBarrier b; b.bar = bar; b.x = xb_xcc_id(); b.st = st;
    if (threadIdx.x == 0) (void)xb_add(&bar[XB_XCNT(b.x)], 1u);
    return b;
}
__device__ __forceinline__ void xcd_barrier_complete(unsigned* bar, unsigned x, unsigned& nloc, unsigned& nx) {
    const unsigned G = gridDim.x * gridDim.y * gridDim.z;
    unsigned sum, cnt, mine, sp = 0u;
    for (;;) {
        sum = 0u; cnt = 0u; mine = 0u;
#pragma unroll
        for (unsigned j = 0; j < 16; ++j) { const unsigned c = xb_ld(&bar[XB_XCNT(j)]); sum += c; cnt += (c > 0u) ? 1u : 0u; mine = (j == x) ? c : mine; }
        if (sum == G) break;
        __builtin_amdgcn_s_sleep(1);
        if ((++sp & 255u) == 0u) { if (xb_ld(&bar[XB_TMO])) break; if (sp > XB_SPIN_CAP) { atomicAdd(&bar[XB_TMO], 1u); break; } }
    }
    nloc = mine > 0u ? mine : 1u; nx = cnt > 0u ? cnt : 1u;
}
__device__ __forceinline__ void xcd_barrier(const XcdBarrier& b) {
    asm volatile("s_waitcnt vmcnt(0)" ::: "memory");
    __syncthreads();
    if (threadIdx.x == 0) {
        unsigned* bar = b.bar;
        __builtin_amdgcn_s_waitcnt(0);
        unsigned nloc = b.st[0], nx = b.st[1];
        if (nloc == 0u) { xcd_barrier_complete(bar, b.x, nloc, nx); b.st[0] = nloc; b.st[1] = nx; }
        const unsigned old = xb_add(&bar[XB_XSUB(b.x)], 1u);
        const unsigned gen = old / nloc;
        if (old + 1u == (gen + 1u) * nloc) {
            __builtin_amdgcn_fence(__ATOMIC_RELEASE, "agent");
            asm volatile("s_waitcnt vmcnt(0)" ::: "memory");
            const unsigned og = xb_add(&bar[XB_TOP], 1u);
            const unsigned tg = og / nx;
            if (og + 1u == (tg + 1u) * nx) xb_add(&bar[XB_TOPGEN], 1u);
            else XB_SPIN(xb_ld(&bar[XB_TOPGEN]) == tg, bar);
            __builtin_amdgcn_fence(__ATOMIC_ACQUIRE, "agent");
            xb_add(&bar[XB_XGEN(b.x)], 1u);
            asm volatile("s_waitcnt vmcnt(0)" ::: "memory");
        } else {
            XB_SPIN(xb_ld(&bar[XB_XGEN(b.x)]) == gen, bar);
            __builtin_amdgcn_fence(__ATOMIC_ACQUIRE, "agent");
            asm volatile("s_waitcnt vmcnt(0)" ::: "memory");
        }
    }
    __syncthreads();
}

namespace pg8 {
constexpr int BM = 256, BK = 64, HALF = 128, HTB = HALF * BK * 2, STAGE_BYTES = 8 * HTB, NXCD = 8, WGM = 4;
__host__ __device__ __forceinline__ int lds_byte(int r, int c) { const int st = (r >> 4) * 2 + (c >> 5), rr = r & 15, cc = c & 31, ob = rr * 64 + cc * 2; return st * 1024 + (ob ^ (((ob >> 9) & 1) << 5)); }
__host__ __device__ __forceinline__ void stage_rc(int b, int& R, int& C) { const int st = b / 1024, sb = b % 1024, swz = sb ^ (((sb >> 9) & 1) << 5); R = (st >> 1) * 16 + swz / 64; C = (st & 1) * 32 + (swz % 64) / 2; }
__host__ __device__ __forceinline__ int perm32(int rho) { const int n = rho >> 4, i = rho & 15; return 8 * (i >> 2) + 4 * n + (i & 3); }

struct UnitPN { int pm, pn; };
__device__ __forceinline__ bool static_next(int i, int G, int c, int nM, int nN, int& pm, int& pn) {
    const int nwg = nM * nN; const long L = (long)i * G + c; if (L >= nwg) return false;
    int wgid = (int)L; { const int q = nwg / NXCD, r = nwg % NXCD, xcd = wgid % NXCD, off = wgid / NXCD; wgid = (xcd < r ? xcd * (q + 1) : r * (q + 1) + (xcd - r) * q) + off; }
    const int nig = WGM * nN, gid = wgid / nig, fm = gid * WGM, gsz = (nM - fm) < WGM ? (nM - fm) : WGM;
    pm = fm + ((wgid % nig) % gsz); pn = (wgid % nig) / gsz; return true;
}
struct PlainOrder {
    typedef UnitPN Unit; static constexpr bool VARA = false, VARB = false;
    const char* A; const char* B; int K, nM, nN, G, c;
    __device__ __forceinline__ bool next(int i, Unit& u) const { return static_next(i, G, c, nM, nN, u.pm, u.pn); }
    __device__ __forceinline__ const char* baseA(const Unit& u) const { return A + (size_t)u.pm * 256 * K * 2; }
    __device__ __forceinline__ const char* baseB(const Unit& u) const { return B + (size_t)u.pn * 256 * K * 2; }
    __device__ __forceinline__ unsigned hstepA() const { return (unsigned)(128 * K * 2); }
    __device__ __forceinline__ unsigned hstepB() const { return (unsigned)(128 * K * 2); }
    __device__ __forceinline__ size_t koffA(int t) const { return (size_t)t * 128; }
    __device__ __forceinline__ void offA(const Unit&, const int (&R)[2], const int (&C)[2], unsigned (&o)[2][2]) const {
#pragma unroll
        for (int h = 0; h < 2; ++h)
#pragma unroll
            for (int i = 0; i < 2; ++i) o[h][i] = (unsigned)((h * 128 + R[i]) * K + C[i]) * 2u; }
    __device__ __forceinline__ void offB(const Unit& u, const int (&R)[2], const int (&C)[2], unsigned (&o)[2][2]) const { offA(u, R, C, o); }
};

struct PlainOrder8 {
    typedef UnitPN Unit; static constexpr bool VARA = false, VARB = false;
    const char* A; const char* B; int K, nM, nN, G, c;
    __device__ __forceinline__ bool next(int i, Unit& u) const { return static_next(i, G, c, nM, nN, u.pm, u.pn); }
    __device__ __forceinline__ const char* baseA(const Unit& u) const { return A + (size_t)u.pm * 256 * K; }
    __device__ __forceinline__ const char* baseB(const Unit& u) const { return B + (size_t)u.pn * 256 * K; }
    __device__ __forceinline__ unsigned hstepA() const { return (unsigned)(128 * K); }
    __device__ __forceinline__ unsigned hstepB() const { return (unsigned)(128 * K); }
    __device__ __forceinline__ size_t koffA(int t) const { return (size_t)t * 128; }
    __device__ __forceinline__ void offA(const Unit&, const int (&R)[2], const int (&C)[2], unsigned (&o)[2][2]) const {
#pragma unroll
        for (int h = 0; h < 2; ++h)
#pragma unroll
            for (int i = 0; i < 2; ++i) o[h][i] = (unsigned)((h * 128 + R[i]) * K + C[i] * 2); }
    __device__ __forceinline__ void offB(const Unit& u, const int (&R)[2], const int (&C)[2], unsigned (&o)[2][2]) const { offA(u, R, C, o); }
};
__device__ __forceinline__ const char* uni_ptr(const char* p) { const unsigned long long v = (unsigned long long)(uintptr_t)p; return (const char*)(uintptr_t)(((unsigned long long)(unsigned)__builtin_amdgcn_readfirstlane((int)(v >> 32)) << 32) | (unsigned)__builtin_amdgcn_readfirstlane((int)(unsigned)v)); }
template <bool B, class X, class Y> struct sel_t { typedef X type; };
template <class X, class Y> struct sel_t<false, X, Y> { typedef Y type; };
template <class Epi, class Sched>
__device__ __forceinline__ void gemm_phase(LAS unsigned char* lds, const int K, const Sched& S, const Epi& E) {
    typedef typename Sched::Unit Unit;
    int tid_ = threadIdx.x; asm volatile("" : "+v"(tid_));
    const int tid = tid_, wid = __builtin_amdgcn_readfirstlane(tid >> 6), lane = tid & 63, wr = wid >> 2, wc = wid & 3, fr = lane & 15, fq = lane >> 4;
    typedef typename sel_t<Epi::I8, i32x4, f32x4>::type acc_t;
    const int nt = K / (Epi::I8 ? 2 * BK : BK);
    int Rr[2], Cc[2], Rb[2];
#pragma unroll
    for (int i = 0; i < 2; ++i) { stage_rc(tid * 16 + i * 8192, Rr[i], Cc[i]); Rb[i] = Epi::PERM ? ((Rr[i] & ~31) + perm32(Rr[i] & 31)) : Rr[i]; }
    const size_t kstep = (size_t)(BK * 2);
    const unsigned ldsw = (unsigned)wid * 1024u, ldsb = (unsigned)(uintptr_t)lds;
    const unsigned hsA = S.hstepA(), hsB = S.hstepB();
    const int aoff = lds_byte(wr * 64 + fr, fq * 8), boff = lds_byte(wc * 32 + fr, fq * 8);
#define PG8_SA(b, h) (((b) * 2 + (h)) * HTB)
#define PG8_SB(b, h) ((4 + (b) * 2 + (h)) * HTB)
#ifdef PG8_BUILTIN_GLDS
#define PG8_STAGE_A(bufoff, gbase, O, h) do { _Pragma("unroll") for (int _i = 0; _i < 2; ++_i) \
        __builtin_amdgcn_global_load_lds((const unsigned*)(Sched::VARA ? (const char*)(gbase) + (O)[h][_i] : (const char*)(gbase) + (size_t)(h) * hsA + (O)[0][_i]), (LAS unsigned*)(lds + (bufoff) + ldsw + _i * 8192), 16, 0, 0); } while (0)
#define PG8_STAGE_B(bufoff, gbase, O, h) do { _Pragma("unroll") for (int _i = 0; _i < 2; ++_i) \
        __builtin_amdgcn_global_load_lds((const unsigned*)(Sched::VARB ? (const char*)(gbase) + (O)[h][_i] : (const char*)(gbase) + (size_t)(h) * hsB + (O)[0][_i]), (LAS unsigned*)(lds + (bufoff) + ldsw + _i * 8192), 16, 0, 0); } while (0)
#else
#define PG8_GLDS(ubase, voff, ldsaddr) do { unsigned keep_; asm volatile("s_mov_b32 %0, m0\n\ts_mov_b32 m0, %3\n\ts_nop 0\n\tglobal_load_lds_dwordx4 %1, %2\n\ts_mov_b32 m0, %0" \
        : "=&s"(keep_) : "v"(voff), "s"(uni_ptr(ubase)), "s"((unsigned)(ldsaddr)) : "memory"); } while (0)
#define PG8_STAGE_A(bufoff, gbase, O, h) do { _Pragma("unroll") for (int _i = 0; _i < 2; ++_i) \
        PG8_GLDS(Sched::VARA ? (const char*)(gbase) : (const char*)(gbase) + (size_t)(h) * hsA, Sched::VARA ? (O)[h][_i] : (O)[0][_i], ldsb + (unsigned)(bufoff) + ldsw + _i * 8192u); } while (0)
#define PG8_STAGE_B(bufoff, gbase, O, h) do { _Pragma("unroll") for (int _i = 0; _i < 2; ++_i) \
        PG8_GLDS(Sched::VARB ? (const char*)(gbase) : (const char*)(gbase) + (size_t)(h) * hsB, Sched::VARB ? (O)[h][_i] : (O)[0][_i], ldsb + (unsigned)(bufoff) + ldsw + _i * 8192u); } while (0)
#endif
#define PG8_LDA(dst, b, h) do { _Pragma("unroll") for (int m = 0; m < 4; ++m) _Pragma("unroll") for (int k = 0; k < 2; ++k) dst[m][k] = *(const LAS bf16x8*)(lds + PG8_SA(b, h) + aoff + m * 2048 + k * 1024); } while (0)
#define PG8_LDB(dst, b, h) do { _Pragma("unroll") for (int n = 0; n < 2; ++n) _Pragma("unroll") for (int k = 0; k < 2; ++k) dst[n][k] = *(const LAS bf16x8*)(lds + PG8_SB(b, h) + boff + n * 2048 + k * 1024); } while (0)
#define PG8_MMA(ai, bj, At, Bt) do { _Pragma("unroll") for (int m = 0; m < 4; ++m) _Pragma("unroll") for (int n = 0; n < 2; ++n) _Pragma("unroll") for (int k = 0; k < 2; ++k) \
        { if constexpr (Epi::I8) acc[ai][bj][m][n] = __builtin_bit_cast(acc_t, __builtin_amdgcn_mfma_i32_16x16x64_i8(__builtin_bit_cast(i32x4, Bt[n][k]), __builtin_bit_cast(i32x4, At[m][k]), __builtin_bit_cast(i32x4, acc[ai][bj][m][n]), 0, 0, 0)); \
          else acc[ai][bj][m][n] = __builtin_bit_cast(acc_t, __builtin_amdgcn_mfma_f32_16x16x32_bf16(Bt[n][k], At[m][k], __builtin_bit_cast(f32x4, acc[ai][bj][m][n]), 0, 0, 0)); } } while (0)
#ifdef DBG_WAIT0
#define PG8_WAIT_V(n) asm volatile("s_waitcnt vmcnt(0)" ::: "memory")
#else
#define PG8_WAIT_V(n) asm volatile("s_waitcnt vmcnt(" #n ")" ::: "memory")
#endif
#define PG8_WAIT_L(n) asm volatile("s_waitcnt lgkmcnt(" #n ")" ::: "memory")
#define PG8_BAR __builtin_amdgcn_s_barrier()
#define PG8_SCHED __builtin_amdgcn_sched_barrier(0)
    Unit cur, nxt; int ui = 0;
    if (!S.next(0, cur)) return;
    acc_t acc[2][2][4][2];
#pragma unroll
    for (int a = 0; a < 2; ++a)
#pragma unroll
        for (int b = 0; b < 2; ++b)
#pragma unroll
            for (int m = 0; m < 4; ++m)
#pragma unroll
                for (int n = 0; n < 2; ++n) acc[a][b][m][n] = acc_t{};
    bf16x8 At[4][2], B0[2][2], B1[2][2];
    unsigned oA[2][2], oB[2][2];
    S.offA(cur, Rr, Cc, oA); S.offB(cur, Rb, Cc, oB);
    const char* cA = S.baseA(cur); const char* cB = S.baseB(cur);
    PG8_STAGE_B(PG8_SB(0, 0), cB, oB, 0); PG8_STAGE_B(PG8_SB(0, 1), cB, oB, 1); PG8_STAGE_A(PG8_SA(0, 0), cA, oA, 0); PG8_STAGE_A(PG8_SA(0, 1), cA, oA, 1);
    if (wr == 1) PG8_BAR;
    PG8_WAIT_V(2); PG8_BAR;
    PG8_STAGE_B(PG8_SB(1, 0), cB + kstep, oB, 0); PG8_STAGE_A(PG8_SA(1, 0), cA + S.koffA(1), oA, 0); PG8_STAGE_B(PG8_SB(1, 1), cB + kstep, oB, 1);
    PG8_WAIT_V(6); PG8_BAR;
    for (;;) {
        const bool has_next = S.next(ui + 1, nxt);
        const char* nA = has_next ? S.baseA(nxt) : cA; const char* nB = has_next ? S.baseB(nxt) : cB;
        unsigned nOA[2][2], nOB[2][2];
#pragma unroll
        for (int h = 0; h < 2; ++h)
#pragma unroll
            for (int i = 0; i < 2; ++i) { nOA[h][i] = oA[h][i]; nOB[h][i] = oB[h][i]; }
        if constexpr (Sched::VARA) { if (has_next) S.offA(nxt, Rr, Cc, nOA); }
        if constexpr (Sched::VARB) { if (has_next) S.offB(nxt, Rb, Cc, nOB); }
#pragma unroll 1
        for (int t = 0; t < nt; t += 2) {
            const bool last = (t == nt - 2);
            if constexpr (Epi::MIDK) { if (t == nt / 2) E.mid(acc, cur, wr, wc, fr, fq); }
            const char* a1 = cA + S.koffA(t + 1);
            const char* a2 = last ? nA : cA + S.koffA(t + 2); const char* b2 = last ? nB : cB + (size_t)(t + 2) * kstep;
            const char* a3 = last ? nA + S.koffA(1) : cA + S.koffA(t + 3); const char* b3 = b2 + kstep;
            unsigned sA[2][2], sB[2][2];
#pragma unroll
            for (int h = 0; h < 2; ++h)
#pragma unroll
                for (int i = 0; i < 2; ++i) { sA[h][i] = (Sched::VARA && last) ? nOA[h][i] : oA[h][i]; sB[h][i] = (Sched::VARB && last) ? nOB[h][i] : oB[h][i]; }
            PG8_LDB(B0, 0, 0); PG8_LDB(B1, 0, 1); PG8_SCHED; PG8_LDA(At, 0, 0); PG8_STAGE_A(PG8_SA(1, 1), a1, oA, 1);
            PG8_WAIT_V(8); PG8_WAIT_L(0); PG8_BAR; __builtin_amdgcn_s_setprio(1); PG8_MMA(0, 0, At, B0); PG8_MMA(0, 1, At, B1); __builtin_amdgcn_s_setprio(0); PG8_BAR; PG8_SCHED;
            PG8_LDA(At, 0, 1); PG8_STAGE_B(PG8_SB(0, 0), b2, sB, 0); PG8_STAGE_B(PG8_SB(0, 1), b2, sB, 1); PG8_STAGE_A(PG8_SA(0, 0), a2, sA, 0);
            PG8_WAIT_V(8); PG8_WAIT_L(0); PG8_BAR; __builtin_amdgcn_s_setprio(1); PG8_MMA(1, 0, At, B0); PG8_MMA(1, 1, At, B1); __builtin_amdgcn_s_setprio(0); PG8_BAR; PG8_SCHED;
            PG8_LDB(B0, 1, 0); PG8_LDB(B1, 1, 1); PG8_SCHED; PG8_LDA(At, 1, 0); PG8_STAGE_A(PG8_SA(0, 1), a2, sA, 1);
            PG8_WAIT_V(8); PG8_WAIT_L(0); PG8_BAR; __builtin_amdgcn_s_setprio(1); PG8_MMA(0, 0, At, B0); PG8_MMA(0, 1, At, B1); __builtin_amdgcn_s_setprio(0); PG8_BAR; PG8_SCHED;
            PG8_LDA(At, 1, 1); PG8_STAGE_B(PG8_SB(1, 0), b3, sB, 0); PG8_STAGE_B(PG8_SB(1, 1), b3, sB, 1); PG8_STAGE_A(PG8_SA(1, 0), a3, sA, 0);
            PG8_WAIT_V(8); PG8_WAIT_L(0); PG8_BAR; __builtin_amdgcn_s_setprio(1); PG8_MMA(1, 0, At, B0); PG8_MMA(1, 1, At, B1); __builtin_amdgcn_s_setprio(0); PG8_BAR; PG8_SCHED;
        }
        if (wr == 0) PG8_BAR;
        E(acc, cur, wr, wc, fr, fq);
        if (!has_next) break;
#pragma unroll
        for (int a = 0; a < 2; ++a)
#pragma unroll
            for (int b = 0; b < 2; ++b)
#pragma unroll
                for (int m = 0; m < 4; ++m)
#pragma unroll
                    for (int n = 0; n < 2; ++n) acc[a][b][m][n] = acc_t{};
        cur = nxt; cA = nA; cB = nB; ++ui;
#pragma unroll
        for (int h = 0; h < 2; ++h)
#pragma unroll
            for (int i = 0; i < 2; ++i) { oA[h][i] = nOA[h][i]; oB[h][i] = nOB[h][i]; }
        if (wr == 1) PG8_BAR;
    }
    PG8_WAIT_V(0);
    PG8_BAR;
#undef PG8_SA
#undef PG8_SB
#undef PG8_STAGE_A
#undef PG8_STAGE_B
#ifdef PG8_GLDS
#undef PG8_GLDS
#endif
#undef PG8_LDA
#undef PG8_LDB
#undef PG8_MMA
#undef PG8_WAIT_V
#undef PG8_WAIT_L
#undef PG8_BAR
#undef PG8_SCHED
}
}
using pg8::UnitPN;

struct F1Order {
    typedef UnitPN Unit; static constexpr bool VARA = false, VARB = false;
    const char* A; const char* B; int G, c;
    __device__ __forceinline__ bool next(int i, Unit& u) const { const int L = i * G + c; if (L >= 1024) return false; u.pn = L >> 2; u.pm = L & 3; return true; }
    __device__ __forceinline__ const char* baseA(const Unit& u) const { return A + (size_t)u.pm * 256 * 2048; }
    __device__ __forceinline__ const char* baseB(const Unit& u) const { return B + ((size_t)(u.pn >> 5) * 8192 + 2 * (u.pn & 31)) * 2048; }
    __device__ __forceinline__ unsigned hstepA() const { return 128u * 2048u; }
    __device__ __forceinline__ unsigned hstepB() const { return 2048u; }
    __device__ __forceinline__ size_t koffA(int t) const { return (size_t)t * 128; }
    __device__ __forceinline__ void offA(const Unit&, const int (&R)[2], const int (&C)[2], unsigned (&o)[2][2]) const {
#pragma unroll
        for (int h = 0; h < 2; ++h)
#pragma unroll
            for (int i = 0; i < 2; ++i) o[h][i] = (unsigned)((h * 128 + R[i]) * 1024 + C[i]) * 2u; }
    __device__ __forceinline__ void offB(const Unit&, const int (&R)[2], const int (&C)[2], unsigned (&o)[2][2]) const {
#pragma unroll
        for (int h = 0; h < 2; ++h)
#pragma unroll
            for (int i = 0; i < 2; ++i) o[h][i] = (unsigned)((h + 64 * R[i]) * 1024 + C[i]) * 2u; }
};
struct FBOrder {
    typedef UnitPN Unit; static constexpr bool VARA = false, VARB = false;
    const char* A; const char* B; int G, c;
    __device__ __forceinline__ bool next(int i, Unit& u) const { const int L = i * G + c; if (L >= 1024) return false; u.pm = L >> 4; u.pn = L & 15; return true; }
    __device__ __forceinline__ const char* baseA(const Unit& u) const { return A + (size_t)u.pm * 65536; }
    __device__ __forceinline__ const char* baseB(const Unit& u) const { return B + ((size_t)u.pm * 4096 + (size_t)u.pn * 256) * 512; }
    __device__ __forceinline__ unsigned hstepA() const { return 0u; }
    __device__ __forceinline__ unsigned hstepB() const { return 128u * 512u; }
    __device__ __forceinline__ size_t koffA(int t) const { return (size_t)t * 128; }
    __device__ __forceinline__ void offA(const Unit&, const int (&R)[2], const int (&C)[2], unsigned (&o)[2][2]) const {
#pragma unroll
        for (int h = 0; h < 2; ++h)
#pragma unroll
            for (int i = 0; i < 2; ++i) o[h][i] = (unsigned)(R[i] * 256 + C[i]) * 2u; }
    __device__ __forceinline__ void offB(const Unit&, const int (&R)[2], const int (&C)[2], unsigned (&o)[2][2]) const {
#pragma unroll
        for (int h = 0; h < 2; ++h)
#pragma unroll
            for (int i = 0; i < 2; ++i) o[h][i] = (unsigned)((h * 128 + R[i]) * 256 + C[i]) * 2u; }
};
struct MergeOrder {
    typedef UnitPN Unit; static constexpr bool VARA = false, VARB = false;
    const char* A; const char* A2; const char* B; int G, c;
    __device__ __forceinline__ bool next(int i, Unit& u) const { return pg8::static_next(i, G, c, T / 256, 4, u.pm, u.pn); }
    __device__ __forceinline__ const char* baseA(const Unit& u) const { return A + (size_t)u.pm * 256 * 1024; }
    __device__ __forceinline__ const char* baseB(const Unit& u) const { return B + (size_t)u.pn * 256 * 2048; }
    __device__ __forceinline__ unsigned hstepA() const { return 128u * 1024u; }
    __device__ __forceinline__ unsigned hstepB() const { return 128u * 2048u; }
    __device__ __forceinline__ size_t koffA(int t) const { return t < 8 ? (size_t)t * 128 : (size_t)(A2 - A) + (size_t)(t - 8) * 128; }
    __device__ __forceinline__ void offA(const Unit&, const int (&R)[2], const int (&C)[2], unsigned (&o)[2][2]) const {
#pragma unroll
        for (int h = 0; h < 2; ++h)
#pragma unroll
            for (int i = 0; i < 2; ++i) o[h][i] = (unsigned)((h * 128 + R[i]) * 512 + C[i]) * 2u; }
    __device__ __forceinline__ void offB(const Unit&, const int (&R)[2], const int (&C)[2], unsigned (&o)[2][2]) const {
#pragma unroll
        for (int h = 0; h < 2; ++h)
#pragma unroll
            for (int i = 0; i < 2; ++i) o[h][i] = (unsigned)((h * 128 + R[i]) * 1024 + C[i]) * 2u; }
};
struct F1Order8 {
    typedef UnitPN Unit; static constexpr bool VARA = false, VARB = false;
    const char* A; const char* B; int G, c;
    __device__ __forceinline__ bool next(int i, Unit& u) const { const int L = i * G + c; if (L >= 1024) return false; u.pn = L >> 2; u.pm = L & 3; return true; }
    __device__ __forceinline__ const char* baseA(const Unit& u) const { return A + (size_t)u.pm * 256 * 1024; }
    __device__ __forceinline__ const char* baseB(const Unit& u) const { return B + ((size_t)(u.pn >> 5) * 8192 + 2 * (u.pn & 31)) * 1024; }
    __device__ __forceinline__ unsigned hstepA() const { return 128u * 1024u; }
    __device__ __forceinline__ unsigned hstepB() const { return 1024u; }
    __device__ __forceinline__ size_t koffA(int t) const { return (size_t)t * 128; }
    __device__ __forceinline__ void offA(const Unit&, const int (&R)[2], const int (&C)[2], unsigned (&o)[2][2]) const {
#pragma unroll
        for (int h = 0; h < 2; ++h)
#pragma unroll
            for (int i = 0; i < 2; ++i) o[h][i] = (unsigned)((h * 128 + R[i]) * 1024 + C[i] * 2); }
    __device__ __forceinline__ void offB(const Unit&, const int (&R)[2], const int (&C)[2], unsigned (&o)[2][2]) const {
#pragma unroll
        for (int h = 0; h < 2; ++h)
#pragma unroll
            for (int i = 0; i < 2; ++i) o[h][i] = (unsigned)((h + 64 * R[i]) * 1024 + C[i] * 2); }
};
struct MoeUnit { int e, row0, cnt, orow, pn; };
template <int NPN> __device__ __forceinline__ bool moe_next(int i, int G, int c, const LAS int* tst, const LAS int* cntl, MoeUnit& u) {
    const int L = i * G + c; const int tile = L / NPN; const int total = __builtin_amdgcn_readfirstlane(tst[32]);
    if (tile >= total) return false;
    const LAS unsigned char* texp = (const LAS unsigned char*)(tst + 40);
    const int e = __builtin_amdgcn_readfirstlane((int)texp[tile]);
    u.e = e; u.row0 = (tile - __builtin_amdgcn_readfirstlane(tst[e])) * 256; u.cnt = __builtin_amdgcn_readfirstlane(cntl[e]); u.orow = tile * 256; u.pn = L % NPN; return true;
}
struct MoeUpOrder {
    typedef MoeUnit Unit; static constexpr bool VARA = true, VARB = false;
    const char* A; const char* B; const u32x2* list; const LAS int* tst; const LAS int* cntl; int G, c;
    __device__ __forceinline__ bool next(int i, Unit& u) const { return moe_next<2>(i, G, c, tst, cntl, u); }
    __device__ __forceinline__ const char* baseA(const Unit&) const { return A; }
    __device__ __forceinline__ const char* baseB(const Unit& u) const { return B + ((size_t)u.e * 512 + (size_t)u.pn * 256) * 2048; }
    __device__ __forceinline__ unsigned hstepA() const { return 0u; }
    __device__ __forceinline__ unsigned hstepB() const { return 128u * 2048u; }
    __device__ __forceinline__ size_t koffA(int t) const { return (size_t)t * 128; }
    __device__ __forceinline__ void offA(const Unit& u, const int (&R)[2], const int (&C)[2], unsigned (&o)[2][2]) const {
#pragma unroll
        for (int h = 0; h < 2; ++h)
#pragma unroll
            for (int i = 0; i < 2; ++i) { const int li = u.row0 + h * 128 + R[i]; const int tok = (li < u.cnt) ? (int)(list[(size_t)u.e * 65536 + li].x & 0x7fffffffu) : 0; o[h][i] = (unsigned)tok * 2048u + (unsigned)C[i] * 2u; } }
    __device__ __forceinline__ void offB(const Unit&, const int (&R)[2], const int (&C)[2], unsigned (&o)[2][2]) const {
#pragma unroll
        for (int h = 0; h < 2; ++h)
#pragma unroll
            for (int i = 0; i < 2; ++i) o[h][i] = (unsigned)((h * 128 + R[i]) * 1024 + C[i]) * 2u; }
};
struct MoeUpOrder8 {
    typedef MoeUnit Unit; static constexpr bool VARA = true, VARB = false;
    const char* A; const char* B; const u32x2* list; const LAS int* tst; const LAS int* cntl; int G, c;
    __device__ __forceinline__ bool next(int i, Unit& u) const { return moe_next<2>(i, G, c, tst, cntl, u); }
    __device__ __forceinline__ const char* baseA(const Unit&) const { return A; }
    __device__ __forceinline__ const char* baseB(const Unit& u) const { return B + ((size_t)u.e * 512 + (size_t)u.pn * 256) * 1024; }
    __device__ __forceinline__ unsigned hstepA() const { return 0u; }
    __device__ __forceinline__ unsigned hstepB() const { return 128u * 1024u; }
    __device__ __forceinline__ size_t koffA(int t) const { return (size_t)t * 128; }
    __device__ __forceinline__ void offA(const Unit& u, const int (&R)[2], const int (&C)[2], unsigned (&o)[2][2]) const {
#pragma unroll
        for (int h = 0; h < 2; ++h)
#pragma unroll
            for (int i = 0; i < 2; ++i) { const int li = u.row0 + h * 128 + R[i]; const int tok = (li < u.cnt) ? (int)(list[(size_t)u.e * 65536 + li].x & 0x7fffffffu) : 0; o[h][i] = (unsigned)tok * 1024u + (unsigned)C[i] * 2u; } }
    __device__ __forceinline__ void offB(const Unit&, const int (&R)[2], const int (&C)[2], unsigned (&o)[2][2]) const {
#pragma unroll
        for (int h = 0; h < 2; ++h)
#pragma unroll
            for (int i = 0; i < 2; ++i) o[h][i] = (unsigned)((h * 128 + R[i]) * 1024 + C[i] * 2); }
};
struct MoeDownOrder {
    typedef MoeUnit Unit; static constexpr bool VARA = false, VARB = false;
    const char* A; const char* B; const LAS int* tst; const LAS int* cntl; int G, c;
    __device__ __forceinline__ bool next(int i, Unit& u) const { return moe_next<4>(i, G, c, tst, cntl, u); }
    __device__ __forceinline__ const char* baseA(const Unit& u) const { return A + (size_t)u.orow * 512; }
    __device__ __forceinline__ const char* baseB(const Unit& u) const { return B + ((size_t)u.e * 1024 + (size_t)u.pn * 256) * 512; }
    __device__ __forceinline__ unsigned hstepA() const { return 128u * 512u; }
    __device__ __forceinline__ unsigned hstepB() const { return 128u * 512u; }
    __device__ __forceinline__ size_t koffA(int t) const { return (size_t)t * 128; }
    __device__ __forceinline__ void offA(const Unit&, const int (&R)[2], const int (&C)[2], unsigned (&o)[2][2]) const {
#pragma unroll
        for (int h = 0; h < 2; ++h)
#pragma unroll
            for (int i = 0; i < 2; ++i) o[h][i] = (unsigned)((h * 128 + R[i]) * 256 + C[i]) * 2u; }
    __device__ __forceinline__ void offB(const Unit& u, const int (&R)[2], const int (&C)[2], unsigned (&o)[2][2]) const { offA(u, R, C, o); }
};

typedef const f32x4 (&AccRef)[2][2][4][2];
#ifdef EPI_NT_STORES
#define EPI_ST(TY, P, V) __builtin_nontemporal_store((V), (TY*)(P))
#else
#define EPI_ST(TY, P, V) (*(TY*)(P) = (V))
#endif
#ifndef EPI_FENCE
#define EPI_FENCE do { } while (0)
#endif
#define EPI_LOOP_AM _Pragma("unroll") for (int ai = 0; ai < 2; ++ai) _Pragma("unroll") for (int m = 0; m < 4; ++m)

__device__ __forceinline__ unsigned q8(float x) { return (unsigned)(sigmoidf_(x) * 255.0f + 0.5f); }
__device__ __forceinline__ size_t gate_off(int pm, int which, int pn4, int wave, int ai, int bj, int m, int lane) { return ((((size_t)(pm * 2 + which) * 4 + pn4) * 8 + wave) * 16 + (ai * 2 + bj) * 4 + m) * 512 + lane * 8; }
struct EpiZ {
    static constexpr bool PERM = true, MIDK = false, I8 = false;
    bf16_t* __restrict__ QL; bf16_t* __restrict__ KVL; float* __restrict__ SSQQ; float* __restrict__ SSQKV; unsigned char* __restrict__ GATE; const float* __restrict__ bg; bf16_t* __restrict__ KB; const float* __restrict__ RC; const float* __restrict__ RS;
    __device__ __forceinline__ void operator()(AccRef acc, const UnitPN& u, int wr, int wc, int fr, int fq) const {
        const int row0 = u.pm * 256 + wr * 64 + fr, c0 = wc * 32 + 8 * fq;
        if (u.pn < 2) {
            bf16_t* O = u.pn ? KVL : QL; float* SS = u.pn ? SSQKV : SSQQ;
            EPI_LOOP_AM { const int row = row0 + ai * 128 + m * 16; float s = 0.f;
#pragma unroll
                for (int bj = 0; bj < 2; ++bj) { const f32x4 v0 = acc[ai][bj][m][0], v1 = acc[ai][bj][m][1];
                    s += (v0[0] * v0[0] + v0[1] * v0[1]) + (v0[2] * v0[2] + v0[3] * v0[3]) + (v1[0] * v1[0] + v1[1] * v1[1]) + (v1[2] * v1[2] + v1[3] * v1[3]);
                    EPI_ST(u32x4, O + (size_t)row * 256 + bj * 128 + c0, pack8(v0, v1)); }
                s += __shfl_xor(s, 16); s += __shfl_xor(s, 32);
                if (fq == 0) SS[(size_t)row * 4 + wc] = s; }
        } else if (u.pn < 10) {
            const int gc0 = (u.pn - 2) * 256 + c0;
            f32x4 bv[2][2];
#pragma unroll
            for (int bj = 0; bj < 2; ++bj)
#pragma unroll
                for (int n = 0; n < 2; ++n) bv[bj][n] = *(const f32x4*)(bg + gc0 + bj * 128 + 4 * n);
            EPI_LOOP_AM { const int row = row0 + ai * 128 + m * 16;
#pragma unroll
                for (int bj = 0; bj < 2; ++bj) { const f32x4 v0 = acc[ai][bj][m][0] + bv[bj][0], v1 = acc[ai][bj][m][1] + bv[bj][1];
                    u32x2 w;
                    w.x = q8(v0[0]) | (q8(v0[1]) << 8) | (q8(v0[2]) << 16) | (q8(v0[3]) << 24); w.y = q8(v1[0]) | (q8(v1[1]) << 8) | (q8(v1[2]) << 16) | (q8(v1[3]) << 24);
                    EPI_ST(u32x2, GATE + (size_t)row * 2048 + gc0 + bj * 128, w); }
                EPI_FENCE; }
        } else if (wc == 0) {
            f32x4 cs[2][4], sn[2][4];
            EPI_LOOP_AM { const int row = row0 + ai * 128 + m * 16; cs[ai][m] = *(const f32x4*)(RC + (size_t)row * 16 + 4 * fq); sn[ai][m] = *(const f32x4*)(RS + (size_t)row * 16 + 4 * fq); }
            EPI_LOOP_AM { const int row = row0 + ai * 128 + m * 16; const int b = row >> 13, s = row & 8191;
                const f32x4 x1 = acc[ai][0][m][0], x2 = acc[ai][0][m][1];
                const u32x2 p1 = pack4(x1 * cs[ai][m] - x2 * sn[ai][m]), p2 = pack4(x2 * cs[ai][m] + x1 * sn[ai][m]);
#pragma unroll
                for (int h = 0; h < 8; ++h) { bf16_t* kp = KB + (((size_t)(b * 8 + h) * 128 + (s >> 6)) * 12 + 8 + (fq >> 1)) * 512 + (s & 63) * 8 + 4 * (fq & 1); *(u32x2*)kp = p1; EPI_ST(u32x2, kp + 1024, p2); } }
        }
    }
};
struct EpiF1 {
    static constexpr bool PERM = true, MIDK = false, I8 = false;
    bf16_t* YT2;
    __device__ __forceinline__ void operator()(AccRef acc, const UnitPN& u, int wr, int wc, int fr, int fq) const {
        const int b = u.pn >> 5, tt = u.pn & 31;
        EPI_LOOP_AM { const int r = u.pm * 256 + ai * 128 + wr * 64 + m * 16 + fr; const int ri = r >> 9, gc = r & 511;
#pragma unroll
            for (int bj = 0; bj < 2; ++bj) { const int sa = 2 * tt + bj, sb = wc * 32 + 8 * fq;
                EPI_ST(u32x4, YT2 + ((((size_t)b * 512 + gc) * 64 + sa) * 2 + ri) * 128 + sb, pack8(acc[ai][bj][m][0], acc[ai][bj][m][1])); } }
    }
};
struct EpiFA {
    static constexpr bool PERM = true, MIDK = false, I8 = false;
    bf16_t* Z;
    __device__ __forceinline__ void operator()(AccRef acc, const UnitPN& u, int wr, int wc, int fr, int fq) const {
        EPI_LOOP_AM { const int kb = wr * 64 + m * 16 + fr;
#pragma unroll
            for (int bj = 0; bj < 2; ++bj) { const int gcb = u.pn * 4 + bj * 2 + (wc >> 1), sa = 32 * (wc & 1) + 8 * fq;
                EPI_ST(u32x4, Z + (((((size_t)(kb >> 1) * 4096 + gcb) * 2 + (kb & 1)) * 2 + ai) * 64 + sa), pack8(acc[ai][bj][m][0], acc[ai][bj][m][1])); } }
    }
};
struct EpiFB {
    static constexpr bool PERM = true, MIDK = false, I8 = false;
    bf16_t* FO;
    __device__ __forceinline__ void operator()(AccRef acc, const UnitPN& u, int wr, int wc, int fr, int fq) const {
        const int b = u.pn >> 1;
#pragma unroll
        for (int m = 0; m < 4; ++m) { const int ka = m * 16 + fr, s = 2 * u.pm + wr + 128 * ka;
#pragma unroll
            for (int bj = 0; bj < 2; ++bj) { const int gc = (u.pn & 1) * 256 + bj * 128 + wc * 32 + 8 * fq;
                EPI_ST(u32x4, FO + ((size_t)b * 8192 + s) * 512 + gc, pack8(acc[0][bj][m][0], acc[0][bj][m][1])); } }
    }
};
struct EpiQ {
    static constexpr bool PERM = true, MIDK = false, I8 = false;
    bf16_t* __restrict__ Q; const float* __restrict__ SSQ; const float* __restrict__ RC; const float* __restrict__ RS;
    __device__ __forceinline__ void operator()(AccRef acc, const UnitPN& u, int wr, int wc, int fr, int fq) const {
        const int g0 = u.pn * 8 + wc, g1 = g0 + 4; const bool rope = (g0 % 3 == 2) || (g1 % 3 == 2);
#pragma unroll
        for (int ai = 0; ai < 2; ++ai) {
            f32x4 sq[4], cs[4], sn[4];
#pragma unroll
            for (int m = 0; m < 4; ++m) { const int row = u.pm * 256 + ai * 128 + wr * 64 + m * 16 + fr; sq[m] = *(const f32x4*)(SSQ + (size_t)row * 4);
                if (rope) { cs[m] = *(const f32x4*)(RC + (size_t)row * 16 + 4 * fq); sn[m] = *(const f32x4*)(RS + (size_t)row * 16 + 4 * fq); } else { cs[m] = sq[m]; sn[m] = sq[m]; } }
#pragma unroll
            for (int m = 0; m < 4; ++m) { const int row = u.pm * 256 + ai * 128 + wr * 64 + m * 16 + fr;
                const float rs = C2 * __builtin_amdgcn_rsqf(((sq[m][0] + sq[m][1]) + (sq[m][2] + sq[m][3])) * (1.0f / 256.0f) + EPS);
#pragma unroll
                for (int bj = 0; bj < 2; ++bj) { const int g32 = u.pn * 8 + bj * 4 + wc; const int hh = g32 / 3, part = g32 - 3 * hh;
                    const f32x4 v0 = acc[ai][bj][m][0] * rs, v1 = acc[ai][bj][m][1] * rs;
                    if (part < 2) { EPI_ST(u32x4, Q + (size_t)row * QC + g32 * 32 + 8 * fq, pack8(v0, v1)); }
                    else { bf16_t* qp = Q + (size_t)row * QC + hh * 96 + 64 + 4 * fq;
                        *(u32x2*)qp = pack4(v0 * cs[m] - v1 * sn[m]); EPI_ST(u32x2, qp + 16, pack4(v1 * cs[m] + v0 * sn[m])); } } }
        }
    }
};
struct EpiKV {
    static constexpr bool PERM = true, MIDK = false, I8 = false;
    bf16_t* __restrict__ KB; bf16_t* __restrict__ VB; const float* __restrict__ SSQ;
    __device__ __forceinline__ void operator()(AccRef acc, const UnitPN& u, int wr, int wc, int fr, int fq) const {
        f32x4 sq[2][4];
        EPI_LOOP_AM { const int row = u.pm * 256 + ai * 128 + wr * 64 + m * 16 + fr; sq[ai][m] = *(const f32x4*)(SSQ + (size_t)row * 4); }
        EPI_LOOP_AM { const int row = u.pm * 256 + ai * 128 + wr * 64 + m * 16 + fr; const int b = row >> 13, s = row & 8191;
            const float rs = __builtin_amdgcn_rsqf(((sq[ai][m][0] + sq[ai][m][1]) + (sq[ai][m][2] + sq[ai][m][3])) * (1.0f / 256.0f) + EPS);
#pragma unroll
            for (int bj = 0; bj < 2; ++bj) { const int c = (u.pn & 1) * 256 + bj * 128 + wc * 32 + 8 * fq; const int hh = c >> 6, d = c & 63;
                const u32x4 w = pack8(acc[ai][bj][m][0] * rs, acc[ai][bj][m][1] * rs);
                if (u.pn < 2) EPI_ST(u32x4, KB + (((size_t)(b * 8 + hh) * 128 + (s >> 6)) * 12 + (d >> 3)) * 512 + (s & 63) * 8, w);
                else EPI_ST(u32x4, VB + (((size_t)(b * 8 + hh) * 128 + (s >> 6)) * 8 + (d >> 5) * 4 + ((s & 63) >> 4)) * 512 + (s & 15) * 32 + (d & 31), w); } }
    }
};
struct EpiMerge2 {
    static constexpr bool PERM = true, MIDK = true, I8 = false;
    bf16_t* __restrict__ MRG; const unsigned char* __restrict__ GATE;
    __device__ __forceinline__ void mid(f32x4 (&acc)[2][2][4][2], const UnitPN& u, int wr, int wc, int fr, int fq) const {
#pragma unroll
        for (int ai = 0; ai < 2; ++ai) {
            u32x2 ga[4][2], gf[4][2];
#pragma unroll
            for (int m = 0; m < 4; ++m)
#pragma unroll
                for (int bj = 0; bj < 2; ++bj) { ga[m][bj] = *(const u32x2*)(GATE + gate_off(u.pm, 0, u.pn, wr * 4 + wc, ai, bj, m, fq * 16 + fr)); gf[m][bj] = *(const u32x2*)(GATE + gate_off(u.pm, 1, u.pn, wr * 4 + wc, ai, bj, m, fq * 16 + fr)); }
#pragma unroll
            for (int m = 0; m < 4; ++m)
#pragma unroll
                for (int bj = 0; bj < 2; ++bj) { const u32x2 a = ga[m][bj], f = gf[m][bj];
#pragma unroll
                    for (int j = 0; j < 4; ++j) { const float fa0 = (float)((a.x >> (8 * j)) & 0xffu), fa1 = (float)((a.y >> (8 * j)) & 0xffu);
                        const float ff0 = fmaxf((float)((f.x >> (8 * j)) & 0xffu), 1.0f), ff1 = fmaxf((float)((f.y >> (8 * j)) & 0xffu), 1.0f);
                        acc[ai][bj][m][0][j] *= fa0 * __builtin_amdgcn_rcpf(ff0); acc[ai][bj][m][1][j] *= fa1 * __builtin_amdgcn_rcpf(ff1); } }
        }
    }
    __device__ __forceinline__ void operator()(AccRef acc, const UnitPN& u, int wr, int wc, int fr, int fq) const {
#pragma unroll
        for (int ai = 0; ai < 2; ++ai) {
            u32x2 gf[4][2];
#pragma unroll
            for (int m = 0; m < 4; ++m)
#pragma unroll
                for (int bj = 0; bj < 2; ++bj) gf[m][bj] = *(const u32x2*)(GATE + gate_off(u.pm, 1, u.pn, wr * 4 + wc, ai, bj, m, fq * 16 + fr));
#pragma unroll
            for (int m = 0; m < 4; ++m)
#pragma unroll
                for (int bj = 0; bj < 2; ++bj) { const int row = u.pm * 256 + ai * 128 + wr * 64 + m * 16 + fr, col = u.pn * 256 + bj * 128 + wc * 32 + 8 * fq; const u32x2 f = gf[m][bj];
                    f32x4 v0 = acc[ai][bj][m][0] * (1.0f / 255.0f), v1 = acc[ai][bj][m][1] * (1.0f / 255.0f);
#pragma unroll
                    for (int j = 0; j < 4; ++j) { v0[j] *= fmaxf((float)((f.x >> (8 * j)) & 0xffu), 1.0f); v1[j] *= fmaxf((float)((f.y >> (8 * j)) & 0xffu), 1.0f); }
                    EPI_ST(u32x4, MRG + (size_t)row * 1024 + col, pack8(v0, v1)); }
        }
    }
};
struct EpiH {
    static constexpr bool PERM = true, MIDK = false, I8 = false;
    const float* __restrict__ X; bf16_t* __restrict__ Hout; const float* __restrict__ MODF;
    __device__ __forceinline__ void operator()(AccRef acc, const UnitPN& u, int wr, int wc, int fr, int fq) const {
        const int b = u.pm >> 5; const int col0 = u.pn * 256 + wc * 32 + 8 * fq;
        f32x4 gt[2][2];
#pragma unroll
        for (int bj = 0; bj < 2; ++bj)
#pragma unroll
            for (int n = 0; n < 2; ++n) gt[bj][n] = *(const f32x4*)(MODF + (size_t)b * 8192 + 2048 + col0 + bj * 128 + n * 4);
#pragma unroll
        for (int ai = 0; ai < 2; ++ai)
#pragma unroll
            for (int mp = 0; mp < 2; ++mp) {
                f32x4 xv[2][2][2];
#pragma unroll
                for (int mm = 0; mm < 2; ++mm)
#pragma unroll
                    for (int bj = 0; bj < 2; ++bj) { const size_t off = (size_t)(u.pm * 256 + ai * 128 + wr * 64 + (2 * mp + mm) * 16 + fr) * 1024 + col0;
                        xv[mm][bj][0] = *(const f32x4*)(X + off + bj * 128); xv[mm][bj][1] = *(const f32x4*)(X + off + bj * 128 + 4); }
#pragma unroll
                for (int mm = 0; mm < 2; ++mm)
#pragma unroll
                    for (int bj = 0; bj < 2; ++bj) { const int m = 2 * mp + mm; const size_t off = (size_t)(u.pm * 256 + ai * 128 + wr * 64 + m * 16 + fr) * 1024 + col0;
                        EPI_ST(u32x4, Hout + off + bj * 128, pack8(xv[mm][bj][0] + gt[bj][0] * acc[ai][bj][m][0], xv[mm][bj][1] + gt[bj][1] * acc[ai][bj][m][1])); }
            }
    }
};
struct EpiUp {
    static constexpr bool PERM = true, MIDK = false, I8 = false;
    bf16_t* HID;
    __device__ __forceinline__ void operator()(AccRef acc, const MoeUnit& u, int wr, int wc, int fr, int fq) const {
        EPI_LOOP_AM { const int lr = ai * 128 + wr * 64 + m * 16 + fr;
#pragma unroll
            for (int bj = 0; bj < 2; ++bj) { const int hh = u.pn * 128 + bj * 64 + wc * 16 + 4 * fq;
                const f32x4 g = acc[ai][bj][m][0], uu = acc[ai][bj][m][1]; f32x4 o;
#pragma unroll
                for (int j = 0; j < 4; ++j) o[j] = g[j] * sigmoidf_(g[j]) * uu[j];
                EPI_ST(u32x2, HID + (size_t)(u.orow + lr) * 256 + hh, pack4(o)); } }
    }
};
struct EpiDown {
    static constexpr bool PERM = true, MIDK = false, I8 = false;
    bf16_t* __restrict__ Y2;
    __device__ __forceinline__ void operator()(AccRef acc, const MoeUnit& u, int wr, int wc, int fr, int fq) const {
        EPI_LOOP_AM { const size_t row = (size_t)u.orow + ai * 128 + wr * 64 + m * 16 + fr;
#pragma unroll
            for (int bj = 0; bj < 2; ++bj) { const int col = u.pn * 256 + bj * 128 + wc * 32 + 8 * fq;
                EPI_ST(u32x4, Y2 + row * 1024 + col, pack8(acc[ai][bj][m][0], acc[ai][bj][m][1])); } }
    }
};

#ifdef PROBE_KLOOP
struct EpiNull {
    static constexpr bool PERM = true, MIDK = false, I8 = false;
    float* sink; int never;
    __device__ __forceinline__ void operator()(AccRef acc, const UnitPN& u, int wr, int wc, int fr, int fq) const {
        if (never < 0) { f32x4 s = acc[0][0][0][0];
            EPI_LOOP_AM { s += acc[ai][0][m][0] + acc[ai][0][m][1] + acc[ai][1][m][0] + acc[ai][1][m][1]; }
            *(f32x4*)(sink + fr) = s; }
    }
};
#endif

typedef const i32x4 (&AccRefI)[2][2][4][2];
__device__ __forceinline__ f32x4 i2f(const i32x4 v, float s) { return (f32x4){(float)v[0] * s, (float)v[1] * s, (float)v[2] * s, (float)v[3] * s}; }
struct EpiZ8 {
    static constexpr bool PERM = true, MIDK = false, I8 = true;
    unsigned char* __restrict__ ws; const float* __restrict__ bg;
    __device__ __forceinline__ void operator()(AccRefI acc, const UnitPN& u, int wr, int wc, int fr_, int fq_) const {
        int fr = fr_, fq = fq_; asm volatile("" : "+v"(fr), "+v"(fq));
        const int row0 = u.pm * 256 + wr * 64 + fr, c0 = wc * 32 + 8 * fq;
        const float* SU = (const float*)(ws + WS_SU);
        const float sw = __uint_as_float(((const unsigned*)(ws + WS_CTL))[CW_WMAX]) * (1.0f / 127.0f);
        if (u.pn < 2) {
            bf16_t* O = (bf16_t*)(ws + (u.pn ? WS_KVL : WS_QL)); float* SS = (float*)(ws + (u.pn ? WS_SSQKV : WS_SSQQ));
            EPI_LOOP_AM { const int row = row0 + ai * 128 + m * 16; float s = 0.f; const float su_ = SU[row] * sw;
#pragma unroll
                for (int bj = 0; bj < 2; ++bj) { const f32x4 v0 = i2f(acc[ai][bj][m][0], su_), v1 = i2f(acc[ai][bj][m][1], su_);
                    s += (v0[0] * v0[0] + v0[1] * v0[1]) + (v0[2] * v0[2] + v0[3] * v0[3]) + (v1[0] * v1[0] + v1[1] * v1[1]) + (v1[2] * v1[2] + v1[3] * v1[3]);
                    EPI_ST(u32x4, O + (size_t)row * 256 + bj * 128 + c0, pack8(v0, v1)); }
                s += __shfl_xor(s, 16); s += __shfl_xor(s, 32);
                if (fq == 0) SS[(size_t)row * 4 + wc] = s; }
        } else if (u.pn < 10) {
            const int gc0 = (u.pn - 2) * 256 + c0;
#pragma unroll
            for (int bj = 0; bj < 2; ++bj) {
                const f32x4 bv0 = *(const f32x4*)(bg + gc0 + bj * 128), bv1 = *(const f32x4*)(bg + gc0 + bj * 128 + 4);
                EPI_LOOP_AM { const int row = row0 + ai * 128 + m * 16; const float su_ = SU[row] * sw;
                    const f32x4 v0 = i2f(acc[ai][bj][m][0], su_) + bv0, v1 = i2f(acc[ai][bj][m][1], su_) + bv1;
                    u32x2 w;
                    w.x = q8(v0[0]) | (q8(v0[1]) << 8) | (q8(v0[2]) << 16) | (q8(v0[3]) << 24); w.y = q8(v1[0]) | (q8(v1[1]) << 8) | (q8(v1[2]) << 16) | (q8(v1[3]) << 24);
                    EPI_ST(u32x2, ws + WS_GATE + gate_off(u.pm, (u.pn - 2) >> 2, (u.pn - 2) & 3, wr * 4 + wc, ai, bj, m, fq * 16 + fr), w); }
            }
        } else if (wc == 0) {
            f32x4 cs[2][4], sn[2][4];
            EPI_LOOP_AM { const int row = row0 + ai * 128 + m * 16; cs[ai][m] = *(const f32x4*)((const float*)(ws + WS_ROPEC) + (size_t)row * 16 + 4 * fq); sn[ai][m] = *(const f32x4*)((const float*)(ws + WS_ROPES) + (size_t)row * 16 + 4 * fq); }
            EPI_LOOP_AM { const int row = row0 + ai * 128 + m * 16; const int b = row >> 13, s = row & 8191; const float su_ = SU[row] * sw;
                const f32x4 x1 = i2f(acc[ai][0][m][0], su_), x2 = i2f(acc[ai][0][m][1], su_);
                const u32x2 p1 = pack4(x1 * cs[ai][m] - x2 * sn[ai][m]), p2 = pack4(x2 * cs[ai][m] + x1 * sn[ai][m]);
#pragma unroll
                for (int h = 0; h < 8; ++h) { bf16_t* kp = (bf16_t*)(ws + WS_K) + (((size_t)(b * 8 + h) * 128 + (s >> 6)) * 12 + 8 + (fq >> 1)) * 512 + (s & 63) * 8 + 4 * (fq & 1); EPI_ST(u32x2, kp, p1); EPI_ST(u32x2, kp + 1024, p2); } }
        }
    }
};
struct EpiF18 {
    static constexpr bool PERM = true, MIDK = false, I8 = true;
    unsigned char* __restrict__ ws;
    __device__ __forceinline__ void operator()(AccRefI acc, const UnitPN& u, int wr, int wc, int fr, int fq) const {
        const int b = u.pn >> 5, tt = u.pn & 31;
        const float* SU = (const float*)(ws + WS_SU); bf16_t* YT2 = (bf16_t*)(ws + WS_YT2);
        const float sw = __uint_as_float(((const unsigned*)(ws + WS_CTL))[CW_WMAX + 1]) * (1.0f / 127.0f);
#pragma unroll
        for (int bj = 0; bj < 2; ++bj) {
            float sc[8];
#pragma unroll
            for (int i = 0; i < 8; ++i) sc[i] = SU[(size_t)b * 8192 + (2 * tt + bj) + 64 * (wc * 32 + 8 * fq + i)] * sw;
            EPI_LOOP_AM { const int r = u.pm * 256 + ai * 128 + wr * 64 + m * 16 + fr; const int ri = r >> 9, gc = r & 511; const int sa = 2 * tt + bj, sb = wc * 32 + 8 * fq;
                const i32x4 a0 = acc[ai][bj][m][0], a1 = acc[ai][bj][m][1];
                const f32x4 v0 = {(float)a0[0] * sc[0], (float)a0[1] * sc[1], (float)a0[2] * sc[2], (float)a0[3] * sc[3]};
                const f32x4 v1 = {(float)a1[0] * sc[4], (float)a1[1] * sc[5], (float)a1[2] * sc[6], (float)a1[3] * sc[7]};
                EPI_ST(u32x4, YT2 + ((((size_t)b * 512 + gc) * 64 + sa) * 2 + ri) * 128 + sb, pack8(v0, v1)); }
        }
    }
};
struct EpiUp8 {
    static constexpr bool PERM = true, MIDK = false, I8 = true;
    unsigned char* __restrict__ ws;
    __device__ __forceinline__ void operator()(AccRefI acc, const MoeUnit& u, int wr, int wc, int fr, int fq) const {
        bf16_t* HID = (bf16_t*)(ws + WS_Q); const u32x2* list = (const u32x2*)(ws + WS_LIST);
        const float sw = __uint_as_float(((const unsigned*)(ws + WS_CTL))[CW_WMAX + 2 + u.e]) * (1.0f / 127.0f);
        float sr[2][4];
        EPI_LOOP_AM { const int li = u.row0 + ai * 128 + wr * 64 + m * 16 + fr; sr[ai][m] = __uint_as_float(list[(size_t)u.e * 65536 + (li < u.cnt ? li : 0)].y) * sw; }
        EPI_LOOP_AM { const int lr = ai * 128 + wr * 64 + m * 16 + fr; const int hh = u.pn * 128 + wc * 32 + 8 * fq;
            u32x2 w[2];
#pragma unroll
            for (int bj = 0; bj < 2; ++bj) { const f32x4 g = i2f(acc[ai][bj][m][0], sr[ai][m]), uu = i2f(acc[ai][bj][m][1], sr[ai][m]); f32x4 o;
#pragma unroll
                for (int j = 0; j < 4; ++j) o[j] = g[j] * sigmoidf_(g[j]) * uu[j];
                w[bj] = pack4(o); }
            EPI_ST(u32x4, HID + (size_t)(u.orow + lr) * 256 + hh, ((u32x4){w[0].x, w[0].y, w[1].x, w[1].y})); }
    }
};

namespace att {
constexpr int NW = 8, KVBLK = 64, NT = SEQ / KVBLK, UROWS = 512;
constexpr int KSLOT = 12288, VSLOT = 8192, NSK = 3, NSV = 4;
constexpr int L_K = 0, L_V = NSK * KSLOT, L_WS = L_V + NSV * VSLOT, L_Q = L_WS + NW * 64 * 4, L_OST = L_Q, BYTES = L_Q + NW * 6144;
#define SBAR() __builtin_amdgcn_sched_barrier(0)
typedef short v4i16_t __attribute__((ext_vector_type(4)));
__device__ __forceinline__ int crow(int r, int hi) { return (r & 3) + 8 * (r >> 2) + 4 * hi; }
__device__ __forceinline__ s16x4 vtr(const LAS unsigned char* p) { return __builtin_bit_cast(s16x4, __builtin_amdgcn_ds_read_tr16_b64_v4i16((LAS v4i16_t*)p)); }
#define MF(a, b, c) __builtin_amdgcn_mfma_f32_32x32x16_bf16(a, b, c, 0, 0, 0)

__device__ __forceinline__ void attn_unit(const bf16_t* __restrict__ Qb, const bf16_t* __restrict__ Kt, const bf16_t* __restrict__ Vt, bf16_t* __restrict__ Ob, LAS unsigned char* lds) {
    const int tid = threadIdx.x, lane = tid & 63, r32 = lane & 31, hi = lane >> 5; const int wid = __builtin_amdgcn_readfirstlane(tid >> 6);
    const bool late = false;
    LAS float* wsf = (LAS float*)(lds + L_WS) + wid * 64;
    const unsigned voff = (unsigned)lane * 16u; const unsigned ldsbase = (unsigned)(uintptr_t)lds;
    const char* kbA = (const char*)Kt + wid * 1024; const char* kbB = (const char*)Kt + (8 + (wid & 3)) * 1024; const char* vbs = (const char*)Vt + wid * 1024;
    const int kdA = L_K + wid * 1024, kdB = L_K + (8 + (wid & 3)) * 1024, vd = L_V + wid * 1024;
#define GLDS(base, ldsoff) do { unsigned keep_; asm volatile("s_mov_b32 %0, m0\n\ts_mov_b32 m0, %3\n\ts_nop 0\n\tglobal_load_lds_dwordx4 %1, %2\n\ts_mov_b32 m0, %0" \
        : "=&s"(keep_) : "v"(voff), "s"(base), "s"((unsigned)(ldsbase + (ldsoff))) : "memory"); } while (0)
#define DMA_K(t, s) do { const int t_ = (t) < NT ? (t) : NT - 1; GLDS(kbA + (size_t)t_ * 12288, kdA + (s) * KSLOT); GLDS(kbB + (size_t)t_ * 12288, kdB + (s) * KSLOT); } while (0)
#define DMA_V(t, s) do { const int t_ = (t) < NT ? (t) : NT - 1; GLDS(vbs + (size_t)t_ * 8192, vd + (s) * VSLOT); } while (0)
#define WAIT_BAR(N) do { asm volatile("s_waitcnt vmcnt(" #N ") lgkmcnt(0)" ::: "memory"); __builtin_amdgcn_s_barrier(); asm volatile("" ::: "memory"); } while (0)
    const LAS unsigned char* kp0 = lds + L_K + hi * 1024 + r32 * 16;
    const LAS unsigned char* vp0 = lds + L_V + ((lane >> 4) & 1) * 32 + (lane & 3) * 8 + (4 * hi + ((lane & 15) >> 2)) * 64;
    DMA_K(0, 0); DMA_V(0, 0); DMA_K(1, 1); DMA_V(1, 1);
    bf16x8 qa[6];
    const LAS unsigned char* qbp = lds + L_Q + wid * 6144 + hi * 512 + r32 * 16;
    { const bf16_t* Qw = Qb + (size_t)(wid * 64 + r32) * QC + hi * 8;
#pragma unroll
      for (int d0 = 0; d0 < 6; ++d0) { qa[d0] = *reinterpret_cast<const bf16x8*>(Qw + d0 * 16); const bf16x8 qv = *reinterpret_cast<const bf16x8*>(Qw + (size_t)32 * QC + d0 * 16);
          *(LAS bf16x8*)(lds + L_Q + wid * 6144 + hi * 512 + r32 * 16 + d0 * 1024) = qv; } }
    bf16x8 qb0, qb1, qb2, qb3, qb4, qb5;
    { const bf16_t* Qw = Qb + (size_t)(wid * 64 + 32 + r32) * QC + hi * 8; qb0 = *reinterpret_cast<const bf16x8*>(Qw); qb1 = *reinterpret_cast<const bf16x8*>(Qw + 16); qb2 = *reinterpret_cast<const bf16x8*>(Qw + 32); qb3 = *reinterpret_cast<const bf16x8*>(Qw + 48); qb4 = *reinterpret_cast<const bf16x8*>(Qw + 64); qb5 = *reinterpret_cast<const bf16x8*>(Qw + 80); }
    f32x16 oA0 = f32x16{}, oA1 = f32x16{}, oB0 = f32x16{}, oB1 = f32x16{};
    u32x4 pA0, pA1, pA2, pA3, pB0, pB1, pB2, pB3;
    float lA = 0.f, lB = 0.f;
    WAIT_BAR(0);
#define PKW(P, B) cvt_pk_bf16(P[B], P[B + 1])
#define PAF(w) __builtin_bit_cast(bf16x8, w)
#define EX4(X, B) do { X[B] = __builtin_amdgcn_exp2f(X[B]); X[B + 1] = __builtin_amdgcn_exp2f(X[B + 1]); X[B + 2] = __builtin_amdgcn_exp2f(X[B + 2]); X[B + 3] = __builtin_amdgcn_exp2f(X[B + 3]); } while (0)
#define EX16(X) do { EX4(X, 0); EX4(X, 4); EX4(X, 8); EX4(X, 12); } while (0)
#define SUM16(L, X) do { L += ((X[0] + X[1]) + (X[2] + X[3])) + ((X[4] + X[5]) + (X[6] + X[7])) + ((X[8] + X[9]) + (X[10] + X[11])) + ((X[12] + X[13]) + (X[14] + X[15])); } while (0)
#define PACK(W0, W1, X) do { W0 = (u32x4){PKW(X, 0), PKW(X, 2), PKW(X, 4), PKW(X, 6)}; W1 = (u32x4){PKW(X, 8), PKW(X, 10), PKW(X, 12), PKW(X, 14)}; } while (0)
#define KRD(d0) do { ka##d0 = *(const LAS bf16x8*)(kpn + (d0) * 2048); kb##d0 = *(const LAS bf16x8*)(kpn + (d0) * 2048 + 512); } while (0)
#define VRD(i) do { l##i = vtr(vp_ + (((i) >> 2) * 4096 + ((i) & 3) * 1024)); h##i = vtr(vp_ + (((i) >> 2) * 4096 + ((i) & 3) * 1024 + 512)); } while (0)
#define VFR(i) ((bf16x8){l##i[0], l##i[1], l##i[2], l##i[3], h##i[0], h##i[1], h##i[2], h##i[3]})
#define PV(vsl) do { const LAS unsigned char* vp_ = vp0 + (vsl) * VSLOT; s16x4 l0, h0, l1, h1, l2, h2, l3, h3, l4, h4, l5, h5, l6, h6, l7, h7; \
    VRD(0); VRD(4); VRD(1); __builtin_amdgcn_s_setprio(1); SBAR(); \
    oA0 = MF(PAF(pA0), VFR(0), oA0); oB0 = MF(PAF(pB0), VFR(0), oB0); VRD(5); SBAR(); \
    oA1 = MF(PAF(pA0), VFR(4), oA1); oB1 = MF(PAF(pB0), VFR(4), oB1); VRD(2); SBAR(); \
    oA0 = MF(PAF(pA1), VFR(1), oA0); oB0 = MF(PAF(pB1), VFR(1), oB0); VRD(6); SBAR(); \
    oA1 = MF(PAF(pA1), VFR(5), oA1); oB1 = MF(PAF(pB1), VFR(5), oB1); VRD(3); SBAR(); \
    oA0 = MF(PAF(pA2), VFR(2), oA0); oB0 = MF(PAF(pB2), VFR(2), oB0); VRD(7); SBAR(); \
    oA1 = MF(PAF(pA2), VFR(6), oA1); oB1 = MF(PAF(pB2), VFR(6), oB1); SBAR(); \
    oA0 = MF(PAF(pA3), VFR(3), oA0); oB0 = MF(PAF(pB3), VFR(3), oB0); SBAR(); \
    oA1 = MF(PAF(pA3), VFR(7), oA1); oB1 = MF(PAF(pB3), VFR(7), oB1); __builtin_amdgcn_s_setprio(0); SBAR(); } while (0)
#define STEP(t, ks, vs, HASP) do { \
    if (late && (HASP)) { PV(((vs) + 3) & 3); } \
    { const LAS unsigned char* kpn = kp0 + (ks) * KSLOT; bf16x8 ka0, kb0, ka1, kb1, ka2, kb2, ka3, kb3, ka4, kb4, ka5, kb5; \
      f32x16 sA0, sA1, sB0, sB1; const f32x16 z16 = f32x16{}; \
      KRD(0); KRD(1); __builtin_amdgcn_s_setprio(1); SBAR(); \
      sA0 = MF(ka0, qa[0], z16); sB0 = MF(ka0, qb0, z16); sA1 = MF(kb0, qa[0], z16); sB1 = MF(kb0, qb0, z16); KRD(2); SBAR(); \
      sA0 = MF(ka1, qa[1], sA0); sB0 = MF(ka1, qb1, sB0); sA1 = MF(kb1, qa[1], sA1); sB1 = MF(kb1, qb1, sB1); KRD(3); SBAR(); \
      sA0 = MF(ka2, qa[2], sA0); sB0 = MF(ka2, qb2, sB0); sA1 = MF(kb2, qa[2], sA1); sB1 = MF(kb2, qb2, sB1); KRD(4); SBAR(); \
      sA0 = MF(ka3, qa[3], sA0); sB0 = MF(ka3, qb3, sB0); sA1 = MF(kb3, qa[3], sA1); sB1 = MF(kb3, qb3, sB1); KRD(5); SBAR(); \
      sA0 = MF(ka4, qa[4], sA0); sB0 = MF(ka4, qb4, sB0); sA1 = MF(kb4, qa[4], sA1); sB1 = MF(kb4, qb4, sB1); SBAR(); \
      sA0 = MF(ka5, qa[5], sA0); sB0 = MF(ka5, qb5, sB0); sA1 = MF(kb5, qa[5], sA1); sB1 = MF(kb5, qb5, sB1); __builtin_amdgcn_s_setprio(0); SBAR(); \
      EX16(sA0); SUM16(lA, sA0); PACK(pA0, pA1, sA0); SBAR(); \
      EX16(sA1); SUM16(lA, sA1); PACK(pA2, pA3, sA1); SBAR(); \
      EX16(sB0); SUM16(lB, sB0); PACK(pB0, pB1, sB0); SBAR(); \
      EX16(sB1); SUM16(lB, sB1); PACK(pB2, pB3, sB1); SBAR(); } \
    if (!late) { PV(vs); } \
    DMA_V((t) + 2, ((vs) + 2) & 3); DMA_K((t) + 2, ((ks) == 0 ? 2 : (ks) - 1)); \
    WAIT_BAR(3); } while (0)
    int ks = 0, vs = 0;
#pragma unroll 1
    for (int t = 0; t < NT; ++t) {
        STEP(t, ks, vs, (t > 0));
        ks = (ks == 2) ? 0 : ks + 1; vs = (vs + 1) & 3;
    }
    if (late) { PV(3); }
    LAS bf16_t* stg = (LAS bf16_t*)(lds + L_OST) + wid * 2048;
#define OUT_BLOCK(O0, O1, L, blk) do { float l_ = (L); { auto rr = __builtin_amdgcn_permlane32_swap(__float_as_uint(l_), __float_as_uint(l_), false, false); l_ = __uint_as_float(rr[0]) + __uint_as_float(rr[1]); } \
    if (hi == 0) wsf[r32] = l_; \
    asm volatile("s_waitcnt lgkmcnt(0)" ::: "memory"); \
    _Pragma("unroll") for (int r = 0; r < 16; ++r) { const int orow = crow(r, hi); const float rl = __builtin_amdgcn_rcpf(wsf[orow]); \
        stg[orow * 64 + r32] = (bf16_t)(cvt_pk_bf16(O0[r] * rl, 0.f) & 0xffffu); stg[orow * 64 + 32 + r32] = (bf16_t)(cvt_pk_bf16(O1[r] * rl, 0.f) & 0xffffu); } \
    asm volatile("s_waitcnt lgkmcnt(0)" ::: "memory"); \
    { bf16_t* Ow = Ob + (size_t)(wid * 64 + (blk) * 32) * 512; \
      _Pragma("unroll") for (int i = 0; i < 4; ++i) { const int row = i * 8 + (lane >> 3), ch = lane & 7; const u32x4 v = *(const LAS u32x4*)(stg + row * 64 + ch * 8); *(u32x4*)(Ow + (size_t)row * 512 + ch * 8) = v; } } \
    asm volatile("s_waitcnt lgkmcnt(0)" ::: "memory"); } while (0)
    OUT_BLOCK(oA0, oA1, lA, 0);
    OUT_BLOCK(oB0, oB1, lB, 1);
    WAIT_BAR(0);
#undef GLDS
#undef DMA_K
#undef DMA_V
#undef WAIT_BAR
#undef PKW
#undef PAF
#undef EX16
#undef EX4
#undef SUM16
#undef PACK
#undef KRD
#undef VRD
#undef VFR
#undef PV
#undef STEP
#undef OUT_BLOCK
}
#undef SBAR
#undef MF
}

struct Args { const float* in[27]; float* out; unsigned char* ws; int ph_lo, ph_hi, li, pad; };
struct Frame {
    LAS unsigned char* lds; int tid, lane, wave, vcu, G;
};
__device__ __forceinline__ unsigned f2bf(float f) { unsigned u = __builtin_bit_cast(unsigned, f); return (u + 0x7fffu + ((u >> 16) & 1u)) >> 16; }
__device__ __forceinline__ unsigned pk2(float lo, float hi) { return f2bf(lo) | (f2bf(hi) << 16); }

__device__ __forceinline__ float wave_max(float v) {
#pragma unroll
    for (int o = 1; o < 64; o <<= 1) v = fmaxf(v, __shfl_xor(v, o));
    return v;
}
template <class RM>
__device__ __forceinline__ void tr_item(const float* __restrict__ W, int ldw, int k0, int n0, const float* __restrict__ kscale, bf16_t* WT, int Kdst, const RM& rm, LAS float* scr, int lane, unsigned* wmaxp = nullptr) {
    float amax = 0.f;
#pragma unroll 8
    for (int i = 0; i < 32; ++i) { const int kk = 2 * i + (lane >> 5); float v = W[(size_t)(k0 + kk) * ldw + n0 + (lane & 31)]; if (kscale) v *= kscale[k0 + kk]; scr[kk * 33 + (lane & 31)] = v; amax = fmaxf(amax, fabsf(v)); }
    if (wmaxp) { amax = wave_max(amax); if (lane == 0) atomicMax(wmaxp, __float_as_uint(amax)); }
    LDS_WAIT(); asm volatile("" ::: "memory");
    const int c = lane & 7;
#pragma unroll
    for (int j = 0; j < 4; ++j) { const int n = (lane >> 3) + 8 * j; const LAS float* s = scr + (8 * c) * 33 + n;
        u32x4 o; o.x = pk2(s[0 * 33], s[1 * 33]); o.y = pk2(s[2 * 33], s[3 * 33]); o.z = pk2(s[4 * 33], s[5 * 33]); o.w = pk2(s[6 * 33], s[7 * 33]);
        *(u32x4*)(WT + (size_t)rm(n0 + n) * Kdst + k0 + 8 * c) = o; }
    LDS_WAIT(); asm volatile("" ::: "memory");
}
__device__ __forceinline__ int rope_pos(int i) { return 8 * ((i & 15) >> 2) + 4 * (i >> 4) + (i & 3); }
struct RmIdent { int off; __device__ __forceinline__ int operator()(int n) const { return n + off; } };
struct RmWin { __device__ __forceinline__ int operator()(int n) const { return n < 512 ? n : (n < 544 ? 2560 + rope_pos(n - 512) : 512 + (n - 1056)); } };
struct RmUq { __device__ __forceinline__ int operator()(int n) const { const int h = n / 96, d = n - 96 * h; return d < 64 ? n : 96 * h + 64 + rope_pos(d - 64); } };
struct RmGu { int up; __device__ __forceinline__ int operator()(int hh) const { return 256 * (hh >> 7) + 128 * ((hh >> 2) & 1) + 32 * ((hh >> 5) & 3) + 8 * ((hh >> 3) & 3) + (hh & 3) + 4 * up; } };

__device__ const double INVF[16] = {1.0, 0.5623413251903491, 0.31622776601683794, 0.1778279410038923, 0.1, 0.05623413251903491, 0.03162277660168379, 0.01778279410038923,
    0.01, 0.005623413251903491, 0.0031622776601683794, 0.0017782794100389228, 0.001, 0.0005623413251903491, 0.00031622776601683794, 0.00017782794100389227};

__device__ __forceinline__ void p0_prologue(const Frame& F, const Args& a) {
    unsigned char* ws = a.ws; unsigned* WMAX = (unsigned*)((gu32*)(ws + WS_CTL) + CW_WMAX);
    {
        LAS float* cact = (LAS float*)(F.lds);
        LAS float* red = (LAS float*)(F.lds + 32768);
        float* MODF = (float*)(ws + WS_MODF);
        const float* c = a.in[1];
        for (int i = F.tid; i < 8192; i += 512) { const int b = i >> 10, k = i & 1023; const float v = c[i]; cact[k * 8 + b] = v * sigmoidf_(v); }
        __syncthreads();
        for (int it = blockIdx.x; it < 128; it += F.G) {
            const int n = it * 64 + F.lane, kg = F.wave;
            const float* W = (n < 6144) ? (a.in[3] + n) : (a.in[24] + (n - 6144)); const int ldw = (n < 6144) ? 6144 : 2048;
            float acc[8];
#pragma unroll
            for (int b = 0; b < 8; ++b) acc[b] = 0.f;
#pragma unroll 8
            for (int k = kg * 128; k < kg * 128 + 128; ++k) { const float w = W[(size_t)k * ldw]; const f32x4 c0 = *(const LAS f32x4*)(cact + k * 8), c1 = *(const LAS f32x4*)(cact + k * 8 + 4);
                acc[0] += c0[0] * w; acc[1] += c0[1] * w; acc[2] += c0[2] * w; acc[3] += c0[3] * w; acc[4] += c1[0] * w; acc[5] += c1[1] * w; acc[6] += c1[2] * w; acc[7] += c1[3] * w; }
#pragma unroll
            for (int b = 0; b < 8; ++b) red[(kg * 8 + b) * 64 + F.lane] = acc[b];
            __syncthreads();
            { const int b = F.tid >> 6, cl = F.tid & 63, nn = it * 64 + cl; float s = 0.f;
#pragma unroll
              for (int q = 0; q < 8; ++q) s += red[(q * 8 + b) * 64 + cl];
              MODF[b * 8192 + nn] = s + (nn < 6144 ? a.in[4][nn] : a.in[25][nn - 6144]); }
            __syncthreads();
        }
        __syncthreads();
    }
    LAS float* scr = (LAS float*)(F.lds + F.wave * 16384);
    const int gw = F.vcu * NWAVES + F.wave, NGW = F.G * NWAVES;
    bf16_t* WIN = (bf16_t*)(ws + WS_WIN); bf16_t* WFY = (bf16_t*)(ws + WS_WFY); bf16_t* WUQ = (bf16_t*)(ws + WS_WUQ); bf16_t* WUKV = (bf16_t*)(ws + WS_WUKV);
    bf16_t* WBA = (bf16_t*)(ws + WS_WBA); bf16_t* WBF = (bf16_t*)(ws + WS_WBF); bf16_t* WOUT = (bf16_t*)(ws + WS_WOUT);
    bf16_t* WGU = (bf16_t*)(ws + WS_WGU); bf16_t* WDN = (bf16_t*)(ws + WS_WDN);
    constexpr int I_WIN = 81 * 16, I_UQ = 24 * 4, I_UK = 16 * 4, I_UV = 16 * 4, I_BA = 32 * 8, I_BF = 32 * 8, I_OUT = 32 * 16, I_G = 32 * 8 * 16, I_U = I_G, I_D = 32 * 32 * 4;
    constexpr int I_FY = 16 * 8 * 4;
    constexpr int NITEMS = I_WIN + I_UQ + I_UK + I_UV + I_BA + I_BF + I_OUT + I_G + I_U + I_D + I_FY;
    for (int it = gw; it < NITEMS; it += NGW) {
        int r = it;
        if (r < I_WIN) { const int kb = r / 81, nbi = r % 81; const int n0 = nbi < 17 ? nbi * 32 : 1056 + (nbi - 17) * 32;
            tr_item(a.in[6], 3104, kb * 64, n0, nullptr, WIN, 1024, RmWin{}, scr, F.lane, WMAX + 0); continue; } r -= I_WIN;
        if (r < I_UQ) { tr_item(a.in[9], 768, (r / 24) * 64, (r % 24) * 32, a.in[7], WUQ, 256, RmUq{}, scr, F.lane); continue; } r -= I_UQ;
        if (r < I_UK) { tr_item(a.in[10], 512, (r / 16) * 64, (r % 16) * 32, a.in[8], WUKV, 256, RmIdent{0}, scr, F.lane); continue; } r -= I_UK;
        if (r < I_UV) { tr_item(a.in[11], 512, (r / 16) * 64, (r % 16) * 32, a.in[8], WUKV, 256, RmIdent{512}, scr, F.lane); continue; } r -= I_UV;
        if (r < I_BA) { tr_item(a.in[12], 1024, (r / 32) * 64, (r % 32) * 32, nullptr, WBA, 1024, RmIdent{0}, scr, F.lane); continue; } r -= I_BA;
        if (r < I_BF) { tr_item(a.in[13], 1024, (r / 32) * 64, (r % 32) * 32, nullptr, WBA + 512, 1024, RmIdent{0}, scr, F.lane); continue; } r -= I_BF;
        if (r < I_OUT) { tr_item(a.in[15], 1024, (r / 32) * 64, (r % 32) * 32, nullptr, WOUT, 1024, RmIdent{0}, scr, F.lane); continue; } r -= I_OUT;
        if (r < I_G) { const int e = r / 128, q = r % 128; tr_item(a.in[21] + (size_t)e * 1024 * 256, 256, (q / 8) * 64, (q % 8) * 32, nullptr, WGU + (size_t)e * 512 * 1024, 1024, RmGu{0}, scr, F.lane, WMAX + 2 + e); continue; } r -= I_G;
        if (r < I_U) { const int e = r / 128, q = r % 128; tr_item(a.in[22] + (size_t)e * 1024 * 256, 256, (q / 8) * 64, (q % 8) * 32, nullptr, WGU + (size_t)e * 512 * 1024, 1024, RmGu{1}, scr, F.lane, WMAX + 2 + e); continue; } r -= I_U;
        if (r < I_D) { const int e = r / 128, q = r % 128; tr_item(a.in[23] + (size_t)e * 256 * 1024, 1024, (q / 32) * 64, (q % 32) * 32, nullptr, WDN + (size_t)e * 1024 * 256, 256, RmIdent{0}, scr, F.lane); continue; } r -= I_D;
        {
            const int kb = r >> 5, g = (r >> 2) & 7, jq = r & 3;
            const float* W = a.in[6] + (size_t)(kb * 64) * 3104 + 544 + 64 * g;
#pragma unroll 8
            for (int kk = 0; kk < 64; ++kk) scr[F.lane * 64 + kk] = W[(size_t)kk * 3104 + F.lane];
            LDS_WAIT(); asm volatile("" ::: "memory");
            float ar[16], ai_[16];
#pragma unroll
            for (int j = 0; j < 16; ++j) { ar[j] = 0.f; ai_[j] = 0.f; }
#pragma unroll 2
            for (int cI = 0; cI < 64; ++cI) { const float xv = scr[cI * 64 + F.lane];
#pragma unroll
                for (int j = 0; j < 16; ++j) { const float ph = (float)((cI * (jq * 16 + j)) & 63) * (1.0f / 64.0f);
                    ar[j] += xv * __builtin_amdgcn_cosf(ph); ai_[j] -= xv * __builtin_amdgcn_sinf(ph); } }
            float amax = 0.f;
#pragma unroll
            for (int j = 0; j < 16; ++j) { const int jj = jq * 16 + j; amax = fmaxf(amax, fmaxf(fabsf(ar[j]), fabsf(ai_[j])) * FNORM);
                WFY[(size_t)(g * 64 + jj) * 1024 + kb * 64 + F.lane] = (bf16_t)f2bf(ar[j] * FNORM);
                WFY[(size_t)(512 + g * 64 + jj) * 1024 + kb * 64 + F.lane] = (bf16_t)f2bf(ai_[j] * FNORM); }
            amax = wave_max(amax); if (F.lane == 0) atomicMax(WMAX + 1, __float_as_uint(amax));
            LDS_WAIT(); asm volatile("" ::: "memory");
        }
    }
    const int gt = F.vcu * 512 + F.tid, NGT = F.G * 512;
    { float* RC = (float*)(ws + WS_ROPEC); float* RS = (float*)(ws + WS_ROPES); const int* pos = (const int*)a.in[2];
        for (int i = gt; i < T * 16; i += NGT) { const int t = i >> 4, f = i & 15; const double rev = (double)pos[t] * INVF[f] * 0.15915494309189535; const float fr = (float)(rev - __builtin_floor(rev));
            RC[i] = __builtin_amdgcn_cosf(fr); RS[i] = __builtin_amdgcn_sinf(fr); } }
    { bf16_t* DFTA = (bf16_t*)(ws + WS_DFTA);
        for (int i = gt; i < 256 * 256; i += NGT) { const int r = i >> 8, cI = i & 255; const int rip = r >> 7, kb = r & 127, ri = cI >> 7, sb = cI & 127;
            const float ph = (float)((sb * kb) & 127) * (1.0f / 128.0f); const float cs = __builtin_amdgcn_cosf(ph), sn = __builtin_amdgcn_sinf(ph);
            const float v = (rip == ri) ? cs : (rip == 0 ? sn : -sn); DFTA[i] = (bf16_t)f2bf(v); } }
    { bf16_t* TB2 = (bf16_t*)(ws + WS_TB2);
        for (int i = gt; i < 64 * 128 * 256; i += NGT) { const int pair = i >> 15, r = (i >> 8) & 127, cI = i & 255; const int kbp = r >> 6, ka = r & 63, kbpp = cI >> 7, ri = (cI >> 6) & 1, sa = cI & 63;
            const int kbb = 2 * pair + kbp; const float ph = (float)((sa * (kbb + 128 * ka)) & 8191) * (1.0f / 8192.0f);
            const float v = (kbp == kbpp) ? (ri ? __builtin_amdgcn_sinf(ph) : __builtin_amdgcn_cosf(ph)) : 0.f; TB2[i] = (bf16_t)f2bf(v); } }
}

__device__ __forceinline__ unsigned q8s(float v) { return (unsigned)(int)fminf(fmaxf(__builtin_rintf(v), -127.f), 127.f) & 0xffu; }
__device__ __forceinline__ void p1_norm(const Frame& F, const Args& a) {
    unsigned char* ws = a.ws; const float* MODF = (const float*)(ws + WS_MODF);
    const unsigned* WMAX = (const unsigned*)((gu32*)(ws + WS_CTL) + CW_WMAX);
    {
        const bf16_t* WIN = (const bf16_t*)(ws + WS_WIN); const bf16_t* WFY = (const bf16_t*)(ws + WS_WFY); const bf16_t* WGU = (const bf16_t*)(ws + WS_WGU);
        u32x2* W8IN = (u32x2*)(ws + WS_W8IN); u32x2* W8FY = (u32x2*)(ws + WS_W8FY); u32x2* W8GU = (u32x2*)(ws + WS_W8GU);
        constexpr int C_IN = NWIN * 1024 / 8, C_FY = 1024 * 1024 / 8, C_GU = 32 * 512 * 1024 / 8;
        const int gt = F.vcu * 512 + F.tid, NGT = F.G * 512;
        for (int i = gt; i < C_IN + C_FY + C_GU; i += NGT) {
            const bf16_t* src; u32x2* dst; float wm;
            if (i < C_IN) { src = WIN + (size_t)i * 8; dst = W8IN + i; wm = __uint_as_float(WMAX[0]); }
            else if (i < C_IN + C_FY) { const int j = i - C_IN; src = WFY + (size_t)j * 8; dst = W8FY + j; wm = __uint_as_float(WMAX[1]); }
            else { const int j = i - C_IN - C_FY; src = WGU + (size_t)j * 8; dst = W8GU + j; wm = __uint_as_float(WMAX[2 + (j >> 16)]); }
            const float inv = wm > 0.f ? 127.0f / wm : 0.f;
            const u32x4 w = *(const u32x4*)src;
            u32x2 o;
            o.x = q8s(bf_lo(w.x) * inv) | (q8s(bf_hi(w.x) * inv) << 8) | (q8s(bf_lo(w.y) * inv) << 16) | (q8s(bf_hi(w.y) * inv) << 24);
            o.y = q8s(bf_lo(w.z) * inv) | (q8s(bf_hi(w.z) * inv) << 8) | (q8s(bf_lo(w.w) * inv) << 16) | (q8s(bf_hi(w.w) * inv) << 24);
            *dst = o; }
    }
    const float* x = a.in[0]; const float* g = a.in[5]; unsigned char* U8 = (unsigned char*)(ws + WS_R1); float* SU = (float*)(ws + WS_SU);
    const int gw = F.vcu * NWAVES + F.wave, NGW = F.G * NWAVES;
    for (int ch = gw; ch < T / 32; ch += NGW) {
        const int b = (ch * 32) >> 13;
        f32x4 Gv[4], Sv[4];
#pragma unroll
        for (int j = 0; j < 4; ++j) { const int k = 4 * F.lane + 256 * j; Gv[j] = *(const f32x4*)(g + k) * (*(const f32x4*)(MODF + b * 8192 + 1024 + k) + 1.0f); Sv[j] = *(const f32x4*)(MODF + b * 8192 + k); }
#pragma unroll 2
        for (int rr = 0; rr < 32; ++rr) { const size_t row = (size_t)ch * 32 + rr; const f32x4* xr = (const f32x4*)(x + row * 1024) + F.lane;
            f32x4 v[4]; float s = 0.f;
#pragma unroll
            for (int j = 0; j < 4; ++j) { v[j] = xr[64 * j]; s += (v[j][0] * v[j][0] + v[j][1] * v[j][1]) + (v[j][2] * v[j][2] + v[j][3] * v[j][3]); }
            const float rs = __builtin_amdgcn_rsqf(wave_sum(s) * (1.0f / 1024.0f) + EPS);
            float am = 0.f;
#pragma unroll
            for (int j = 0; j < 4; ++j) { v[j] = v[j] * rs * Gv[j] + Sv[j]; am = fmaxf(am, fmaxf(fmaxf(fabsf(v[j][0]), fabsf(v[j][1])), fmaxf(fabsf(v[j][2]), fabsf(v[j][3])))); }
            am = wave_max(am); const float inv = am > 0.f ? 127.0f / am : 0.f;
            unsigned* o4 = (unsigned*)(U8 + row * 1024) + F.lane;
#pragma unroll
            for (int j = 0; j < 4; ++j) o4[64 * j] = q8s(v[j][0] * inv) | (q8s(v[j][1] * inv) << 8) | (q8s(v[j][2] * inv) << 16) | (q8s(v[j][3] * inv) << 24);
            if (F.lane == 0) SU[row] = am * (1.0f / 127.0f); }
    }
}

__device__ __forceinline__ float wave_sum_dpp(float v) {
    int x = __float_as_int(v);
    x = __float_as_int(__int_as_float(x) + __int_as_float(__builtin_amdgcn_update_dpp(0, x, 0xB1, 0xF, 0xF, true)));
    x = __float_as_int(__int_as_float(x) + __int_as_float(__builtin_amdgcn_update_dpp(0, x, 0x4E, 0xF, 0xF, true)));
    x = __float_as_int(__int_as_float(x) + __int_as_float(__builtin_amdgcn_update_dpp(0, x, 0x141, 0xF, 0xF, true)));
    x = __float_as_int(__int_as_float(x) + __int_as_float(__builtin_amdgcn_update_dpp(0, x, 0x140, 0xF, 0xF, true)));
    x = __float_as_int(__int_as_float(x) + __int_as_float(__builtin_amdgcn_update_dpp(0, x, 0x142, 0xA, 0xF, false)));
    x = __float_as_int(__int_as_float(x) + __int_as_float(__builtin_amdgcn_update_dpp(0, x, 0x143, 0xC, 0xF, false)));
    return __int_as_float(__builtin_amdgcn_readlane(x, 63));
}
constexpr int RT_WPH = 0, RT_WPL = 74304, RT_LCNT = 148608, RT_LBASE = RT_LCNT + 128, RT_INFO = RT_LBASE + 128, RT_CVEC = RT_INFO + 4096, RT_STG = RT_CVEC + 256;
__device__ __forceinline__ int wp_off(int n, int k) { return n * 2064 + k * 2; }
__device__ __forceinline__ void p7_route(const Frame& F, const Args& a) {
    unsigned char* ws = a.ws; gu32* ctl = (gu32*)(ws + WS_CTL);
    const bf16_t* H = (const bf16_t*)(ws + WS_YT2); const float* MODF = (const float*)(ws + WS_MODF); const float* g = a.in[16];
    unsigned char* VM8 = (unsigned char*)(ws + WS_R1); u32x2* LIST = (u32x2*)(ws + WS_LIST); u32x4* TOKINFO = (u32x4*)(ws + WS_ROUTEW);
    LAS int* lcnt = (LAS int*)(F.lds + RT_LCNT); LAS int* lbase = (LAS int*)(F.lds + RT_LBASE); LAS unsigned* info = (LAS unsigned*)(F.lds + RT_INFO); LAS float* winfo = (LAS float*)(F.lds + RT_INFO + 1024); LAS float* sinfo = (LAS float*)(F.lds + RT_INFO + 3072);
    LAS float* cvec = (LAS float*)(F.lds + RT_CVEC); LAS float* stg = (LAS float*)(F.lds + RT_STG + F.wave * 1152);
    const int l16 = F.lane & 15, fq = F.lane >> 4;
    int wb = -1;
    for (int ch = F.vcu; ch < T / 256; ch += F.G) {
        const int b = (ch * 256) >> 13;
        if (b != wb) {
            __syncthreads();
            const float* Gm = MODF + b * 8192 + 4096; const float* Sm = MODF + b * 8192 + 3072;
            float pg = 0.f, pe = 0.f;
            for (int i = F.tid; i < 1024 * 4; i += 512) { const int k = i >> 2, n = i & 3; const float w0 = a.in[17][i]; pg += Sm[k] * w0; const float w = w0 * (g[k] * (Gm[k] + 1.0f)); const unsigned h16 = f2bf(w);
                *(LAS unsigned short*)(F.lds + RT_WPH + wp_off(n, k)) = (unsigned short)h16; *(LAS unsigned short*)(F.lds + RT_WPL + wp_off(n, k)) = (unsigned short)f2bf(w - __uint_as_float(h16 << 16)); }
            for (int i = F.tid; i < 1024 * 32; i += 512) { const int k = i >> 5, n = 4 + (i & 31); const float w0 = a.in[19][i]; pe += Sm[k] * w0; const float w = w0 * (g[k] * (Gm[k] + 1.0f)); const unsigned h16 = f2bf(w);
                *(LAS unsigned short*)(F.lds + RT_WPH + wp_off(n, k)) = (unsigned short)h16; *(LAS unsigned short*)(F.lds + RT_WPL + wp_off(n, k)) = (unsigned short)f2bf(w - __uint_as_float(h16 << 16)); }
            { LAS float* part = (LAS float*)(F.lds + RT_STG);
              part[(F.tid & 3) * 128 + (F.tid >> 2)] = pg; part[512 + (F.tid & 31) * 16 + (F.tid >> 5)] = pe;
              __syncthreads();
              if (F.tid < 36) { float d = 0.f;
                  if (F.tid < 4) { for (int j = 0; j < 128; ++j) d += part[F.tid * 128 + j]; d += a.in[18][F.tid]; }
                  else { for (int j = 0; j < 16; ++j) d += part[512 + (F.tid - 4) * 16 + j]; d += a.in[20][F.tid - 4]; }
                  cvec[F.tid] = d; } }
            wb = b;
        }
        if (F.tid < 32) lcnt[F.tid] = 0;
        __syncthreads();
        f32x4 Gv[4], Sv[4];
#pragma unroll
        for (int j = 0; j < 4; ++j) { const int k = 4 * F.lane + 256 * j; Gv[j] = *(const f32x4*)(g + k) * (*(const f32x4*)(MODF + b * 8192 + 4096 + k) + 1.0f); Sv[j] = *(const f32x4*)(MODF + b * 8192 + 3072 + k); }
#pragma unroll 1
        for (int bi = 0; bi < 2; ++bi) {
            const size_t R0 = (size_t)ch * 256 + F.wave * 32 + bi * 16;
            f32x4 acc0 = f32x4{}, acc1 = f32x4{}, acc2 = f32x4{};
            { const bf16_t* hp = H + (R0 + l16) * 1024 + fq * 8;
              const int n0 = l16, n1 = 16 + l16, n2 = (32 + l16) < 36 ? 32 + l16 : 35;
              bf16x8 av[2][8];
#pragma unroll
              for (int i = 0; i < 8; ++i) av[0][i] = *reinterpret_cast<const bf16x8*>(hp + i * 32);
#pragma unroll
              for (int kb = 0; kb < 4; ++kb) {
                  if (kb < 3) {
#pragma unroll
                      for (int i = 0; i < 8; ++i) av[(kb + 1) & 1][i] = *reinterpret_cast<const bf16x8*>(hp + ((kb + 1) * 8 + i) * 32); }
#pragma unroll
                  for (int i = 0; i < 8; ++i) { const int k = (kb * 8 + i) * 32 + fq * 8; const bf16x8 af = av[kb & 1][i];
                      const bf16x8 h0 = *(const LAS bf16x8*)(F.lds + RT_WPH + wp_off(n0, k)), h1 = *(const LAS bf16x8*)(F.lds + RT_WPH + wp_off(n1, k)), h2 = *(const LAS bf16x8*)(F.lds + RT_WPH + wp_off(n2, k));
                      const bf16x8 e0 = *(const LAS bf16x8*)(F.lds + RT_WPL + wp_off(n0, k)), e1 = *(const LAS bf16x8*)(F.lds + RT_WPL + wp_off(n1, k)), e2 = *(const LAS bf16x8*)(F.lds + RT_WPL + wp_off(n2, k));
                      acc0 = __builtin_amdgcn_mfma_f32_16x16x32_bf16(af, h0, acc0, 0, 0, 0); acc1 = __builtin_amdgcn_mfma_f32_16x16x32_bf16(af, h1, acc1, 0, 0, 0); acc2 = __builtin_amdgcn_mfma_f32_16x16x32_bf16(af, h2, acc2, 0, 0, 0);
                      acc0 = __builtin_amdgcn_mfma_f32_16x16x32_bf16(af, e0, acc0, 0, 0, 0); acc1 = __builtin_amdgcn_mfma_f32_16x16x32_bf16(af, e1, acc1, 0, 0, 0); acc2 = __builtin_amdgcn_mfma_f32_16x16x32_bf16(af, e2, acc2, 0, 0, 0); } }
            }
            u32x2 hn[4];
            { const u32x2* hr = (const u32x2*)(H + R0 * 1024) + F.lane;
#pragma unroll
              for (int j = 0; j < 4; ++j) hn[j] = hr[64 * j]; }
#pragma unroll 1
            for (int half = 0; half < 2; ++half) {
                if ((fq >> 1) == half) {
#pragma unroll
                    for (int r = 0; r < 4; ++r) { const int rl = (fq & 1) * 4 + r; stg[rl * 36 + l16] = acc0[r]; stg[rl * 36 + 16 + l16] = acc1[r]; if (l16 < 4) stg[rl * 36 + 32 + l16] = acc2[r]; } }
                LDS_WAIT(); asm volatile("" ::: "memory");
#pragma unroll 4
                for (int rr = 0; rr < 8; ++rr) { const int lr = F.wave * 32 + bi * 16 + half * 8 + rr; const size_t row = (size_t)ch * 256 + lr;
                    f32x4 v[4]; float s = 0.f;
                    u32x2 hc[4];
#pragma unroll
                    for (int j = 0; j < 4; ++j) hc[j] = hn[j];
                    { const u32x2* hr = (const u32x2*)(H + (row + ((half * 8 + rr) < 15 ? 1 : 0)) * 1024) + F.lane;
#pragma unroll
                      for (int j = 0; j < 4; ++j) hn[j] = hr[64 * j]; }
#pragma unroll
                    for (int j = 0; j < 4; ++j) { const u32x2 hw = hc[j]; v[j] = (f32x4){bf_lo(hw.x), bf_hi(hw.x), bf_lo(hw.y), bf_hi(hw.y)}; s += (v[j][0] * v[j][0] + v[j][1] * v[j][1]) + (v[j][2] * v[j][2] + v[j][3] * v[j][3]); }
                    const float rs = __builtin_amdgcn_rsqf(wave_sum_dpp(s) * (1.0f / 1024.0f) + EPS);
                    float am = 0.f;
#pragma unroll
                    for (int j = 0; j < 4; ++j) { v[j] = v[j] * rs * Gv[j] + Sv[j]; am = fmaxf(am, fmaxf(fmaxf(fabsf(v[j][0]), fabsf(v[j][1])), fmaxf(fabsf(v[j][2]), fabsf(v[j][3])))); }
                    am = wave_max(am); const float inv = am > 0.f ? 127.0f / am : 0.f;
                    { unsigned* o4 = (unsigned*)(VM8 + row * 1024) + F.lane;
#pragma unroll
                      for (int j = 0; j < 4; ++j) o4[64 * j] = q8s(v[j][0] * inv) | (q8s(v[j][1] * inv) << 8) | (q8s(v[j][2] * inv) << 16) | (q8s(v[j][3] * inv) << 24); }
                    const f32x4 graw = *(const LAS f32x4*)(stg + rr * 36), gc = *(const LAS f32x4*)cvec;
                    float gl[4];
#pragma unroll
                    for (int q = 0; q < 4; ++q) gl[q] = graw[q] * rs + gc[q];
                    int gs = 0; float gm = gl[0];
#pragma unroll
                    for (int q = 1; q < 4; ++q) if (gl[q] > gm) { gm = gl[q]; gs = q; }
                    gs = __builtin_amdgcn_readfirstlane(gs);
                    float gden = 0.f;
#pragma unroll
                    for (int q = 0; q < 4; ++q) gden += __expf(gl[q] - gm);
                    const float gp = 1.0f / gden;
                    const f32x4 er0 = *(const LAS f32x4*)(stg + rr * 36 + 4 + gs * 8), er1 = *(const LAS f32x4*)(stg + rr * 36 + 8 + gs * 8), ec0 = *(const LAS f32x4*)(cvec + 4 + gs * 8), ec1 = *(const LAS f32x4*)(cvec + 8 + gs * 8);
                    float b0 = -3.0e38f, b1 = -3.0e38f; int i0 = 0, i1 = 0;
#pragma unroll
                    for (int e = 0; e < 8; ++e) { const float el = (e < 4 ? er0[e & 3] : er1[e & 3]) * rs + (e < 4 ? ec0[e & 3] : ec1[e & 3]);
                        if (el > b0) { b1 = b0; i1 = i0; b0 = el; i0 = e; } else if (el > b1) { b1 = el; i1 = e; } }
                    const float w0 = 1.0f / (1.0f + __expf(b1 - b0)), w1 = 1.0f - w0;
                    if (F.lane == 0) { const int e0 = gs * 8 + i0, e1 = gs * 8 + i1;
                        const int rk0 = __hip_atomic_fetch_add(lcnt + e0, 1, __ATOMIC_RELAXED, __HIP_MEMORY_SCOPE_WORKGROUP);
                        const int rk1 = __hip_atomic_fetch_add(lcnt + e1, 1, __ATOMIC_RELAXED, __HIP_MEMORY_SCOPE_WORKGROUP);
                        info[lr] = (unsigned)e0 | ((unsigned)e1 << 5) | ((unsigned)rk0 << 10) | ((unsigned)rk1 << 20);
                        winfo[2 * lr] = gp * w0; winfo[2 * lr + 1] = gp * w1; sinfo[lr] = am * (1.0f / 127.0f); }
                }
                LDS_WAIT(); asm volatile("" ::: "memory");
            }
        }
        __syncthreads();
        if (F.tid < 32) lbase[F.tid] = (int)__hip_atomic_fetch_add((unsigned*)(ctl + CW_CNT) + F.tid, (unsigned)lcnt[F.tid], __ATOMIC_RELAXED, __HIP_MEMORY_SCOPE_AGENT);
        __syncthreads();
        if (F.tid < 256) { const unsigned w = info[F.tid]; const int e0 = w & 31, e1 = (w >> 5) & 31, rk0 = (w >> 10) & 1023, rk1 = (w >> 20) & 1023; const int t = ch * 256 + F.tid;
            const int p0 = lbase[e0] + rk0, p1 = lbase[e1] + rk1;
            const unsigned sb_ = __float_as_uint(sinfo[F.tid]);
            LIST[(size_t)e0 * 65536 + p0] = (u32x2){(unsigned)t, sb_}; LIST[(size_t)e1 * 65536 + p1] = (u32x2){(unsigned)t, sb_};
            TOKINFO[t] = (u32x4){((unsigned)e0 << 16) | (unsigned)p0, ((unsigned)e1 << 16) | (unsigned)p1, __float_as_uint(winfo[2 * F.tid]), __float_as_uint(winfo[2 * F.tid + 1])}; }
        __syncthreads();
    }
}

__device__ __forceinline__ void p10_final(const Frame& F, const Args& a) {
    unsigned char* ws = a.ws; const float* MODF = (const float*)(ws + WS_MODF); const float* g = a.in[26];
    const bf16_t* Y2 = (const bf16_t*)(ws + WS_GATE); const bf16_t* H = (const bf16_t*)(ws + WS_YT2); float* out = a.out; const u32x4* TOKINFO = (const u32x4*)(ws + WS_ROUTEW);
    LAS int* tst = (LAS int*)(F.lds + MISC_OFF + 256);
    { gu32* ctl = (gu32*)(ws + WS_CTL); LAS int* cntl = (LAS int*)(F.lds + MISC_OFF + 64);
      if (F.tid < 32) cntl[F.tid] = (int)__hip_atomic_load((unsigned*)(ctl + CW_CNT) + F.tid, __ATOMIC_RELAXED, __HIP_MEMORY_SCOPE_AGENT);
      __syncthreads();
      if (F.tid == 0) { int sacc = 0; for (int e = 0; e < 32; ++e) { tst[e] = sacc; sacc += (cntl[e] + 255) >> 8; } tst[32] = sacc; }
      __syncthreads(); }
    const int gw = F.vcu * NWAVES + F.wave, NGW = F.G * NWAVES;
    for (int ch = gw; ch < T / 32; ch += NGW) {
        const int b = (ch * 32) >> 13;
        f32x4 Gv[4], Sv[4], Tv[4];
#pragma unroll
        for (int j = 0; j < 4; ++j) { const int k = 4 * F.lane + 256 * j; Gv[j] = *(const f32x4*)(g + k) * (*(const f32x4*)(MODF + b * 8192 + 6144 + 1024 + k) + 1.0f); Sv[j] = *(const f32x4*)(MODF + b * 8192 + 6144 + k); Tv[j] = *(const f32x4*)(MODF + b * 8192 + 5120 + k); }
        unsigned my_r0, my_r1, my_w0, my_w1;
        { const u32x4 ti = TOKINFO[(size_t)ch * 32 + (F.lane & 31)];
          my_r0 = (unsigned)tst[ti.x >> 16] * 256u + (ti.x & 0xffffu); my_r1 = (unsigned)tst[ti.y >> 16] * 256u + (ti.y & 0xffffu); my_w0 = ti.z; my_w1 = ti.w; }
#pragma unroll 4
        for (int rr = 0; rr < 32; ++rr) { const size_t row = (size_t)ch * 32 + rr; f32x4* hr = (f32x4*)(out + row * 1024) + F.lane; const u32x2* hb = (const u32x2*)(H + row * 1024) + F.lane;
            const size_t r0 = (size_t)__builtin_amdgcn_readlane(my_r0, rr), r1 = (size_t)__builtin_amdgcn_readlane(my_r1, rr);
            const float w0 = __uint_as_float(__builtin_amdgcn_readlane(my_w0, rr)), w1 = __uint_as_float(__builtin_amdgcn_readlane(my_w1, rr));
            const u32x2* y0 = (const u32x2*)(Y2 + r0 * 1024) + F.lane; const u32x2* y1 = (const u32x2*)(Y2 + r1 * 1024) + F.lane;
            f32x4 v[4]; float s = 0.f;
#pragma unroll
            for (int j = 0; j < 4; ++j) { const u32x2 p = y0[64 * j], q = y1[64 * j], hw = hb[64 * j]; v[j] = (f32x4){bf_lo(hw.x), bf_hi(hw.x), bf_lo(hw.y), bf_hi(hw.y)};
                v[j][0] += Tv[j][0] * (w0 * bf_lo(p.x) + w1 * bf_lo(q.x)); v[j][1] += Tv[j][1] * (w0 * bf_hi(p.x) + w1 * bf_hi(q.x)); v[j][2] += Tv[j][2] * (w0 * bf_lo(p.y) + w1 * bf_lo(q.y)); v[j][3] += Tv[j][3] * (w0 * bf_hi(p.y) + w1 * bf_hi(q.y));
                s += (v[j][0] * v[j][0] + v[j][1] * v[j][1]) + (v[j][2] * v[j][2] + v[j][3] * v[j][3]); }
            const float rs = __builtin_amdgcn_rsqf(wave_sum(s) * (1.0f / 1024.0f) + EPS);
#pragma unroll
            for (int j = 0; j < 4; ++j) hr[64 * j] = v[j] * rs * Gv[j] + Sv[j]; }
    }
}

constexpr int N_PHASES = 11;
constexpr int MISC_BAR = MISC_OFF + 32, MISC_CNT = MISC_OFF + 64, MISC_TST = MISC_OFF + 256;

__global__ void __launch_bounds__(NWAVES * 64, 2) fwd(Args args) {
    extern __shared__ __attribute__((aligned(16))) unsigned char lds[];
    Frame F;
    F.lds = (LAS unsigned char*)lds;
    F.tid = threadIdx.x; F.lane = F.tid & 63; F.wave = __builtin_amdgcn_readfirstlane(F.tid >> 6);
    F.G = gridDim.x; { const int bx = blockIdx.x; F.vcu = (F.G % 8 == 0) ? (bx % 8) * (F.G / 8) + bx / 8 : bx; }
    unsigned char* ws = args.ws;
    gu32* ctl = (gu32*)(ws + WS_CTL);
    for (int u = F.tid; u < 1024 / 4; u += NWAVES * 64) ((LAS unsigned*)(F.lds + MISC_OFF))[u] = 0u;
    __syncthreads();
#if MK_PER_PHASE
#define GRID_BAR() do { } while (0)
#else
    XcdBarrier bar = xcd_barrier_post((unsigned*)(ctl + CW_BAR), (volatile LAS unsigned*)(F.lds + MISC_BAR));
#define GRID_BAR() xcd_barrier(bar)
#endif
#ifdef DBG_SYSFENCE
    __builtin_amdgcn_fence(__ATOMIC_ACQUIRE, ""); asm volatile("s_waitcnt vmcnt(0)" ::: "memory"); __syncthreads();
#endif
    const int lo = args.ph_lo, hi = args.ph_hi;
#ifndef PH_MASK
#define PH_MASK 0x7ff
#endif
#define IN(k) ((((PH_MASK) >> (k)) & 1) && lo <= (k) && (k) < hi)
#define BOTH(k) (IN(k) && IN((k) + 1))
    LAS unsigned char* ring = F.lds + RING_OFF;
#define REFRESH_F() do { int t_ = threadIdx.x; asm volatile("" : "+v"(t_)); F.tid = t_; F.lane = t_ & 63; } while (0)
    const int bx = (int)blockIdx.x;

    if (IN(0)) { REFRESH_F(); p0_prologue(F, args); if (BOTH(0)) GRID_BAR(); }
    if (IN(1)) { REFRESH_F(); p1_norm(F, args); if (BOTH(1)) GRID_BAR(); }
    if (IN(2)) {
#ifdef WG_STAGGER
        if (bx & 1) { for (int q = 0; q < WG_STAGGER; ++q) __builtin_amdgcn_s_sleep(127); }
#endif
#ifndef NO_G1M
        { pg8::PlainOrder8 S{(const char*)(ws + WS_R1), (const char*)(ws + WS_W8IN), 1024, T / 256, NWIN / 256, F.G, bx};
          EpiZ8 E{ws, args.in[14]};
          pg8::gemm_phase(ring, 1024, S, E); }
#endif
#ifdef PROBE_KLOOP
        { pg8::PlainOrder S{(const char*)(ws + WS_R1), (const char*)(ws + WS_WIN), 1024, T / 256, NWIN / 256, F.G, bx};
          EpiNull E{(float*)(ws + WS_SSQQ), args.ph_lo};
          pg8::gemm_phase(ring, 1024, S, E); }
#endif
#ifndef NO_G1F
        { F1Order8 S{(const char*)(ws + WS_W8FY), (const char*)(ws + WS_R1), F.G, bx};
          EpiF18 E{ws};
          pg8::gemm_phase(ring, 1024, S, E); }
#endif
        if (BOTH(2)) GRID_BAR();
    }
    if (IN(3)) {
#ifndef NO_P3A
        { pg8::PlainOrder S{(const char*)(ws + WS_QL), (const char*)(ws + WS_WUQ), 256, T / 256, 3, F.G, bx};
          EpiQ E{(bf16_t*)(ws + WS_Q), (const float*)(ws + WS_SSQQ), (const float*)(ws + WS_ROPEC), (const float*)(ws + WS_ROPES)};
          pg8::gemm_phase(ring, 256, S, E); }
#endif
#ifndef NO_P3B
        { pg8::PlainOrder S{(const char*)(ws + WS_KVL), (const char*)(ws + WS_WUKV), 256, T / 256, 4, F.G, bx};
          EpiKV E{(bf16_t*)(ws + WS_K), (bf16_t*)(ws + WS_V), (const float*)(ws + WS_SSQKV)};
          pg8::gemm_phase(ring, 256, S, E); }
#endif
#ifndef NO_P3C
        { pg8::PlainOrder S{(const char*)(ws + WS_DFTA), (const char*)(ws + WS_YT2), 256, 1, 1024, F.G, bx};
          EpiFA E{(bf16_t*)(ws + WS_R1)};
          pg8::gemm_phase(ring, 256, S, E); }
#endif
        if (BOTH(3)) GRID_BAR();
    }
    if (IN(4)) {
        { FBOrder S{(const char*)(ws + WS_TB2), (const char*)(ws + WS_R1), F.G, bx};
          EpiFB E{(bf16_t*)(ws + WS_YT2)};
          pg8::gemm_phase(ring, 256, S, E); }
        __syncthreads();
        { const bf16_t* Q = (const bf16_t*)(ws + WS_Q); const bf16_t* KB = (const bf16_t*)(ws + WS_K); const bf16_t* VB = (const bf16_t*)(ws + WS_V); bf16_t* O = (bf16_t*)(ws + WS_QL);
#define ATT_LOOP \
          for (int i = 0;; ++i) { const int unit = i * F.G + F.vcu; if (unit >= 1024) break; const int bh = unit >> 4, qb = unit & 15, b = bh >> 3, h = bh & 7; \
              att::attn_unit(Q + ((size_t)b * 8192 + qb * 512) * QC + h * 96, KB + (size_t)bh * 8192 * 96, VB + (size_t)bh * 8192 * 64, O + ((size_t)b * 8192 + qb * 512) * 512 + h * 64, ring); }
          ATT_LOOP
        }
        if (BOTH(4)) GRID_BAR();
    }
    if (IN(5)) {
        { MergeOrder S{(const char*)(ws + WS_QL), (const char*)(ws + WS_YT2), (const char*)(ws + WS_WBA), F.G, bx};
          EpiMerge2 E{(bf16_t*)(ws + WS_R1), (const unsigned char*)(ws + WS_GATE)};
          pg8::gemm_phase(ring, 1024, S, E); }
        if (BOTH(5)) GRID_BAR();
    }
    if (IN(6)) {
        { pg8::PlainOrder S{(const char*)(ws + WS_R1), (const char*)(ws + WS_WOUT), 1024, T / 256, 4, F.G, bx};
          EpiH E{args.in[0], (bf16_t*)(ws + WS_YT2), (const float*)(ws + WS_MODF)};
          pg8::gemm_phase(ring, 1024, S, E); }
        if (BOTH(6)) GRID_BAR();
    }
    if (IN(7)) { REFRESH_F(); p7_route(F, args); if (BOTH(7)) GRID_BAR(); }
    if (IN(8) || IN(9)) {
        REFRESH_F();
        LAS int* tst = (LAS int*)(F.lds + MISC_TST); LAS int* cntl = (LAS int*)(F.lds + MISC_CNT);
        if (F.tid < 32) cntl[F.tid] = (int)__hip_atomic_load((unsigned*)(ctl + CW_CNT) + F.tid, __ATOMIC_RELAXED, __HIP_MEMORY_SCOPE_AGENT);
        __syncthreads();
        if (F.tid == 0) { int s = 0; for (int e = 0; e < 32; ++e) { tst[e] = s; s += (cntl[e] + 255) >> 8; } tst[32] = s; }
        __syncthreads();
        { LAS unsigned char* texp = (LAS unsigned char*)(tst + 40); const int e = F.tid >> 4; if (F.tid < 512) for (int tl = tst[e] + (F.tid & 15); tl < tst[e + 1]; tl += 16) texp[tl] = (unsigned char)e; }
        __syncthreads();
        if (IN(8)) {
            MoeUpOrder8 S{(const char*)(ws + WS_R1), (const char*)(ws + WS_W8GU), (const u32x2*)(ws + WS_LIST), tst, cntl, F.G, bx};
            EpiUp8 E{ws};
            pg8::gemm_phase(ring, 1024, S, E);
            if (BOTH(8)) GRID_BAR();
        }
        if (IN(9)) {
            MoeDownOrder S{(const char*)(ws + WS_Q), (const char*)(ws + WS_WDN), tst, cntl, F.G, bx};
            EpiDown E{(bf16_t*)(ws + WS_GATE)};
            pg8::gemm_phase(ring, 256, S, E);
            if (BOTH(9)) GRID_BAR();
        }
    }
    if (IN(10)) { REFRESH_F(); p10_final(F, args); }
#ifdef DBG_SYSFENCE
    asm volatile("s_waitcnt vmcnt(0)" ::: "memory"); __syncthreads(); __builtin_amdgcn_fence(__ATOMIC_RELEASE, ""); asm volatile("s_waitcnt vmcnt(0)" ::: "memory");
#endif
#undef IN
#undef BOTH
}

extern "C" void kernel_launch(void* const* d_in, const int* in_sizes, int n_in, void* d_out, int out_size, void* d_ws, size_t ws_size, hipStream_t stream) {
    static int grid = 0;
    if (grid == 0) {
        if (n_in != 27 || in_sizes[0] != T * D || out_size != T * D || ws_size < WS_END) { fprintf(stderr, "kernel_launch: shape/workspace mismatch: n_in %d in0 %d out %d ws %zu (need %zu)\n", n_in, n_in > 0 ? in_sizes[0] : -1, out_size, ws_size, (size_t)WS_END); grid = -1; return; }
        int dev = 0, cus = 0;
        if (hipGetDevice(&dev) != hipSuccess || hipDeviceGetAttribute(&cus, hipDeviceAttributeMultiprocessorCount, dev) != hipSuccess) { fprintf(stderr, "kernel_launch: device query failed\n"); grid = -1; return; }
        if (hipFuncSetAttribute((const void*)fwd, hipFuncAttributeMaxDynamicSharedMemorySize, LDS_BYTES) != hipSuccess) { fprintf(stderr, "kernel_launch: hipFuncSetAttribute failed\n"); grid = -1; return; }
        int per_cu = 0;
        if (hipOccupancyMaxActiveBlocksPerMultiprocessor(&per_cu, (const void*)fwd, NWAVES * 64, LDS_BYTES) != hipSuccess || per_cu < 1) fprintf(stderr, "kernel_launch: note: occupancy query reports %d workgroups per CU\n", per_cu);
        (void)hipGetLastError();
        grid = cus;
    }
    if (grid < 0) return;
    if (hipMemsetAsync((char*)d_ws + WS_CTL, 0, CTL_ZERO_BYTES, stream) != hipSuccess) { fprintf(stderr, "kernel_launch: memset failed\n"); return; }
    Args a{};
    for (int i = 0; i < 27; ++i) a.in[i] = (const float*)d_in[i];
    a.out = (float*)d_out; a.ws = (unsigned char*)d_ws;
#if MK_PER_PHASE
    for (int p = 0; p < N_PHASES; ++p) { a.ph_lo = p; a.ph_hi = p + 1; a.li = p;
        hipLaunchKernelGGL(fwd, dim3(grid), dim3(NWAVES * 64), LDS_BYTES, stream, a);
        const hipError_t le = hipPeekAtLastError(); if (le != hipSuccess) { fprintf(stderr, "kernel_launch: launch %d failed: %s\n", p, hipGetErrorName(le)); break; } }
#else
#ifdef PROBE_MASK
    { bool first = true;
      for (int k = 0; k < N_PHASES; ++k) for (int rep = 0; rep < (((PROBE_MASK) >> k) & 1 ? 2 : 1); ++rep) { a.ph_lo = k; a.ph_hi = k + 1; a.li = 0;
        if (!first) (void)hipMemsetAsync((char*)d_ws + WS_CTL + CW_BAR * 4, 0, XCD_BAR_WORDS * 4, stream);
        first = false;
        hipLaunchKernelGGL(fwd, dim3(grid), dim3(NWAVES * 64), LDS_BYTES, stream, a); } }
#else
    a.ph_lo = 0; a.ph_hi = N_PHASES; a.li = 0;
    hipLaunchKernelGGL(fwd, dim3(grid), dim3(NWAVES * 64), LDS_BYTES, stream, a);
    { const hipError_t le = hipPeekAtLastError(); if (le != hipSuccess) fprintf(stderr, "kernel_launch: launch failed: %s\n", hipGetErrorName(le)); }
#endif
#endif
}
```

```cpp
#include <hip/hip_runtime.h>
#include <cstdio>
#include <cstdint>

#ifndef MK_PER_PHASE
#define MK_PER_PHASE 0
#endif

#define LAS __attribute__((address_space(3)))
#define GAS __attribute__((address_space(1)))
typedef unsigned short bf16_t;
typedef short bf16x8 __attribute__((ext_vector_type(8)));
typedef short s16x4 __attribute__((ext_vector_type(4)));
typedef float f32x4 __attribute__((ext_vector_type(4)));
typedef float f32x16 __attribute__((ext_vector_type(16)));
typedef unsigned u32x4 __attribute__((ext_vector_type(4)));
typedef unsigned u32x2 __attribute__((ext_vector_type(2)));
typedef GAS unsigned gu32;
typedef int i32x4 __attribute__((ext_vector_type(4)));

constexpr int NB = 8, SEQ = 8192, T = NB * SEQ, D = 1024;
constexpr int NH = 8, DQK = 96, DV = 64, QC = NH * DQK;
constexpr float EPS = 1e-6f;
constexpr float C2 = 0.14724444602590306f;
constexpr float FNORM = 0.0013810679320049755f;
constexpr int NEXP = 32, DEXP = 256;
constexpr int NWAVES = 8;

constexpr size_t MiB = 1u << 20;
constexpr size_t WS_CTL = 0, CTL_ZERO_BYTES = 1 * MiB;
constexpr size_t WS_SSQQ = 1 * MiB, WS_SSQKV = 2 * MiB, WS_ROUTEW = 3 * MiB, WS_MODF = 4 * MiB;
constexpr size_t WS_ROPEC = 8 * MiB, WS_ROPES = 12 * MiB, WS_LIST = 16 * MiB;
constexpr size_t WS_WIN = 32 * MiB, WS_WFY = 38 * MiB, WS_WUQ = 40 * MiB, WS_WUKV = 40 * MiB + 512 * 1024, WS_WBA = 41 * MiB, WS_WBF = 42 * MiB, WS_WOUT = 43 * MiB;
constexpr size_t WS_DFTA = 45 * MiB, WS_TB2 = 46 * MiB, WS_WGU = 50 * MiB, WS_WDN = 82 * MiB;
constexpr size_t WS_R1 = 100 * MiB;
constexpr size_t WS_GATE = 228 * MiB;
constexpr size_t WS_QL = 484 * MiB, WS_KVL = 516 * MiB;
constexpr size_t WS_Q = 548 * MiB, WS_K = 644 * MiB, WS_V = 740 * MiB;
constexpr size_t WS_YT2 = 804 * MiB;
constexpr size_t WS_W8IN = 932 * MiB, WS_W8FY = 935 * MiB, WS_W8GU = 936 * MiB;
constexpr size_t WS_SU = 5 * MiB;
constexpr size_t WS_END = 1024 * MiB;
constexpr int CW_TMO = 0;
constexpr int CW_BAR = 4096;
constexpr int CW_CNT = 8192;
constexpr int CW_WMAX = 8256;
constexpr int CW_MOD = 16384;
constexpr int NWIN = 2816;

constexpr int LDS_BYTES = 163840;
constexpr int MISC_OFF = 163840 - 1024;
constexpr int RING_OFF = 0;

#define LDS_WAIT() asm volatile("s_waitcnt lgkmcnt(0)" ::: "memory")
#define VM_WAIT() asm volatile("s_waitcnt vmcnt(0)" ::: "memory")
typedef float f32x2_t __attribute__((ext_vector_type(2))); typedef __bf16 bf16x2_t __attribute__((ext_vector_type(2)));
__device__ __forceinline__ unsigned cvt_pk_bf16(float lo, float hi) { f32x2_t v = {lo, hi}; bf16x2_t b = __builtin_convertvector(v, bf16x2_t); return __builtin_bit_cast(unsigned, b); }
__device__ __forceinline__ float bf_lo(unsigned w) { return __uint_as_float(w << 16); }
__device__ __forceinline__ float bf_hi(unsigned w) { return __uint_as_float(w & 0xffff0000u); }
__device__ __forceinline__ u32x4 pack8(const f32x4 a, const f32x4 b) { u32x4 w; w.x = cvt_pk_bf16(a[0], a[1]); w.y = cvt_pk_bf16(a[2], a[3]); w.z = cvt_pk_bf16(b[0], b[1]); w.w = cvt_pk_bf16(b[2], b[3]); return w; }
__device__ __forceinline__ u32x2 pack4(const f32x4 a) { u32x2 w; w.x = cvt_pk_bf16(a[0], a[1]); w.y = cvt_pk_bf16(a[2], a[3]); return w; }
__device__ __forceinline__ float sigmoidf_(float x) { return __builtin_amdgcn_rcpf(1.0f + __builtin_amdgcn_exp2f(-1.4426950408889634f * x)); }
__device__ __forceinline__ float wave_sum(float v) {
#pragma unroll
    for (int o = 1; o < 64; o <<= 1) v += __shfl_xor(v, o);
    return v;
}

#define XB_TMO      128
#define XB_XCNT(j)  (256  + 64 * (j))
#define XB_XSUB(j)  (1280 + 64 * (j))
#define XB_XGEN(j)  (2304 + 64 * (j))
#define XB_TOP      3328
#define XB_TOPGEN   3392
#define XCD_BAR_WORDS 3456
#define XB_SPIN_CAP (1u << 18)
__device__ __forceinline__ unsigned xb_ld(unsigned* p)              { return __hip_atomic_load(p, __ATOMIC_RELAXED, __HIP_MEMORY_SCOPE_AGENT); }
__device__ __forceinline__ unsigned xb_add(unsigned* p, unsigned v) { return __hip_atomic_fetch_add(p, v, __ATOMIC_RELAXED, __HIP_MEMORY_SCOPE_AGENT); }
__device__ __forceinline__ unsigned xb_xcc_id() { return (unsigned)__builtin_amdgcn_s_getreg((3 << 11) | 20) & 0xFu; }
#define XB_SPIN(cond, bar) do { unsigned _sp = 0; while (cond) { __builtin_amdgcn_s_sleep(1); \
    if ((++_sp & 255u) == 0u) { if (xb_ld(&(bar)[XB_TMO])) break; if (_sp > XB_SPIN_CAP) { atomicAdd(&(bar)[XB_TMO], 1u); break; } } } } while (0)
struct XcdBarrier { unsigned* bar; unsigned x; volatile LAS unsigned* st; };
__device__ __forceinline__ XcdBarrier xcd_barrier_post(unsigned* bar, volatile LAS unsigned* st) {
    XcdBarrier b; b.bar = bar; b.x = xb_xcc_id(); b.st = st;
    if (threadIdx.x == 0) (void)xb_add(&bar[XB_XCNT(b.x)], 1u);
    return b;
}
__device__ __forceinline__ void xcd_barrier_complete(unsigned* bar, unsigned x, unsigned& nloc, unsigned& nx) {
    const unsigned G = gridDim.x * gridDim.y * gridDim.z;
    unsigned sum, cnt, mine, sp = 0u;
    for (;;) {
        sum = 0u; cnt = 0u; mine = 0u;
#pragma unroll
        for (unsigned j = 0; j < 16; ++j) { const unsigned c = xb_ld(&bar[XB_XCNT(j)]); sum += c; cnt += (c > 0u) ? 1u : 0u; mine = (j == x) ? c : mine; }
        if (sum == G) break;
        __builtin_amdgcn_s_sleep(1);
        if ((++sp & 255u) == 0u) { if (xb_ld(&bar[XB_TMO])) break; if (sp > XB_SPIN_CAP) { atomicAdd(&bar[XB_TMO], 1u); break; } }
    }
    nloc = mine > 0u ? mine : 1u; nx = cnt > 0u ? cnt : 1u;
}
__device__ __forceinline__ void xcd_barrier(const XcdBarrier& b) {
    asm volatile("s_waitcnt vmcnt(0)" ::: "memory");
    __syncthreads();
    if (threadIdx.x == 0) {
        unsigned* bar = b.bar;
        __builtin_amdgcn_s_waitcnt(0);
        unsigned nloc = b.st[0], nx = b.st[1];
        if (nloc == 0u) { xcd_barrier_complete(bar, b.x, nloc, nx); b.st[0] = nloc; b.st[1] = nx; }
        const unsigned old = xb_add(&bar[XB_XSUB(b.x)], 1u);
        const unsigned gen = old / nloc;
        if (old + 1u == (gen + 1u) * nloc) {
            __builtin_amdgcn_fence(__ATOMIC_RELEASE, "agent");
            asm volatile("s_waitcnt vmcnt(0)" ::: "memory");
            const unsigned og = xb_add(&bar[XB_TOP], 1u);
            const unsigned tg = og / nx;
            if (og + 1u == (tg + 1u) * nx) xb_add(&bar[XB_TOPGEN], 1u);
            else XB_SPIN(xb_ld(&bar[XB_TOPGEN]) == tg, bar);
            __builtin_amdgcn_fence(__ATOMIC_ACQUIRE, "agent");
            xb_add(&bar[XB_XGEN(b.x)], 1u);
            asm volatile("s_waitcnt vmcnt(0)" ::: "memory");
        } else {
            XB_SPIN(xb_ld(&bar[XB_XGEN(b.x)]) == gen, bar);
            __builtin_amdgcn_fence(__ATOMIC_ACQUIRE, "agent");
            asm volatile("s_waitcnt vmcnt(0)" ::: "memory");
        }
    }
    __syncthreads();
}

namespace pg8 {
constexpr int BM = 256, BK = 64, HALF = 128, HTB = HALF * BK * 2, STAGE_BYTES = 8 * HTB, NXCD = 8, WGM = 4;
__host__ __device__ __forceinline__ int lds_byte(int r, int c) { const int st = (r >> 4) * 2 + (c >> 5), rr = r & 15, cc = c & 31, ob = rr * 64 + cc * 2; return st * 1024 + (ob ^ (((ob >> 9) & 1) << 5)); }
__host__ __device__ __forceinline__ void stage_rc(int b, int& R, int& C) { const int st = b / 1024, sb = b % 1024, swz = sb ^ (((sb >> 9) & 1) << 5); R = (st >> 1) * 16 + swz / 64; C = (st & 1) * 32 + (swz % 64) / 2; }
__host__ __device__ __forceinline__ int perm32(int rho) { const int n = rho >> 4, i = rho & 15; return 8 * (i >> 2) + 4 * n + (i & 3); }

struct UnitPN { int pm, pn; };
__device__ __forceinline__ bool static_next(int i, int G, int c, int nM, int nN, int& pm, int& pn) {
    const int nwg = nM * nN; const long L = (long)i * G + c; if (L >= nwg) return false;
    int wgid = (int)L; { const int q = nwg / NXCD, r = nwg % NXCD, xcd = wgid % NXCD, off = wgid / NXCD; wgid = (xcd < r ? xcd * (q + 1) : r * (q + 1) + (xcd - r) * q) + off; }
    const int nig = WGM * nN, gid = wgid / nig, fm = gid * WGM, gsz = (nM - fm) < WGM ? (nM - fm) : WGM;
    pm = fm + ((wgid % nig) % gsz); pn = (wgid % nig) / gsz; return true;
}
struct PlainOrder {
    typedef UnitPN Unit; static constexpr bool VARA = false, VARB = false;
    const char* A; const char* B; int K, nM, nN, G, c;
    __device__ __forceinline__ bool next(int i, Unit& u) const { return static_next(i, G, c, nM, nN, u.pm, u.pn); }
    __device__ __forceinline__ const char* baseA(const Unit& u) const { return A + (size_t)u.pm * 256 * K * 2; }
    __device__ __forceinline__ const char* baseB(const Unit& u) const { return B + (size_t)u.pn * 256 * K * 2; }
    __device__ __forceinline__ unsigned hstepA() const { return (unsigned)(128 * K * 2); }
    __device__ __forceinline__ unsigned hstepB() const { return (unsigned)(128 * K * 2); }
    __device__ __forceinline__ size_t koffA(int t) const { return (size_t)t * 128; }
    __device__ __forceinline__ void offA(const Unit&, const int (&R)[2], const int (&C)[2], unsigned (&o)[2][2]) const {
#pragma unroll
        for (int h = 0; h < 2; ++h)
#pragma unroll
            for (int i = 0; i < 2; ++i) o[h][i] = (unsigned)((h * 128 + R[i]) * K + C[i]) * 2u; }
    __device__ __forceinline__ void offB(const Unit& u, const int (&R)[2], const int (&C)[2], unsigned (&o)[2][2]) const { offA(u, R, C, o); }
};

struct PlainOrder8 {
    typedef UnitPN Unit; static constexpr bool VARA = false, VARB = false;
    const char* A; const char* B; int K, nM, nN, G, c;
    __device__ __forceinline__ bool next(int i, Unit& u) const { return static_next(i, G, c, nM, nN, u.pm, u.pn); }
    __device__ __forceinline__ const char* baseA(const Unit& u) const { return A + (size_t)u.pm * 256 * K; }
    __device__ __forceinline__ const char* baseB(const Unit& u) const { return B + (size_t)u.pn * 256 * K; }
    __device__ __forceinline__ unsigned hstepA() const { return (unsigned)(128 * K); }
    __device__ __forceinline__ unsigned hstepB() const { return (unsigned)(128 * K); }
    __device__ __forceinline__ size_t koffA(int t) const { return (size_t)t * 128; }
    __device__ __forceinline__ void offA(const Unit&, const int (&R)[2], const int (&C)[2], unsigned (&o)[2][2]) const {
#pragma unroll
        for (int h = 0; h < 2; ++h)
#pragma unroll
            for (int i = 0; i < 2; ++i) o[h][i] = (unsigned)((h * 128 + R[i]) * K + C[i] * 2); }
    __device__ __forceinline__ void offB(const Unit& u, const int (&R)[2], const int (&C)[2], unsigned (&o)[2][2]) const { offA(u, R, C, o); }
};
__device__ __forceinline__ const char* uni_ptr(const char* p) { const unsigned long long v = (unsigned long long)(uintptr_t)p; return (const char*)(uintptr_t)(((unsigned long long)(unsigned)__builtin_amdgcn_readfirstlane((int)(v >> 32)) << 32) | (unsigned)__builtin_amdgcn_readfirstlane((int)(unsigned)v)); }
template <bool B, class X, class Y> struct sel_t { typedef X type; };
template <class X, class Y> struct sel_t<false, X, Y> { typedef Y type; };
template <class Epi, class Sched>
__device__ __forceinline__ void gemm_phase(LAS unsigned char* lds, const int K, const Sched& S, const Epi& E) {
    typedef typename Sched::Unit Unit;
    int tid_ = threadIdx.x; asm volatile("" : "+v"(tid_));
    const int tid = tid_, wid = __builtin_amdgcn_readfirstlane(tid >> 6), lane = tid & 63, wr = wid >> 2, wc = wid & 3, fr = lane & 15, fq = lane >> 4;
    typedef typename sel_t<Epi::I8, i32x4, f32x4>::type acc_t;
    const int nt = K / (Epi::I8 ? 2 * BK : BK);
    int Rr[2], Cc[2], Rb[2];
#pragma unroll
    for (int i = 0; i < 2; ++i) { stage_rc(tid * 16 + i * 8192, Rr[i], Cc[i]); Rb[i] = Epi::PERM ? ((Rr[i] & ~31) + perm32(Rr[i] & 31)) : Rr[i]; }
    const size_t kstep = (size_t)(BK * 2);
    const unsigned ldsw = (unsigned)wid * 1024u, ldsb = (unsigned)(uintptr_t)lds;
    const unsigned hsA = S.hstepA(), hsB = S.hstepB();
    const int aoff = lds_byte(wr * 64 + fr, fq * 8), boff = lds_byte(wc * 32 + fr, fq * 8);
#define PG8_SA(b, h) (((b) * 2 + (h)) * HTB)
#define PG8_SB(b, h) ((4 + (b) * 2 + (h)) * HTB)
#ifdef PG8_BUILTIN_GLDS
#define PG8_STAGE_A(bufoff, gbase, O, h) do { _Pragma("unroll") for (int _i = 0; _i < 2; ++_i) \
        __builtin_amdgcn_global_load_lds((const unsigned*)(Sched::VARA ? (const char*)(gbase) + (O)[h][_i] : (const char*)(gbase) + (size_t)(h) * hsA + (O)[0][_i]), (LAS unsigned*)(lds + (bufoff) + ldsw + _i * 8192), 16, 0, 0); } while (0)
#define PG8_STAGE_B(bufoff, gbase, O, h) do { _Pragma("unroll") for (int _i = 0; _i < 2; ++_i) \
        __builtin_amdgcn_global_load_lds((const unsigned*)(Sched::VARB ? (const char*)(gbase) + (O)[h][_i] : (const char*)(gbase) + (size_t)(h) * hsB + (O)[0][_i]), (LAS unsigned*)(lds + (bufoff) + ldsw + _i * 8192), 16, 0, 0); } while (0)
#else
#define PG8_GLDS(ubase, voff, ldsaddr) do { unsigned keep_; asm volatile("s_mov_b32 %0, m0\n\ts_mov_b32 m0, %3\n\ts_nop 0\n\tglobal_load_lds_dwordx4 %1, %2\n\ts_mov_b32 m0, %0" \
        : "=&s"(keep_) : "v"(voff), "s"(uni_ptr(ubase)), "s"((unsigned)(ldsaddr)) : "memory"); } while (0)
#define PG8_STAGE_A(bufoff, gbase, O, h) do { _Pragma("unroll") for (int _i = 0; _i < 2; ++_i) \
        PG8_GLDS(Sched::VARA ? (const char*)(gbase) : (const char*)(gbase) + (size_t)(h) * hsA, Sched::VARA ? (O)[h][_i] : (O)[0][_i], ldsb + (unsigned)(bufoff) + ldsw + _i * 8192u); } while (0)
#define PG8_STAGE_B(bufoff, gbase, O, h) do { _Pragma("unroll") for (int _i = 0; _i < 2; ++_i) \
        PG8_GLDS(Sched::VARB ? (const char*)(gbase) : (const char*)(gbase) + (size_t)(h) * hsB, Sched::VARB ? (O)[h][_i] : (O)[0][_i], ldsb + (unsigned)(bufoff) + ldsw + _i * 8192u); } while (0)
#endif
#define PG8_LDA(dst, b, h) do { _Pragma("unroll") for (int m = 0; m < 4; ++m) _Pragma("unroll") for (int k = 0; k < 2; ++k) dst[m][k] = *(const LAS bf16x8*)(lds + PG8_SA(b, h) + aoff + m * 2048 + k * 1024); } while (0)
#define PG8_LDB(dst, b, h) do { _Pragma("unroll") for (int n = 0; n < 2; ++n) _Pragma("unroll") for (int k = 0; k < 2; ++k) dst[n][k] = *(const LAS bf16x8*)(lds + PG8_SB(b, h) + boff + n * 2048 + k * 1024); } while (0)
#define PG8_MMA(ai, bj, At, Bt) do { __builtin_amdgcn_s_setprio(1); _Pragma("unroll") for (int m = 0; m < 4; ++m) _Pragma("unroll") for (int n = 0; n < 2; ++n) _Pragma("unroll") for (int k = 0; k < 2; ++k) \
        { if constexpr (Epi::I8) acc[ai][bj][m][n] = __builtin_bit_cast(acc_t, __builtin_amdgcn_mfma_i32_16x16x64_i8(__builtin_bit_cast(i32x4, Bt[n][k]), __builtin_bit_cast(i32x4, At[m][k]), __builtin_bit_cast(i32x4, acc[ai][bj][m][n]), 0, 0, 0)); \
          else acc[ai][bj][m][n] = __builtin_bit_cast(acc_t, __builtin_amdgcn_mfma_f32_16x16x32_bf16(Bt[n][k], At[m][k], __builtin_bit_cast(f32x4, acc[ai][bj][m][n]), 0, 0, 0)); } __builtin_amdgcn_s_setprio(0); } while (0)
#ifdef DBG_WAIT0
#define PG8_WAIT_V(n) asm volatile("s_waitcnt vmcnt(0)" ::: "memory")
#else
#define PG8_WAIT_V(n) asm volatile("s_waitcnt vmcnt(" #n ")" ::: "memory")
#endif
#define PG8_WAIT_L(n) asm volatile("s_waitcnt lgkmcnt(" #n ")" ::: "memory")
#define PG8_BAR __builtin_amdgcn_s_barrier()
#define PG8_SCHED __builtin_amdgcn_sched_barrier(0)
    Unit cur, nxt; int ui = 0;
    if (!S.next(0, cur)) return;
    acc_t acc[2][2][4][2];
#pragma unroll
    for (int a = 0; a < 2; ++a)
#pragma unroll
        for (int b = 0; b < 2; ++b)
#pragma unroll
            for (int m = 0; m < 4; ++m)
#pragma unroll
                for (int n = 0; n < 2; ++n) acc[a][b][m][n] = acc_t{};
    bf16x8 At[4][2], B0[2][2], B1[2][2];
    unsigned oA[2][2], oB[2][2];
    S.offA(cur, Rr, Cc, oA); S.offB(cur, Rb, Cc, oB);
    const char* cA = S.baseA(cur); const char* cB = S.baseB(cur);
    PG8_STAGE_B(PG8_SB(0, 0), cB, oB, 0); PG8_STAGE_B(PG8_SB(0, 1), cB, oB, 1); PG8_STAGE_A(PG8_SA(0, 0), cA, oA, 0); PG8_STAGE_A(PG8_SA(0, 1), cA, oA, 1);
    if (wr == 1) PG8_BAR;
    PG8_WAIT_V(2); PG8_BAR;
    PG8_STAGE_B(PG8_SB(1, 0), cB + kstep, oB, 0); PG8_STAGE_A(PG8_SA(1, 0), cA + S.koffA(1), oA, 0); PG8_STAGE_B(PG8_SB(1, 1), cB + kstep, oB, 1);
    PG8_WAIT_V(6); PG8_BAR;
    for (;;) {
        const bool has_next = S.next(ui + 1, nxt);
        const char* nA = has_next ? S.baseA(nxt) : cA; const char* nB = has_next ? S.baseB(nxt) : cB;
        unsigned nOA[2][2], nOB[2][2];
#pragma unroll
        for (int h = 0; h < 2; ++h)
#pragma unroll
            for (int i = 0; i < 2; ++i) { nOA[h][i] = oA[h][i]; nOB[h][i] = oB[h][i]; }
        if constexpr (Sched::VARA) { if (has_next) S.offA(nxt, Rr, Cc, nOA); }
        if constexpr (Sched::VARB) { if (has_next) S.offB(nxt, Rb, Cc, nOB); }
#pragma unroll 1
        for (int t = 0; t < nt; t += 2) {
            const bool last = (t == nt - 2);
            if constexpr (Epi::MIDK) { if (t == nt / 2) E.mid(acc, cur, wr, wc, fr, fq); }
            const char* a1 = cA + S.koffA(t + 1);
            const char* a2 = last ? nA : cA + S.koffA(t + 2); const char* b2 = last ? nB : cB + (size_t)(t + 2) * kstep;
            const char* a3 = last ? nA + S.koffA(1) : cA + S.koffA(t + 3); const char* b3 = b2 + kstep;
            unsigned sA[2][2], sB[2][2];
#pragma unroll
            for (int h = 0; h < 2; ++h)
#pragma unroll
                for (int i = 0; i < 2; ++i) { sA[h][i] = (Sched::VARA && last) ? nOA[h][i] : oA[h][i]; sB[h][i] = (Sched::VARB && last) ? nOB[h][i] : oB[h][i]; }
            PG8_LDB(B0, 0, 0); PG8_LDB(B1, 0, 1); PG8_SCHED; PG8_LDA(At, 0, 0); PG8_STAGE_A(PG8_SA(1, 1), a1, oA, 1);
            PG8_WAIT_V(8); PG8_WAIT_L(0); PG8_BAR; PG8_MMA(0, 0, At, B0); PG8_MMA(0, 1, At, B1); PG8_BAR; PG8_SCHED;
            PG8_LDA(At, 0, 1); PG8_STAGE_B(PG8_SB(0, 0), b2, sB, 0); PG8_STAGE_B(PG8_SB(0, 1), b2, sB, 1); PG8_STAGE_A(PG8_SA(0, 0), a2, sA, 0);
            PG8_WAIT_V(8); PG8_WAIT_L(0); PG8_BAR; PG8_MMA(1, 0, At, B0); PG8_MMA(1, 1, At, B1); PG8_BAR; PG8_SCHED;
            PG8_LDB(B0, 1, 0); PG8_LDB(B1, 1, 1); PG8_SCHED; PG8_LDA(At, 1, 0); PG8_STAGE_A(PG8_SA(0, 1), a2, sA, 1);
            PG8_WAIT_V(8); PG8_WAIT_L(0); PG8_BAR; PG8_MMA(0, 0, At, B0); PG8_MMA(0, 1, At, B1); PG8_BAR; PG8_SCHED;
            PG8_LDA(At, 1, 1); PG8_STAGE_B(PG8_SB(1, 0), b3, sB, 0); PG8_STAGE_B(PG8_SB(1, 1), b3, sB, 1); PG8_STAGE_A(PG8_SA(1, 0), a3, sA, 0);
            PG8_WAIT_V(8); PG8_WAIT_L(0); PG8_BAR; PG8_MMA(1, 0, At, B0); PG8_MMA(1, 1, At, B1); PG8_BAR; PG8_SCHED;
        }
        if (wr == 0) PG8_BAR;
        E(acc, cur, wr, wc, fr, fq);
        if (!has_next) break;
#pragma unroll
        for (int a = 0; a < 2; ++a)
#pragma unroll
            for (int b = 0; b < 2; ++b)
#pragma unroll
                for (int m = 0; m < 4; ++m)
#pragma unroll
                    for (int n = 0; n < 2; ++n) acc[a][b][m][n] = acc_t{};
        cur = nxt; cA = nA; cB = nB; ++ui;
#pragma unroll
        for (int h = 0; h < 2; ++h)
#pragma unroll
            for (int i = 0; i < 2; ++i) { oA[h][i] = nOA[h][i]; oB[h][i] = nOB[h][i]; }
        if (wr == 1) PG8_BAR;
    }
    PG8_WAIT_V(0);
    PG8_BAR;
#undef PG8_SA
#undef PG8_SB
#undef PG8_STAGE_A
#undef PG8_STAGE_B
#ifdef PG8_GLDS
#undef PG8_GLDS
#endif
#undef PG8_LDA
#undef PG8_LDB
#undef PG8_MMA
#undef PG8_WAIT_V
#undef PG8_WAIT_L
#undef PG8_BAR
#undef PG8_SCHED
}
}
using pg8::UnitPN;

struct F1Order {
    typedef UnitPN Unit; static constexpr bool VARA = false, VARB = false;
    const char* A; const char* B; int G, c;
    __device__ __forceinline__ bool next(int i, Unit& u) const { const int L = i * G + c; if (L >= 1024) return false; u.pn = L >> 2; u.pm = L & 3; return true; }
    __device__ __forceinline__ const char* baseA(const Unit& u) const { return A + (size_t)u.pm * 256 * 2048; }
    __device__ __forceinline__ const char* baseB(const Unit& u) const { return B + ((size_t)(u.pn >> 5) * 8192 + 2 * (u.pn & 31)) * 2048; }
    __device__ __forceinline__ unsigned hstepA() const { return 128u * 2048u; }
    __device__ __forceinline__ unsigned hstepB() const { return 2048u; }
    __device__ __forceinline__ size_t koffA(int t) const { return (size_t)t * 128; }
    __device__ __forceinline__ void offA(const Unit&, const int (&R)[2], const int (&C)[2], unsigned (&o)[2][2]) const {
#pragma unroll
        for (int h = 0; h < 2; ++h)
#pragma unroll
            for (int i = 0; i < 2; ++i) o[h][i] = (unsigned)((h * 128 + R[i]) * 1024 + C[i]) * 2u; }
    __device__ __forceinline__ void offB(const Unit&, const int (&R)[2], const int (&C)[2], unsigned (&o)[2][2]) const {
#pragma unroll
        for (int h = 0; h < 2; ++h)
#pragma unroll
            for (int i = 0; i < 2; ++i) o[h][i] = (unsigned)((h + 64 * R[i]) * 1024 + C[i]) * 2u; }
};
struct FBOrder {
    typedef UnitPN Unit; static constexpr bool VARA = false, VARB = false;
    const char* A; const char* B; int G, c;
    __device__ __forceinline__ bool next(int i, Unit& u) const { const int L = i * G + c; if (L >= 1024) return false; u.pm = L >> 4; u.pn = L & 15; return true; }
    __device__ __forceinline__ const char* baseA(const Unit& u) const { return A + (size_t)u.pm * 65536; }
    __device__ __forceinline__ const char* baseB(const Unit& u) const { return B + ((size_t)u.pm * 4096 + (size_t)u.pn * 256) * 512; }
    __device__ __forceinline__ unsigned hstepA() const { return 0u; }
    __device__ __forceinline__ unsigned hstepB() const { return 128u * 512u; }
    __device__ __forceinline__ size_t koffA(int t) const { return (size_t)t * 128; }
    __device__ __forceinline__ void offA(const Unit&, const int (&R)[2], const int (&C)[2], unsigned (&o)[2][2]) const {
#pragma unroll
        for (int h = 0; h < 2; ++h)
#pragma unroll
            for (int i = 0; i < 2; ++i) o[h][i] = (unsigned)(R[i] * 256 + C[i]) * 2u; }
    __device__ __forceinline__ void offB(const Unit&, const int (&R)[2], const int (&C)[2], unsigned (&o)[2][2]) const {
#pragma unroll
        for (int h = 0; h < 2; ++h)
#pragma unroll
            for (int i = 0; i < 2; ++i) o[h][i] = (unsigned)((h * 128 + R[i]) * 256 + C[i]) * 2u; }
};
struct MergeOrder {
    typedef UnitPN Unit; static constexpr bool VARA = false, VARB = false;
    const char* A; const char* A2; const char* B; int G, c;
    __device__ __forceinline__ bool next(int i, Unit& u) const { return pg8::static_next(i, G, c, T / 256, 4, u.pm, u.pn); }
    __device__ __forceinline__ const char* baseA(const Unit& u) const { return A + (size_t)u.pm * 256 * 1024; }
    __device__ __forceinline__ const char* baseB(const Unit& u) const { return B + (size_t)u.pn * 256 * 2048; }
    __device__ __forceinline__ unsigned hstepA() const { return 128u * 1024u; }
    __device__ __forceinline__ unsigned hstepB() const { return 128u * 2048u; }
    __device__ __forceinline__ size_t koffA(int t) const { return t < 8 ? (size_t)t * 128 : (size_t)(A2 - A) + (size_t)(t - 8) * 128; }
    __device__ __forceinline__ void offA(const Unit&, const int (&R)[2], const int (&C)[2], unsigned (&o)[2][2]) const {
#pragma unroll
        for (int h = 0; h < 2; ++h)
#pragma unroll
            for (int i = 0; i < 2; ++i) o[h][i] = (unsigned)((h * 128 + R[i]) * 512 + C[i]) * 2u; }
    __device__ __forceinline__ void offB(const Unit&, const int (&R)[2], const int (&C)[2], unsigned (&o)[2][2]) const {
#pragma unroll
        for (int h = 0; h < 2; ++h)
#pragma unroll
            for (int i = 0; i < 2; ++i) o[h][i] = (unsigned)((h * 128 + R[i]) * 1024 + C[i]) * 2u; }
};
struct F1Order8 {
    typedef UnitPN Unit; static constexpr bool VARA = false, VARB = false;
    const char* A; const char* B; int G, c;
    __device__ __forceinline__ bool next(int i, Unit& u) const { const int L = i * G + c; if (L >= 1024) return false; u.pn = L >> 2; u.pm = L & 3; return true; }
    __device__ __forceinline__ const char* baseA(const Unit& u) const { return A + (size_t)u.pm * 256 * 1024; }
    __device__ __forceinline__ const char* baseB(const Unit& u) const { return B + ((size_t)(u.pn >> 5) * 8192 + 2 * (u.pn & 31)) * 1024; }
    __device__ __forceinline__ unsigned hstepA() const { return 128u * 1024u; }
    __device__ __forceinline__ unsigned hstepB() const { return 1024u; }
    __device__ __forceinline__ size_t koffA(int t) const { return (size_t)t * 128; }
    __device__ __forceinline__ void offA(const Unit&, const int (&R)[2], const int (&C)[2], unsigned (&o)[2][2]) const {
#pragma unroll
        for (int h = 0; h < 2; ++h)
#pragma unroll
            for (int i = 0; i < 2; ++i) o[h][i] = (unsigned)((h * 128 + R[i]) * 1024 + C[i] * 2); }
    __device__ __forceinline__ void offB(const Unit&, const int (&R)[2], const int (&C)[2], unsigned (&o)[2][2]) const {
#pragma unroll
        for (int h = 0; h < 2; ++h)
#pragma unroll
            for (int i = 0; i < 2; ++i) o[h][i] = (unsigned)((h + 64 * R[i]) * 1024 + C[i] * 2); }
};
struct MoeUnit { int e, row0, cnt, orow, pn; };
template <int NPN> __device__ __forceinline__ bool moe_next(int i, int G, int c, const LAS int* tst, const LAS int* cntl, MoeUnit& u) {
    const int L = i * G + c; const int tile = L / NPN; const int total = __builtin_amdgcn_readfirstlane(tst[32]);
    if (tile >= total) return false;
    const LAS unsigned char* texp = (const LAS unsigned char*)(tst + 40);
    const int e = __builtin_amdgcn_readfirstlane((int)texp[tile]);
    u.e = e; u.row0 = (tile - __builtin_amdgcn_readfirstlane(tst[e])) * 256; u.cnt = __builtin_amdgcn_readfirstlane(cntl[e]); u.orow = tile * 256; u.pn = L % NPN; return true;
}
struct MoeUpOrder {
    typedef MoeUnit Unit; static constexpr bool VARA = true, VARB = false;
    const char* A; const char* B; const u32x2* list; const LAS int* tst; const LAS int* cntl; int G, c;
    __device__ __forceinline__ bool next(int i, Unit& u) const { return moe_next<2>(i, G, c, tst, cntl, u); }
    __device__ __forceinline__ const char* baseA(const Unit&) const { return A; }
    __device__ __forceinline__ const char* baseB(const Unit& u) const { return B + ((size_t)u.e * 512 + (size_t)u.pn * 256) * 2048; }
    __device__ __forceinline__ unsigned hstepA() const { return 0u; }
    __device__ __forceinline__ unsigned hstepB() const { return 128u * 2048u; }
    __device__ __forceinline__ size_t koffA(int t) const { return (size_t)t * 128; }
    __device__ __forceinline__ void offA(const Unit& u, const int (&R)[2], const int (&C)[2], unsigned (&o)[2][2]) const {
#pragma unroll
        for (int h = 0; h < 2; ++h)
#pragma unroll
            for (int i = 0; i < 2; ++i) { const int li = u.row0 + h * 128 + R[i]; const int tok = (li < u.cnt) ? (int)(list[(size_t)u.e * 65536 + li].x & 0x7fffffffu) : 0; o[h][i] = (unsigned)tok * 2048u + (unsigned)C[i] * 2u; } }
    __device__ __forceinline__ void offB(const Unit&, const int (&R)[2], const int (&C)[2], unsigned (&o)[2][2]) const {
#pragma unroll
        for (int h = 0; h < 2; ++h)
#pragma unroll
            for (int i = 0; i < 2; ++i) o[h][i] = (unsigned)((h * 128 + R[i]) * 1024 + C[i]) * 2u; }
};
struct MoeUpOrder8 {
    typedef MoeUnit Unit; static constexpr bool VARA = true, VARB = false;
    const char* A; const char* B; const u32x2* list; const LAS int* tst; const LAS int* cntl; int G, c;
    __device__ __forceinline__ bool next(int i, Unit& u) const { return moe_next<2>(i, G, c, tst, cntl, u); }
    __device__ __forceinline__ const char* baseA(const Unit&) const { return A; }
    __device__ __forceinline__ const char* baseB(const Unit& u) const { return B + ((size_t)u.e * 512 + (size_t)u.pn * 256) * 1024; }
    __device__ __forceinline__ unsigned hstepA() const { return 0u; }
    __device__ __forceinline__ unsigned hstepB() const { return 128u * 1024u; }
    __device__ __forceinline__ size_t koffA(int t) const { return (size_t)t * 128; }
    __device__ __forceinline__ void offA(const Unit& u, const int (&R)[2], const int (&C)[2], unsigned (&o)[2][2]) const {
#pragma unroll
        for (int h = 0; h < 2; ++h)
#pragma unroll
            for (int i = 0; i < 2; ++i) { const int li = u.row0 + h * 128 + R[i]; const int tok = (li < u.cnt) ? (int)(list[(size_t)u.e * 65536 + li].x & 0x7fffffffu) : 0; o[h][i] = (unsigned)tok * 1024u + (unsigned)C[i] * 2u; } }
    __device__ __forceinline__ void offB(const Unit&, const int (&R)[2], const int (&C)[2], unsigned (&o)[2][2]) const {
#pragma unroll
        for (int h = 0; h < 2; ++h)
#pragma unroll
            for (int i = 0; i < 2; ++i) o[h][i] = (unsigned)((h * 128 + R[i]) * 1024 + C[i] * 2); }
};
struct MoeDownOrder {
    typedef MoeUnit Unit; static constexpr bool VARA = false, VARB = false;
    const char* A; const char* B; const LAS int* tst; const LAS int* cntl; int G, c;
    __device__ __forceinline__ bool next(int i, Unit& u) const { return moe_next<4>(i, G, c, tst, cntl, u); }
    __device__ __forceinline__ const char* baseA(const Unit& u) const { return A + (size_t)u.orow * 512; }
    __device__ __forceinline__ const char* baseB(const Unit& u) const { return B + ((size_t)u.e * 1024 + (size_t)u.pn * 256) * 512; }
    __device__ __forceinline__ unsigned hstepA() const { return 128u * 512u; }
    __device__ __forceinline__ unsigned hstepB() const { return 128u * 512u; }
    __device__ __forceinline__ size_t koffA(int t) const { return (size_t)t * 128; }
    __device__ __forceinline__ void offA(const Unit&, const int (&R)[2], const int (&C)[2], unsigned (&o)[2][2]) const {
#pragma unroll
        for (int h = 0; h < 2; ++h)
#pragma unroll
            for (int i = 0; i < 2; ++i) o[h][i] = (unsigned)((h * 128 + R[i]) * 256 + C[i]) * 2u; }
    __device__ __forceinline__ void offB(const Unit& u, const int (&R)[2], const int (&C)[2], unsigned (&o)[2][2]) const { offA(u, R, C, o); }
};

typedef const f32x4 (&AccRef)[2][2][4][2];
#ifdef EPI_NT_STORES
#define EPI_ST(TY, P, V) __builtin_nontemporal_store((V), (TY*)(P))
#else
#define EPI_ST(TY, P, V) (*(TY*)(P) = (V))
#endif
#ifndef EPI_FENCE
#define EPI_FENCE do { } while (0)
#endif
#define EPI_LOOP_AM _Pragma("unroll") for (int ai = 0; ai < 2; ++ai) _Pragma("unroll") for (int m = 0; m < 4; ++m)

__device__ __forceinline__ unsigned q8(float x) { return (unsigned)(sigmoidf_(x) * 255.0f + 0.5f); }
__device__ __forceinline__ size_t gate_off(int pm, int which, int pn4, int wave, int ai, int bj, int m, int lane) { return ((((size_t)(pm * 2 + which) * 4 + pn4) * 8 + wave) * 16 + (ai * 2 + bj) * 4 + m) * 512 + lane * 8; }
struct EpiZ {
    static constexpr bool PERM = true, MIDK = false, I8 = false;
    bf16_t* __restrict__ QL; bf16_t* __restrict__ KVL; float* __restrict__ SSQQ; float* __restrict__ SSQKV; unsigned char* __restrict__ GATE; const float* __restrict__ bg; bf16_t* __restrict__ KB; const float* __restrict__ RC; const float* __restrict__ RS;
    __device__ __forceinline__ void operator()(AccRef acc, const UnitPN& u, int wr, int wc, int fr, int fq) const {
        const int row0 = u.pm * 256 + wr * 64 + fr, c0 = wc * 32 + 8 * fq;
        if (u.pn < 2) {
            bf16_t* O = u.pn ? KVL : QL; float* SS = u.pn ? SSQKV : SSQQ;
            EPI_LOOP_AM { const int row = row0 + ai * 128 + m * 16; float s = 0.f;
#pragma unroll
                for (int bj = 0; bj < 2; ++bj) { const f32x4 v0 = acc[ai][bj][m][0], v1 = acc[ai][bj][m][1];
                    s += (v0[0] * v0[0] + v0[1] * v0[1]) + (v0[2] * v0[2] + v0[3] * v0[3]) + (v1[0] * v1[0] + v1[1] * v1[1]) + (v1[2] * v1[2] + v1[3] * v1[3]);
                    EPI_ST(u32x4, O + (size_t)row * 256 + bj * 128 + c0, pack8(v0, v1)); }
                s += __shfl_xor(s, 16); s += __shfl_xor(s, 32);
                if (fq == 0) SS[(size_t)row * 4 + wc] = s; }
        } else if (u.pn < 10) {
            const int gc0 = (u.pn - 2) * 256 + c0;
            f32x4 bv[2][2];
#pragma unroll
            for (int bj = 0; bj < 2; ++bj)
#pragma unroll
                for (int n = 0; n < 2; ++n) bv[bj][n] = *(const f32x4*)(bg + gc0 + bj * 128 + 4 * n);
            EPI_LOOP_AM { const int row = row0 + ai * 128 + m * 16;
#pragma unroll
                for (int bj = 0; bj < 2; ++bj) { const f32x4 v0 = acc[ai][bj][m][0] + bv[bj][0], v1 = acc[ai][bj][m][1] + bv[bj][1];
                    u32x2 w;
                    w.x = q8(v0[0]) | (q8(v0[1]) << 8) | (q8(v0[2]) << 16) | (q8(v0[3]) << 24); w.y = q8(v1[0]) | (q8(v1[1]) << 8) | (q8(v1[2]) << 16) | (q8(v1[3]) << 24);
                    EPI_ST(u32x2, GATE + (size_t)row * 2048 + gc0 + bj * 128, w); }
                EPI_FENCE; }
        } else if (wc == 0) {
            f32x4 cs[2][4], sn[2][4];
            EPI_LOOP_AM { const int row = row0 + ai * 128 + m * 16; cs[ai][m] = *(const f32x4*)(RC + (size_t)row * 16 + 4 * fq); sn[ai][m] = *(const f32x4*)(RS + (size_t)row * 16 + 4 * fq); }
            EPI_LOOP_AM { const int row = row0 + ai * 128 + m * 16; const int b = row >> 13, s = row & 8191;
                const f32x4 x1 = acc[ai][0][m][0], x2 = acc[ai][0][m][1];
                const u32x2 p1 = pack4(x1 * cs[ai][m] - x2 * sn[ai][m]), p2 = pack4(x2 * cs[ai][m] + x1 * sn[ai][m]);
#pragma unroll
                for (int h = 0; h < 8; ++h) { bf16_t* kp = KB + (((size_t)(b * 8 + h) * 128 + (s >> 6)) * 12 + 8 + (fq >> 1)) * 512 + (s & 63) * 8 + 4 * (fq & 1); *(u32x2*)kp = p1; EPI_ST(u32x2, kp + 1024, p2); } }
        }
    }
};
struct EpiF1 {
    static constexpr bool PERM = true, MIDK = false, I8 = false;
    bf16_t* YT2;
    __device__ __forceinline__ void operator()(AccRef acc, const UnitPN& u, int wr, int wc, int fr, int fq) const {
        const int b = u.pn >> 5, tt = u.pn & 31;
        EPI_LOOP_AM { const int r = u.pm * 256 + ai * 128 + wr * 64 + m * 16 + fr; const int ri = r >> 9, gc = r & 511;
#pragma unroll
            for (int bj = 0; bj < 2; ++bj) { const int sa = 2 * tt + bj, sb = wc * 32 + 8 * fq;
                EPI_ST(u32x4, YT2 + ((((size_t)b * 512 + gc) * 64 + sa) * 2 + ri) * 128 + sb, pack8(acc[ai][bj][m][0], acc[ai][bj][m][1])); } }
    }
};
struct EpiFA {
    static constexpr bool PERM = true, MIDK = false, I8 = false;
    bf16_t* Z;
    __device__ __forceinline__ void operator()(AccRef acc, const UnitPN& u, int wr, int wc, int fr, int fq) const {
        EPI_LOOP_AM { const int kb = wr * 64 + m * 16 + fr;
#pragma unroll
            for (int bj = 0; bj < 2; ++bj) { const int gcb = u.pn * 4 + bj * 2 + (wc >> 1), sa = 32 * (wc & 1) + 8 * fq;
                EPI_ST(u32x4, Z + (((((size_t)(kb >> 1) * 4096 + gcb) * 2 + (kb & 1)) * 2 + ai) * 64 + sa), pack8(acc[ai][bj][m][0], acc[ai][bj][m][1])); } }
    }
};
struct EpiFB {
    static constexpr bool PERM = true, MIDK = false, I8 = false;
    bf16_t* FO;
    __device__ __forceinline__ void operator()(AccRef acc, const UnitPN& u, int wr, int wc, int fr, int fq) const {
        const int b = u.pn >> 1;
#pragma unroll
        for (int m = 0; m < 4; ++m) { const int ka = m * 16 + fr, s = 2 * u.pm + wr + 128 * ka;
#pragma unroll
            for (int bj = 0; bj < 2; ++bj) { const int gc = (u.pn & 1) * 256 + bj * 128 + wc * 32 + 8 * fq;
                EPI_ST(u32x4, FO + ((size_t)b * 8192 + s) * 512 + gc, pack8(acc[0][bj][m][0], acc[0][bj][m][1])); } }
    }
};
struct EpiQ {
    static constexpr bool PERM = true, MIDK = false, I8 = false;
    bf16_t* __restrict__ Q; const float* __restrict__ SSQ; const float* __restrict__ RC; const float* __restrict__ RS;
    __device__ __forceinline__ void operator()(AccRef acc, const UnitPN& u, int wr, int wc, int fr, int fq) const {
        const int g0 = u.pn * 8 + wc, g1 = g0 + 4; const bool rope = (g0 % 3 == 2) || (g1 % 3 == 2);
#pragma unroll
        for (int ai = 0; ai < 2; ++ai) {
            f32x4 sq[4], cs[4], sn[4];
#pragma unroll
            for (int m = 0; m < 4; ++m) { const int row = u.pm * 256 + ai * 128 + wr * 64 + m * 16 + fr; sq[m] = *(const f32x4*)(SSQ + (size_t)row * 4);
                if (rope) { cs[m] = *(const f32x4*)(RC + (size_t)row * 16 + 4 * fq); sn[m] = *(const f32x4*)(RS + (size_t)row * 16 + 4 * fq); } else { cs[m] = sq[m]; sn[m] = sq[m]; } }
#pragma unroll
            for (int m = 0; m < 4; ++m) { const int row = u.pm * 256 + ai * 128 + wr * 64 + m * 16 + fr;
                const float rs = C2 * __builtin_amdgcn_rsqf(((sq[m][0] + sq[m][1]) + (sq[m][2] + sq[m][3])) * (1.0f / 256.0f) + EPS);
#pragma unroll
                for (int bj = 0; bj < 2; ++bj) { const int g32 = u.pn * 8 + bj * 4 + wc; const int hh = g32 / 3, part = g32 - 3 * hh;
                    const f32x4 v0 = acc[ai][bj][m][0] * rs, v1 = acc[ai][bj][m][1] * rs;
                    if (part < 2) { EPI_ST(u32x4, Q + (size_t)row * QC + g32 * 32 + 8 * fq, pack8(v0, v1)); }
                    else { bf16_t* qp = Q + (size_t)row * QC + hh * 96 + 64 + 4 * fq;
                        *(u32x2*)qp = pack4(v0 * cs[m] - v1 * sn[m]); EPI_ST(u32x2, qp + 16, pack4(v1 * cs[m] + v0 * sn[m])); } } }
        }
    }
};
struct EpiKV {
    static constexpr bool PERM = true, MIDK = false, I8 = false;
    bf16_t* __restrict__ KB; bf16_t* __restrict__ VB; const float* __restrict__ SSQ;
    __device__ __forceinline__ void operator()(AccRef acc, const UnitPN& u, int wr, int wc, int fr, int fq) const {
        f32x4 sq[2][4];
        EPI_LOOP_AM { const int row = u.pm * 256 + ai * 128 + wr * 64 + m * 16 + fr; sq[ai][m] = *(const f32x4*)(SSQ + (size_t)row * 4); }
        EPI_LOOP_AM { const int row = u.pm * 256 + ai * 128 + wr * 64 + m * 16 + fr; const int b = row >> 13, s = row & 8191;
            const float rs = __builtin_amdgcn_rsqf(((sq[ai][m][0] + sq[ai][m][1]) + (sq[ai][m][2] + sq[ai][m][3])) * (1.0f / 256.0f) + EPS);
#pragma unroll
            for (int bj = 0; bj < 2; ++bj) { const int c = (u.pn & 1) * 256 + bj * 128 + wc * 32 + 8 * fq; const int hh = c >> 6, d = c & 63;
                const u32x4 w = pack8(acc[ai][bj][m][0] * rs, acc[ai][bj][m][1] * rs);
                if (u.pn < 2) EPI_ST(u32x4, KB + (((size_t)(b * 8 + hh) * 128 + (s >> 6)) * 12 + (d >> 3)) * 512 + (s & 63) * 8, w);
                else EPI_ST(u32x4, VB + (((size_t)(b * 8 + hh) * 128 + (s >> 6)) * 8 + (d >> 5) * 4 + ((s & 63) >> 4)) * 512 + (s & 15) * 32 + (d & 31), w); } }
    }
};
struct EpiMerge2 {
    static constexpr bool PERM = true, MIDK = true, I8 = false;
    bf16_t* __restrict__ MRG; const unsigned char* __restrict__ GATE;
    __device__ __forceinline__ void mid(f32x4 (&acc)[2][2][4][2], const UnitPN& u, int wr, int wc, int fr, int fq) const {
#pragma unroll
        for (int ai = 0; ai < 2; ++ai) {
            u32x2 ga[4][2], gf[4][2];
#pragma unroll
            for (int m = 0; m < 4; ++m)
#pragma unroll
                for (int bj = 0; bj < 2; ++bj) { ga[m][bj] = *(const u32x2*)(GATE + gate_off(u.pm, 0, u.pn, wr * 4 + wc, ai, bj, m, fq * 16 + fr)); gf[m][bj] = *(const u32x2*)(GATE + gate_off(u.pm, 1, u.pn, wr * 4 + wc, ai, bj, m, fq * 16 + fr)); }
#pragma unroll
            for (int m = 0; m < 4; ++m)
#pragma unroll
                for (int bj = 0; bj < 2; ++bj) { const u32x2 a = ga[m][bj], f = gf[m][bj];
#pragma unroll
                    for (int j = 0; j < 4; ++j) { const float fa0 = (float)((a.x >> (8 * j)) & 0xffu), fa1 = (float)((a.y >> (8 * j)) & 0xffu);
                        const float ff0 = fmaxf((float)((f.x >> (8 * j)) & 0xffu), 1.0f), ff1 = fmaxf((float)((f.y >> (8 * j)) & 0xffu), 1.0f);
                        acc[ai][bj][m][0][j] *= fa0 * __builtin_amdgcn_rcpf(ff0); acc[ai][bj][m][1][j] *= fa1 * __builtin_amdgcn_rcpf(ff1); } }
        }
    }
    __device__ __forceinline__ void operator()(AccRef acc, const UnitPN& u, int wr, int wc, int fr, int fq) const {
#pragma unroll
        for (int ai = 0; ai < 2; ++ai) {
            u32x2 gf[4][2];
#pragma unroll
            for (int m = 0; m < 4; ++m)
#pragma unroll
                for (int bj = 0; bj < 2; ++bj) gf[m][bj] = *(const u32x2*)(GATE + gate_off(u.pm, 1, u.pn, wr * 4 + wc, ai, bj, m, fq * 16 + fr));
#pragma unroll
            for (int m = 0; m < 4; ++m)
#pragma unroll
                for (int bj = 0; bj < 2; ++bj) { const int row = u.pm * 256 + ai * 128 + wr * 64 + m * 16 + fr, col = u.pn * 256 + bj * 128 + wc * 32 + 8 * fq; const u32x2 f = gf[m][bj];
                    f32x4 v0 = acc[ai][bj][m][0] * (1.0f / 255.0f), v1 = acc[ai][bj][m][1] * (1.0f / 255.0f);
#pragma unroll
                    for (int j = 0; j < 4; ++j) { v0[j] *= fmaxf((float)((f.x >> (8 * j)) & 0xffu), 1.0f); v1[j] *= fmaxf((float)((f.y >> (8 * j)) & 0xffu), 1.0f); }
                    EPI_ST(u32x4, MRG + (size_t)row * 1024 + col, pack8(v0, v1)); }
        }
    }
};
struct EpiH {
    static constexpr bool PERM = true, MIDK = false, I8 = false;
    const float* __restrict__ X; bf16_t* __restrict__ Hout; const float* __restrict__ MODF;
    __device__ __forceinline__ void operator()(AccRef acc, const UnitPN& u, int wr, int wc, int fr, int fq) const {
        const int b = u.pm >> 5; const int col0 = u.pn * 256 + wc * 32 + 8 * fq;
        f32x4 gt[2][2];
#pragma unroll
        for (int bj = 0; bj < 2; ++bj)
#pragma unroll
            for (int n = 0; n < 2; ++n) gt[bj][n] = *(const f32x4*)(MODF + (size_t)b * 8192 + 2048 + col0 + bj * 128 + n * 4);
#pragma unroll
        for (int ai = 0; ai < 2; ++ai)
#pragma unroll
            for (int mp = 0; mp < 2; ++mp) {
                f32x4 xv[2][2][2];
#pragma unroll
                for (int mm = 0; mm < 2; ++mm)
#pragma unroll
                    for (int bj = 0; bj < 2; ++bj) { const size_t off = (size_t)(u.pm * 256 + ai * 128 + wr * 64 + (2 * mp + mm) * 16 + fr) * 1024 + col0;
                        xv[mm][bj][0] = *(const f32x4*)(X + off + bj * 128); xv[mm][bj][1] = *(const f32x4*)(X + off + bj * 128 + 4); }
#pragma unroll
                for (int mm = 0; mm < 2; ++mm)
#pragma unroll
                    for (int bj = 0; bj < 2; ++bj) { const int m = 2 * mp + mm; const size_t off = (size_t)(u.pm * 256 + ai * 128 + wr * 64 + m * 16 + fr) * 1024 + col0;
                        EPI_ST(u32x4, Hout + off + bj * 128, pack8(xv[mm][bj][0] + gt[bj][0] * acc[ai][bj][m][0], xv[mm][bj][1] + gt[bj][1] * acc[ai][bj][m][1])); }
            }
    }
};
struct EpiUp {
    static constexpr bool PERM = true, MIDK = false, I8 = false;
    bf16_t* HID;
    __device__ __forceinline__ void operator()(AccRef acc, const MoeUnit& u, int wr, int wc, int fr, int fq) const {
        EPI_LOOP_AM { const int lr = ai * 128 + wr * 64 + m * 16 + fr;
#pragma unroll
            for (int bj = 0; bj < 2; ++bj) { const int hh = u.pn * 128 + bj * 64 + wc * 16 + 4 * fq;
                const f32x4 g = acc[ai][bj][m][0], uu = acc[ai][bj][m][1]; f32x4 o;
#pragma unroll
                for (int j = 0; j < 4; ++j) o[j] = g[j] * sigmoidf_(g[j]) * uu[j];
                EPI_ST(u32x2, HID + (size_t)(u.orow + lr) * 256 + hh, pack4(o)); } }
    }
};
struct EpiDown {
    static constexpr bool PERM = true, MIDK = false, I8 = false;
    bf16_t* __restrict__ Y2;
    __device__ __forceinline__ void operator()(AccRef acc, const MoeUnit& u, int wr, int wc, int fr, int fq) const {
        EPI_LOOP_AM { const size_t row = (size_t)u.orow + ai * 128 + wr * 64 + m * 16 + fr;
#pragma unroll
            for (int bj = 0; bj < 2; ++bj) { const int col = u.pn * 256 + bj * 128 + wc * 32 + 8 * fq;
                EPI_ST(u32x4, Y2 + row * 1024 + col, pack8(acc[ai][bj][m][0], acc[ai][bj][m][1])); } }
    }
};

#ifdef PROBE_KLOOP
struct EpiNull {
    static constexpr bool PERM = true, MIDK = false, I8 = false;
    float* sink; int never;
    __device__ __forceinline__ void operator()(AccRef acc, const UnitPN& u, int wr, int wc, int fr, int fq) const {
        if (never < 0) { f32x4 s = acc[0][0][0][0];
            EPI_LOOP_AM { s += acc[ai][0][m][0] + acc[ai][0][m][1] + acc[ai][1][m][0] + acc[ai][1][m][1]; }
            *(f32x4*)(sink + fr) = s; }
    }
};
#endif

typedef const i32x4 (&AccRefI)[2][2][4][2];
__device__ __forceinline__ f32x4 i2f(const i32x4 v, float s) { return (f32x4){(float)v[0] * s, (float)v[1] * s, (float)v[2] * s, (float)v[3] * s}; }
struct EpiZ8 {
    static constexpr bool PERM = true, MIDK = false, I8 = true;
    unsigned char* __restrict__ ws; const float* __restrict__ bg;
    __device__ __forceinline__ void operator()(AccRefI acc, const UnitPN& u, int wr, int wc, int fr_, int fq_) const {
        int fr = fr_, fq = fq_; asm volatile("" : "+v"(fr), "+v"(fq));
        const int row0 = u.pm * 256 + wr * 64 + fr, c0 = wc * 32 + 8 * fq;
        const float* SU = (const float*)(ws + WS_SU);
        const float sw = __uint_as_float(((const unsigned*)(ws + WS_CTL))[CW_WMAX]) * (1.0f / 127.0f);
        if (u.pn < 2) {
            bf16_t* O = (bf16_t*)(ws + (u.pn ? WS_KVL : WS_QL)); float* SS = (float*)(ws + (u.pn ? WS_SSQKV : WS_SSQQ));
            EPI_LOOP_AM { const int row = row0 + ai * 128 + m * 16; float s = 0.f; const float su_ = SU[row] * sw;
#pragma unroll
                for (int bj = 0; bj < 2; ++bj) { const f32x4 v0 = i2f(acc[ai][bj][m][0], su_), v1 = i2f(acc[ai][bj][m][1], su_);
                    s += (v0[0] * v0[0] + v0[1] * v0[1]) + (v0[2] * v0[2] + v0[3] * v0[3]) + (v1[0] * v1[0] + v1[1] * v1[1]) + (v1[2] * v1[2] + v1[3] * v1[3]);
                    EPI_ST(u32x4, O + (size_t)row * 256 + bj * 128 + c0, pack8(v0, v1)); }
                s += __shfl_xor(s, 16); s += __shfl_xor(s, 32);
                if (fq == 0) SS[(size_t)row * 4 + wc] = s; }
        } else if (u.pn < 10) {
            const int gc0 = (u.pn - 2) * 256 + c0;
#pragma unroll
            for (int bj = 0; bj < 2; ++bj) {
                const f32x4 bv0 = *(const f32x4*)(bg + gc0 + bj * 128), bv1 = *(const f32x4*)(bg + gc0 + bj * 128 + 4);
                EPI_LOOP_AM { const int row = row0 + ai * 128 + m * 16; const float su_ = SU[row] * sw;
                    const f32x4 v0 = i2f(acc[ai][bj][m][0], su_) + bv0, v1 = i2f(acc[ai][bj][m][1], su_) + bv1;
                    u32x2 w;
                    w.x = q8(v0[0]) | (q8(v0[1]) << 8) | (q8(v0[2]) << 16) | (q8(v0[3]) << 24); w.y = q8(v1[0]) | (q8(v1[1]) << 8) | (q8(v1[2]) << 16) | (q8(v1[3]) << 24);
                    EPI_ST(u32x2, ws + WS_GATE + gate_off(u.pm, (u.pn - 2) >> 2, (u.pn - 2) & 3, wr * 4 + wc, ai, bj, m, fq * 16 + fr), w); }
            }
        } else if (wc == 0) {
            f32x4 cs[2][4], sn[2][4];
            EPI_LOOP_AM { const int row = row0 + ai * 128 + m * 16; cs[ai][m] = *(const f32x4*)((const float*)(ws + WS_ROPEC) + (size_t)row * 16 + 4 * fq); sn[ai][m] = *(const f32x4*)((const float*)(ws + WS_ROPES) + (size_t)row * 16 + 4 * fq); }
            EPI_LOOP_AM { const int row = row0 + ai * 128 + m * 16; const int b = row >> 13, s = row & 8191; const float su_ = SU[row] * sw;
                const f32x4 x1 = i2f(acc[ai][0][m][0], su_), x2 = i2f(acc[ai][0][m][1], su_);
                const u32x2 p1 = pack4(x1 * cs[ai][m] - x2 * sn[ai][m]), p2 = pack4(x2 * cs[ai][m] + x1 * sn[ai][m]);
#pragma unroll
                for (int h = 0; h < 8; ++h) { bf16_t* kp = (bf16_t*)(ws + WS_K) + (((size_t)(b * 8 + h) * 128 + (s >> 6)) * 12 + 8 + (fq >> 1)) * 512 + (s & 63) * 8 + 4 * (fq & 1); EPI_ST(u32x2, kp, p1); EPI_ST(u32x2, kp + 1024, p2); } }
        }
    }
};
struct EpiF18 {
    static constexpr bool PERM = true, MIDK = false, I8 = true;
    unsigned char* __restrict__ ws;
    __device__ __forceinline__ void operator()(AccRefI acc, const UnitPN& u, int wr, int wc, int fr, int fq) const {
        const int b = u.pn >> 5, tt = u.pn & 31;
        const float* SU = (const float*)(ws + WS_SU); bf16_t* YT2 = (bf16_t*)(ws + WS_YT2);
        const float sw = __uint_as_float(((const unsigned*)(ws + WS_CTL))[CW_WMAX + 1]) * (1.0f / 127.0f);
#pragma unroll
        for (int bj = 0; bj < 2; ++bj) {
            float sc[8];
#pragma unroll
            for (int i = 0; i < 8; ++i) sc[i] = SU[(size_t)b * 8192 + (2 * tt + bj) + 64 * (wc * 32 + 8 * fq + i)] * sw;
            EPI_LOOP_AM { const int r = u.pm * 256 + ai * 128 + wr * 64 + m * 16 + fr; const int ri = r & 1, gc = r >> 1; const int sa = 2 * tt + bj, sb = wc * 32 + 8 * fq;
                const i32x4 a0 = acc[ai][bj][m][0], a1 = acc[ai][bj][m][1];
                const f32x4 v0 = {(float)a0[0] * sc[0], (float)a0[1] * sc[1], (float)a0[2] * sc[2], (float)a0[3] * sc[3]};
                const f32x4 v1 = {(float)a1[0] * sc[4], (float)a1[1] * sc[5], (float)a1[2] * sc[6], (float)a1[3] * sc[7]};
                EPI_ST(u32x4, YT2 + ((((size_t)b * 512 + gc) * 64 + sa) * 2 + ri) * 128 + sb, pack8(v0, v1)); }
        }
    }
};
struct EpiUp8 {
    static constexpr bool PERM = true, MIDK = false, I8 = true;
    unsigned char* __restrict__ ws;
    __device__ __forceinline__ void operator()(AccRefI acc, const MoeUnit& u, int wr, int wc, int fr, int fq) const {
        bf16_t* HID = (bf16_t*)(ws + WS_Q); const u32x2* list = (const u32x2*)(ws + WS_LIST);
        const float sw = __uint_as_float(((const unsigned*)(ws + WS_CTL))[CW_WMAX + 2 + u.e]) * (1.0f / 127.0f);
        float sr[2][4];
        EPI_LOOP_AM { const int li = u.row0 + ai * 128 + wr * 64 + m * 16 + fr; sr[ai][m] = __uint_as_float(list[(size_t)u.e * 65536 + (li < u.cnt ? li : 0)].y) * sw; }
        EPI_LOOP_AM { const int lr = ai * 128 + wr * 64 + m * 16 + fr; const int hh = u.pn * 128 + wc * 32 + 8 * fq;
            u32x2 w[2];
#pragma unroll
            for (int bj = 0; bj < 2; ++bj) { const f32x4 g = i2f(acc[ai][bj][m][0], sr[ai][m]), uu = i2f(acc[ai][bj][m][1], sr[ai][m]); f32x4 o;
#pragma unroll
                for (int j = 0; j < 4; ++j) o[j] = g[j] * sigmoidf_(g[j]) * uu[j];
                w[bj] = pack4(o); }
            EPI_ST(u32x4, HID + (size_t)(u.orow + lr) * 256 + hh, ((u32x4){w[0].x, w[0].y, w[1].x, w[1].y})); }
    }
};

namespace att {
constexpr int NW = 8, KVBLK = 64, NT = SEQ / KVBLK, UROWS = 512;
constexpr int KSLOT = 12288, VSLOT = 8192, NSK = 3, NSV = 4;
constexpr int L_K = 0, L_V = NSK * KSLOT, L_WS = L_V + NSV * VSLOT, L_Q = L_WS + NW * 64 * 4, L_OST = L_Q, BYTES = L_Q + NW * 6144;
#define SBAR() __builtin_amdgcn_sched_barrier(0)
typedef short v4i16_t __attribute__((ext_vector_type(4)));
__device__ __forceinline__ int crow(int r, int hi) { return (r & 3) + 8 * (r >> 2) + 4 * hi; }
__device__ __forceinline__ s16x4 vtr(const LAS unsigned char* p) { return __builtin_bit_cast(s16x4, __builtin_amdgcn_ds_read_tr16_b64_v4i16((LAS v4i16_t*)p)); }
#define MF(a, b, c) __builtin_amdgcn_mfma_f32_32x32x16_bf16(a, b, c, 0, 0, 0)

__device__ __forceinline__ void attn_unit(const bf16_t* __restrict__ Qb, const bf16_t* __restrict__ Kt, const bf16_t* __restrict__ Vt, bf16_t* __restrict__ Ob, LAS unsigned char* lds) {
    const int tid = threadIdx.x, lane = tid & 63, r32 = lane & 31, hi = lane >> 5; const int wid = __builtin_amdgcn_readfirstlane(tid >> 6);
    const bool late = false;
    LAS float* wsf = (LAS float*)(lds + L_WS) + wid * 64;
    const unsigned voff = (unsigned)lane * 16u; const unsigned ldsbase = (unsigned)(uintptr_t)lds;
    const char* kbA = (const char*)Kt + wid * 1024; const char* kbB = (const char*)Kt + (8 + (wid & 3)) * 1024; const char* vbs = (const char*)Vt + wid * 1024;
    const int kdA = L_K + wid * 1024, kdB = L_K + (8 + (wid & 3)) * 1024, vd = L_V + wid * 1024;
#define GLDS(base, ldsoff) do { unsigned keep_; asm volatile("s_mov_b32 %0, m0\n\ts_mov_b32 m0, %3\n\ts_nop 0\n\tglobal_load_lds_dwordx4 %1, %2\n\ts_mov_b32 m0, %0" \
        : "=&s"(keep_) : "v"(voff), "s"(base), "s"((unsigned)(ldsbase + (ldsoff))) : "memory"); } while (0)
#define DMA_K(t, s) do { const int t_ = (t) < NT ? (t) : NT - 1; GLDS(kbA + (size_t)t_ * 12288, kdA + (s) * KSLOT); GLDS(kbB + (size_t)t_ * 12288, kdB + (s) * KSLOT); } while (0)
#define DMA_V(t, s) do { const int t_ = (t) < NT ? (t) : NT - 1; GLDS(vbs + (size_t)t_ * 8192, vd + (s) * VSLOT); } while (0)
#define WAIT_BAR(N) do { asm volatile("s_waitcnt vmcnt(" #N ") lgkmcnt(0)" ::: "memory"); __builtin_amdgcn_s_barrier(); asm volatile("" ::: "memory"); } while (0)
    const LAS unsigned char* kp0 = lds + L_K + hi * 1024 + r32 * 16;
    const LAS unsigned char* vp0 = lds + L_V + ((lane >> 4) & 1) * 32 + (lane & 3) * 8 + (4 * hi + ((lane & 15) >> 2)) * 64;
    DMA_K(0, 0); DMA_V(0, 0); DMA_K(1, 1); DMA_V(1, 1);
    bf16x8 qa[6];
    const LAS unsigned char* qbp = lds + L_Q + wid * 6144 + hi * 512 + r32 * 16;
    { const bf16_t* Qw = Qb + (size_t)(wid * 64 + r32) * QC + hi * 8;
#pragma unroll
      for (int d0 = 0; d0 < 6; ++d0) { qa[d0] = *reinterpret_cast<const bf16x8*>(Qw + d0 * 16); const bf16x8 qv = *reinterpret_cast<const bf16x8*>(Qw + (size_t)32 * QC + d0 * 16);
          *(LAS bf16x8*)(lds + L_Q + wid * 6144 + hi * 512 + r32 * 16 + d0 * 1024) = qv; } }
    bf16x8 qb0, qb1, qb2, qb3, qb4, qb5;
    { const bf16_t* Qw = Qb + (size_t)(wid * 64 + 32 + r32) * QC + hi * 8; qb0 = *reinterpret_cast<const bf16x8*>(Qw); qb1 = *reinterpret_cast<const bf16x8*>(Qw + 16); qb2 = *reinterpret_cast<const bf16x8*>(Qw + 32); qb3 = *reinterpret_cast<const bf16x8*>(Qw + 48); qb4 = *reinterpret_cast<const bf16x8*>(Qw + 64); qb5 = *reinterpret_cast<const bf16x8*>(Qw + 80); }
    f32x16 oA0 = f32x16{}, oA1 = f32x16{}, oB0 = f32x16{}, oB1 = f32x16{};
    u32x4 pA0, pA1, pA2, pA3, pB0, pB1, pB2, pB3;
    float lA = 0.f, lB = 0.f;
    WAIT_BAR(0);
#define PKW(P, B) cvt_pk_bf16(P[B], P[B + 1])
#define PAF(w) __builtin_bit_cast(bf16x8, w)
#define EX4(X, B) do { X[B] = __builtin_amdgcn_exp2f(X[B]); X[B + 1] = __builtin_amdgcn_exp2f(X[B + 1]); X[B + 2] = __builtin_amdgcn_exp2f(X[B + 2]); X[B + 3] = __builtin_amdgcn_exp2f(X[B + 3]); } while (0)
#define EX16(X) do { EX4(X, 0); EX4(X, 4); EX4(X, 8); EX4(X, 12); } while (0)
#define SUM16(L, X) do { L += ((X[0] + X[1]) + (X[2] + X[3])) + ((X[4] + X[5]) + (X[6] + X[7])) + ((X[8] + X[9]) + (X[10] + X[11])) + ((X[12] + X[13]) + (X[14] + X[15])); } while (0)
#define PACK(W0, W1, X) do { W0 = (u32x4){PKW(X, 0), PKW(X, 2), PKW(X, 4), PKW(X, 6)}; W1 = (u32x4){PKW(X, 8), PKW(X, 10), PKW(X, 12), PKW(X, 14)}; } while (0)
#define KRD(d0) do { ka##d0 = *(const LAS bf16x8*)(kpn + (d0) * 2048); kb##d0 = *(const LAS bf16x8*)(kpn + (d0) * 2048 + 512); } while (0)
#define VRD(i) do { l##i = vtr(vp_ + (((i) >> 2) * 4096 + ((i) & 3) * 1024)); h##i = vtr(vp_ + (((i) >> 2) * 4096 + ((i) & 3) * 1024 + 512)); } while (0)
#define VFR(i) ((bf16x8){l##i[0], l##i[1], l##i[2], l##i[3], h##i[0], h##i[1], h##i[2], h##i[3]})
#define PV(vsl) do { const LAS unsigned char* vp_ = vp0 + (vsl) * VSLOT; s16x4 l0, h0, l1, h1, l2, h2, l3, h3, l4, h4, l5, h5, l6, h6, l7, h7; \
    VRD(0); VRD(4); VRD(1); __builtin_amdgcn_s_setprio(1); SBAR(); \
    oA0 = MF(PAF(pA0), VFR(0), oA0); oB0 = MF(PAF(pB0), VFR(0), oB0); VRD(5); SBAR(); \
    oA1 = MF(PAF(pA0), VFR(4), oA1); oB1 = MF(PAF(pB0), VFR(4), oB1); VRD(2); SBAR(); \
    oA0 = MF(PAF(pA1), VFR(1), oA0); oB0 = MF(PAF(pB1), VFR(1), oB0); VRD(6); SBAR(); \
    oA1 = MF(PAF(pA1), VFR(5), oA1); oB1 = MF(PAF(pB1), VFR(5), oB1); VRD(3); SBAR(); \
    oA0 = MF(PAF(pA2), VFR(2), oA0); oB0 = MF(PAF(pB2), VFR(2), oB0); VRD(7); SBAR(); \
    oA1 = MF(PAF(pA2), VFR(6), oA1); oB1 = MF(PAF(pB2), VFR(6), oB1); SBAR(); \
    oA0 = MF(PAF(pA3), VFR(3), oA0); oB0 = MF(PAF(pB3), VFR(3), oB0); SBAR(); \
    oA1 = MF(PAF(pA3), VFR(7), oA1); oB1 = MF(PAF(pB3), VFR(7), oB1); __builtin_amdgcn_s_setprio(0); SBAR(); } while (0)
#define STEP(t, ks, vs, HASP) do { \
    if (late && (HASP)) { PV(((vs) + 3) & 3); } \
    { const LAS unsigned char* kpn = kp0 + (ks) * KSLOT; bf16x8 ka0, kb0, ka1, kb1, ka2, kb2, ka3, kb3, ka4, kb4, ka5, kb5; \
      f32x16 sA0, sA1, sB0, sB1; const f32x16 z16 = f32x16{}; \
      KRD(0); KRD(1); __builtin_amdgcn_s_setprio(1); SBAR(); \
      sA0 = MF(ka0, qa[0], z16); sB0 = MF(ka0, qb0, z16); sA1 = MF(kb0, qa[0], z16); sB1 = MF(kb0, qb0, z16); KRD(2); SBAR(); \
      sA0 = MF(ka1, qa[1], sA0); sB0 = MF(ka1, qb1, sB0); sA1 = MF(kb1, qa[1], sA1); sB1 = MF(kb1, qb1, sB1); KRD(3); SBAR(); \
      sA0 = MF(ka2, qa[2], sA0); sB0 = MF(ka2, qb2, sB0); sA1 = MF(kb2, qa[2], sA1); sB1 = MF(kb2, qb2, sB1); KRD(4); SBAR(); \
      sA0 = MF(ka3, qa[3], sA0); sB0 = MF(ka3, qb3, sB0); sA1 = MF(kb3, qa[3], sA1); sB1 = MF(kb3, qb3, sB1); KRD(5); SBAR(); \
      sA0 = MF(ka4, qa[4], sA0); sB0 = MF(ka4, qb4, sB0); sA1 = MF(kb4, qa[4], sA1); sB1 = MF(kb4, qb4, sB1); SBAR(); \
      sA0 = MF(ka5, qa[5], sA0); sB0 = MF(ka5, qb5, sB0); sA1 = MF(kb5, qa[5], sA1); sB1 = MF(kb5, qb5, sB1); __builtin_amdgcn_s_setprio(0); SBAR(); \
      EX16(sA0); SUM16(lA, sA0); PACK(pA0, pA1, sA0); SBAR(); \
      EX16(sA1); SUM16(lA, sA1); PACK(pA2, pA3, sA1); SBAR(); \
      EX16(sB0); SUM16(lB, sB0); PACK(pB0, pB1, sB0); SBAR(); \
      EX16(sB1); SUM16(lB, sB1); PACK(pB2, pB3, sB1); SBAR(); } \
    if (!late) { PV(vs); } \
    DMA_V((t) + 2, ((vs) + 2) & 3); DMA_K((t) + 2, ((ks) == 0 ? 2 : (ks) - 1)); \
    WAIT_BAR(3); } while (0)
    int ks = 0, vs = 0;
#pragma unroll 1
    for (int t = 0; t < NT; ++t) {
        STEP(t, ks, vs, (t > 0));
        ks = (ks == 2) ? 0 : ks + 1; vs = (vs + 1) & 3;
    }
    if (late) { PV(3); }
    LAS bf16_t* stg = (LAS bf16_t*)(lds + L_OST) + wid * 2048;
#define OUT_BLOCK(O0, O1, L, blk) do { float l_ = (L); { auto rr = __builtin_amdgcn_permlane32_swap(__float_as_uint(l_), __float_as_uint(l_), false, false); l_ = __uint_as_float(rr[0]) + __uint_as_float(rr[1]); } \
    if (hi == 0) wsf[r32] = l_; \
    asm volatile("s_waitcnt lgkmcnt(0)" ::: "memory"); \
    _Pragma("unroll") for (int r = 0; r < 16; ++r) { const int orow = crow(r, hi); const float rl = __builtin_amdgcn_rcpf(wsf[orow]); \
        stg[orow * 64 + r32] = (bf16_t)(cvt_pk_bf16(O0[r] * rl, 0.f) & 0xffffu); stg[orow * 64 + 32 + r32] = (bf16_t)(cvt_pk_bf16(O1[r] * rl, 0.f) & 0xffffu); } \
    asm volatile("s_waitcnt lgkmcnt(0)" ::: "memory"); \
    { bf16_t* Ow = Ob + (size_t)(wid * 64 + (blk) * 32) * 512; \
      _Pragma("unroll") for (int i = 0; i < 4; ++i) { const int row = i * 8 + (lane >> 3), ch = lane & 7; const u32x4 v = *(const LAS u32x4*)(stg + row * 64 + ch * 8); *(u32x4*)(Ow + (size_t)row * 512 + ch * 8) = v; } } \
    asm volatile("s_waitcnt lgkmcnt(0)" ::: "memory"); } while (0)
    OUT_BLOCK(oA0, oA1, lA, 0);
    OUT_BLOCK(oB0, oB1, lB, 1);
    WAIT_BAR(0);
#undef GLDS
#undef DMA_K
#undef DMA_V
#undef WAIT_BAR
#undef PKW
#undef PAF
#undef EX16
#undef EX4
#undef SUM16
#undef PACK
#undef KRD
#undef VRD
#undef VFR
#undef PV
#undef STEP
#undef OUT_BLOCK
}
#undef SBAR
#undef MF
}

struct Args { const float* in[27]; float* out; unsigned char* ws; int ph_lo, ph_hi, li, pad; };
struct Frame {
    LAS unsigned char* lds; int tid, lane, wave, vcu, G;
};
__device__ __forceinline__ unsigned f2bf(float f) { unsigned u = __builtin_bit_cast(unsigned, f); return (u + 0x7fffu + ((u >> 16) & 1u)) >> 16; }
__device__ __forceinline__ unsigned pk2(float lo, float hi) { return f2bf(lo) | (f2bf(hi) << 16); }

__device__ __forceinline__ float wave_max(float v) {
#pragma unroll
    for (int o = 1; o < 64; o <<= 1) v = fmaxf(v, __shfl_xor(v, o));
    return v;
}
template <class RM>
__device__ __forceinline__ void tr_item(const float* __restrict__ W, int ldw, int k0, int n0, const float* __restrict__ kscale, bf16_t* WT, int Kdst, const RM& rm, LAS float* scr, int lane, unsigned* wmaxp = nullptr) {
    float amax = 0.f;
#pragma unroll 8
    for (int i = 0; i < 32; ++i) { const int kk = 2 * i + (lane >> 5); float v = W[(size_t)(k0 + kk) * ldw + n0 + (lane & 31)]; if (kscale) v *= kscale[k0 + kk]; scr[kk * 33 + (lane & 31)] = v; amax = fmaxf(amax, fabsf(v)); }
    if (wmaxp) { amax = wave_max(amax); if (lane == 0) atomicMax(wmaxp, __float_as_uint(amax)); }
    LDS_WAIT(); asm volatile("" ::: "memory");
    const int c = lane & 7;
#pragma unroll
    for (int j = 0; j < 4; ++j) { const int n = (lane >> 3) + 8 * j; const LAS float* s = scr + (8 * c) * 33 + n;
        u32x4 o; o.x = pk2(s[0 * 33], s[1 * 33]); o.y = pk2(s[2 * 33], s[3 * 33]); o.z = pk2(s[4 * 33], s[5 * 33]); o.w = pk2(s[6 * 33], s[7 * 33]);
        *(u32x4*)(WT + (size_t)rm(n0 + n) * Kdst + k0 + 8 * c) = o; }
    LDS_WAIT(); asm volatile("" ::: "memory");
}
__device__ __forceinline__ int rope_pos(int i) { return 8 * ((i & 15) >> 2) + 4 * (i >> 4) + (i & 3); }
struct RmIdent { int off; __device__ __forceinline__ int operator()(int n) const { return n + off; } };
struct RmWin { __device__ __forceinline__ int operator()(int n) const { return n < 512 ? n : (n < 544 ? 2560 + rope_pos(n - 512) : 512 + (n - 1056)); } };
struct RmUq { __device__ __forceinline__ int operator()(int n) const { const int h = n / 96, d = n - 96 * h; return d < 64 ? n : 96 * h + 64 + rope_pos(d - 64); } };
struct RmGu { int up; __device__ __forceinline__ int operator()(int hh) const { return 256 * (hh >> 7) + 128 * ((hh >> 2) & 1) + 32 * ((hh >> 5) & 3) + 8 * ((hh >> 3) & 3) + (hh & 3) + 4 * up; } };

__device__ const double INVF[16] = {1.0, 0.5623413251903491, 0.31622776601683794, 0.1778279410038923, 0.1, 0.05623413251903491, 0.03162277660168379, 0.01778279410038923,
    0.01, 0.005623413251903491, 0.0031622776601683794, 0.0017782794100389228, 0.001, 0.0005623413251903491, 0.00031622776601683794, 0.00017782794100389227};

__device__ __forceinline__ void p0_prologue(const Frame& F, const Args& a) {
    unsigned char* ws = a.ws; unsigned* WMAX = (unsigned*)((gu32*)(ws + WS_CTL) + CW_WMAX);
    {
        LAS float* cact = (LAS float*)(F.lds);
        LAS float* red = (LAS float*)(F.lds + 32768);
        float* MODF = (float*)(ws + WS_MODF);
        const float* c = a.in[1];
        for (int i = F.tid; i < 8192; i += 512) { const int b = i >> 10, k = i & 1023; const float v = c[i]; cact[k * 8 + b] = v * sigmoidf_(v); }
        __syncthreads();
        for (int it = blockIdx.x; it < 128; it += F.G) {
            const int n = it * 64 + F.lane, kg = F.wave;
            const float* W = (n < 6144) ? (a.in[3] + n) : (a.in[24] + (n - 6144)); const int ldw = (n < 6144) ? 6144 : 2048;
            float acc[8];
#pragma unroll
            for (int b = 0; b < 8; ++b) acc[b] = 0.f;
#pragma unroll 8
            for (int k = kg * 128; k < kg * 128 + 128; ++k) { const float w = W[(size_t)k * ldw]; const f32x4 c0 = *(const LAS f32x4*)(cact + k * 8), c1 = *(const LAS f32x4*)(cact + k * 8 + 4);
                acc[0] += c0[0] * w; acc[1] += c0[1] * w; acc[2] += c0[2] * w; acc[3] += c0[3] * w; acc[4] += c1[0] * w; acc[5] += c1[1] * w; acc[6] += c1[2] * w; acc[7] += c1[3] * w; }
#pragma unroll
            for (int b = 0; b < 8; ++b) red[(kg * 8 + b) * 64 + F.lane] = acc[b];
            __syncthreads();
            { const int b = F.tid >> 6, cl = F.tid & 63, nn = it * 64 + cl; float s = 0.f;
#pragma unroll
              for (int q = 0; q < 8; ++q) s += red[(q * 8 + b) * 64 + cl];
              MODF[b * 8192 + nn] = s + (nn < 6144 ? a.in[4][nn] : a.in[25][nn - 6144]); }
            __syncthreads();
        }
        __syncthreads();
    }
    LAS float* scr = (LAS float*)(F.lds + F.wave * 16384);
    const int gw = F.vcu * NWAVES + F.wave, NGW = F.G * NWAVES;
    bf16_t* WIN = (bf16_t*)(ws + WS_WIN); bf16_t* WFY = (bf16_t*)(ws + WS_WFY); bf16_t* WUQ = (bf16_t*)(ws + WS_WUQ); bf16_t* WUKV = (bf16_t*)(ws + WS_WUKV);
    bf16_t* WBA = (bf16_t*)(ws + WS_WBA); bf16_t* WBF = (bf16_t*)(ws + WS_WBF); bf16_t* WOUT = (bf16_t*)(ws + WS_WOUT);
    bf16_t* WGU = (bf16_t*)(ws + WS_WGU); bf16_t* WDN = (bf16_t*)(ws + WS_WDN);
    constexpr int I_WIN = 81 * 16, I_UQ = 24 * 4, I_UK = 16 * 4, I_UV = 16 * 4, I_BA = 32 * 8, I_BF = 32 * 8, I_OUT = 32 * 16, I_G = 32 * 8 * 16, I_U = I_G, I_D = 32 * 32 * 4;
    constexpr int I_FY = 16 * 8 * 4;
    constexpr int NITEMS = I_WIN + I_UQ + I_UK + I_UV + I_BA + I_BF + I_OUT + I_G + I_U + I_D + I_FY;
    for (int it = gw; it < NITEMS; it += NGW) {
        int r = it;
        if (r < I_WIN) { const int kb = r / 81, nbi = r % 81; const int n0 = nbi < 17 ? nbi * 32 : 1056 + (nbi - 17) * 32;
            tr_item(a.in[6], 3104, kb * 64, n0, nullptr, WIN, 1024, RmWin{}, scr, F.lane, WMAX + 0); continue; } r -= I_WIN;
        if (r < I_UQ) { tr_item(a.in[9], 768, (r / 24) * 64, (r % 24) * 32, a.in[7], WUQ, 256, RmUq{}, scr, F.lane); continue; } r -= I_UQ;
        if (r < I_UK) { tr_item(a.in[10], 512, (r / 16) * 64, (r % 16) * 32, a.in[8], WUKV, 256, RmIdent{0}, scr, F.lane); continue; } r -= I_UK;
        if (r < I_UV) { tr_item(a.in[11], 512, (r / 16) * 64, (r % 16) * 32, a.in[8], WUKV, 256, RmIdent{512}, scr, F.lane); continue; } r -= I_UV;
        if (r < I_BA) { tr_item(a.in[12], 1024, (r / 32) * 64, (r % 32) * 32, nullptr, WBA, 1024, RmIdent{0}, scr, F.lane); continue; } r -= I_BA;
        if (r < I_BF) { tr_item(a.in[13], 1024, (r / 32) * 64, (r % 32) * 32, nullptr, WBA + 512, 1024, RmIdent{0}, scr, F.lane); continue; } r -= I_BF;
        if (r < I_OUT) { tr_item(a.in[15], 1024, (r / 32) * 64, (r % 32) * 32, nullptr, WOUT, 1024, RmIdent{0}, scr, F.lane); continue; } r -= I_OUT;
        if (r < I_G) { const int e = r / 128, q = r % 128; tr_item(a.in[21] + (size_t)e * 1024 * 256, 256, (q / 8) * 64, (q % 8) * 32, nullptr, WGU + (size_t)e * 512 * 1024, 1024, RmGu{0}, scr, F.lane, WMAX + 2 + e); continue; } r -= I_G;
        if (r < I_U) { const int e = r / 128, q = r % 128; tr_item(a.in[22] + (size_t)e * 1024 * 256, 256, (q / 8) * 64, (q % 8) * 32, nullptr, WGU + (size_t)e * 512 * 1024, 1024, RmGu{1}, scr, F.lane, WMAX + 2 + e); continue; } r -= I_U;
        if (r < I_D) { const int e = r / 128, q = r % 128; tr_item(a.in[23] + (size_t)e * 256 * 1024, 1024, (q / 32) * 64, (q % 32) * 32, nullptr, WDN + (size_t)e * 1024 * 256, 256, RmIdent{0}, scr, F.lane); continue; } r -= I_D;
        {
            const int kb = r >> 5, g = (r >> 2) & 7, jq = r & 3;
            const float* W = a.in[6] + (size_t)(kb * 64) * 3104 + 544 + 64 * g;
#pragma unroll 8
            for (int kk = 0; kk < 64; ++kk) scr[F.lane * 64 + kk] = W[(size_t)kk * 3104 + F.lane];
            LDS_WAIT(); asm volatile("" ::: "memory");
            float ar[16], ai_[16];
#pragma unroll
            for (int j = 0; j < 16; ++j) { ar[j] = 0.f; ai_[j] = 0.f; }
#pragma unroll 2
            for (int cI = 0; cI < 64; ++cI) { const float xv = scr[cI * 64 + F.lane];
#pragma unroll
                for (int j = 0; j < 16; ++j) { const float ph = (float)((cI * (jq * 16 + j)) & 63) * (1.0f / 64.0f);
                    ar[j] += xv * __builtin_amdgcn_cosf(ph); ai_[j] -= xv * __builtin_amdgcn_sinf(ph); } }
            float amax = 0.f;
#pragma unroll
            for (int j = 0; j < 16; ++j) { const int jj = jq * 16 + j; amax = fmaxf(amax, fmaxf(fabsf(ar[j]), fabsf(ai_[j])) * FNORM);
                WFY[(size_t)((g * 64 + jj) * 2) * 1024 + kb * 64 + F.lane] = (bf16_t)f2bf(ar[j] * FNORM);
                WFY[(size_t)((g * 64 + jj) * 2 + 1) * 1024 + kb * 64 + F.lane] = (bf16_t)f2bf(ai_[j] * FNORM); }
            amax = wave_max(amax); if (F.lane == 0) atomicMax(WMAX + 1, __float_as_uint(amax));
            LDS_WAIT(); asm volatile("" ::: "memory");
        }
    }
    const int gt = F.vcu * 512 + F.tid, NGT = F.G * 512;
    { float* RC = (float*)(ws + WS_ROPEC); float* RS = (float*)(ws + WS_ROPES); const int* pos = (const int*)a.in[2];
        for (int i = gt; i < T * 16; i += NGT) { const int t = i >> 4, f = i & 15; const double rev = (double)pos[t] * INVF[f] * 0.15915494309189535; const float fr = (float)(rev - __builtin_floor(rev));
            RC[i] = __builtin_amdgcn_cosf(fr); RS[i] = __builtin_amdgcn_sinf(fr); } }
    { bf16_t* DFTA = (bf16_t*)(ws + WS_DFTA);
        for (int i = gt; i < 256 * 256; i += NGT) { const int r = i >> 8, cI = i & 255; const int rip = r >> 7, kb = r & 127, ri = cI >> 7, sb = cI & 127;
            const float ph = (float)((sb * kb) & 127) * (1.0f / 128.0f); const float cs = __builtin_amdgcn_cosf(ph), sn = __builtin_amdgcn_sinf(ph);
            const float v = (rip == ri) ? cs : (rip == 0 ? sn : -sn); DFTA[i] = (bf16_t)f2bf(v); } }
    { bf16_t* TB2 = (bf16_t*)(ws + WS_TB2);
        for (int i = gt; i < 64 * 128 * 256; i += NGT) { const int pair = i >> 15, r = (i >> 8) & 127, cI = i & 255; const int kbp = r >> 6, ka = r & 63, kbpp = cI >> 7, ri = (cI >> 6) & 1, sa = cI & 63;
            const int kbb = 2 * pair + kbp; const float ph = (float)((sa * (kbb + 128 * ka)) & 8191) * (1.0f / 8192.0f);
            const float v = (kbp == kbpp) ? (ri ? __builtin_amdgcn_sinf(ph) : __builtin_amdgcn_cosf(ph)) : 0.f; TB2[i] = (bf16_t)f2bf(v); } }
}

__device__ __forceinline__ unsigned q8s(float v) { return (unsigned)(int)fminf(fmaxf(__builtin_rintf(v), -127.f), 127.f) & 0xffu; }
__device__ __forceinline__ void p1_norm(const Frame& F, const Args& a) {
    unsigned char* ws = a.ws; const float* MODF = (const float*)(ws + WS_MODF);
    const unsigned* WMAX = (const unsigned*)((gu32*)(ws + WS_CTL) + CW_WMAX);
    {
        const bf16_t* WIN = (const bf16_t*)(ws + WS_WIN); const bf16_t* WFY = (const bf16_t*)(ws + WS_WFY); const bf16_t* WGU = (const bf16_t*)(ws + WS_WGU);
        u32x2* W8IN = (u32x2*)(ws + WS_W8IN); u32x2* W8FY = (u32x2*)(ws + WS_W8FY); u32x2* W8GU = (u32x2*)(ws + WS_W8GU);
        constexpr int C_IN = NWIN * 1024 / 8, C_FY = 1024 * 1024 / 8, C_GU = 32 * 512 * 1024 / 8;
        const int gt = F.vcu * 512 + F.tid, NGT = F.G * 512;
        for (int i = gt; i < C_IN + C_FY + C_GU; i += NGT) {
            const bf16_t* src; u32x2* dst; float wm;
            if (i < C_IN) { src = WIN + (size_t)i * 8; dst = W8IN + i; wm = __uint_as_float(WMAX[0]); }
            else if (i < C_IN + C_FY) { const int j = i - C_IN; src = WFY + (size_t)j * 8; dst = W8FY + j; wm = __uint_as_float(WMAX[1]); }
            else { const int j = i - C_IN - C_FY; src = WGU + (size_t)j * 8; dst = W8GU + j; wm = __uint_as_float(WMAX[2 + (j >> 16)]); }
            const float inv = wm > 0.f ? 127.0f / wm : 0.f;
            const u32x4 w = *(const u32x4*)src;
            u32x2 o;
            o.x = q8s(bf_lo(w.x) * inv) | (q8s(bf_hi(w.x) * inv) << 8) | (q8s(bf_lo(w.y) * inv) << 16) | (q8s(bf_hi(w.y) * inv) << 24);
            o.y = q8s(bf_lo(w.z) * inv) | (q8s(bf_hi(w.z) * inv) << 8) | (q8s(bf_lo(w.w) * inv) << 16) | (q8s(bf_hi(w.w) * inv) << 24);
            *dst = o; }
    }
    const float* x = a.in[0]; const float* g = a.in[5]; unsigned char* U8 = (unsigned char*)(ws + WS_R1); float* SU = (float*)(ws + WS_SU);
    const int gw = F.vcu * NWAVES + F.wave, NGW = F.G * NWAVES;
    for (int ch = gw; ch < T / 32; ch += NGW) {
        const int b = (ch * 32) >> 13;
        f32x4 Gv[4], Sv[4];
#pragma unroll
        for (int j = 0; j < 4; ++j) { const int k = 4 * F.lane + 256 * j; Gv[j] = *(const f32x4*)(g + k) * (*(const f32x4*)(MODF + b * 8192 + 1024 + k) + 1.0f); Sv[j] = *(const f32x4*)(MODF + b * 8192 + k); }
#pragma unroll 2
        for (int rr = 0; rr < 32; ++rr) { const size_t row = (size_t)ch * 32 + rr; const f32x4* xr = (const f32x4*)(x + row * 1024) + F.lane;
            f32x4 v[4]; float s = 0.f;
#pragma unroll
            for (int j = 0; j < 4; ++j) { v[j] = xr[64 * j]; s += (v[j][0] * v[j][0] + v[j][1] * v[j][1]) + (v[j][2] * v[j][2] + v[j][3] * v[j][3]); }
            const float rs = __builtin_amdgcn_rsqf(wave_sum(s) * (1.0f / 1024.0f) + EPS);
            float am = 0.f;
#pragma unroll
            for (int j = 0; j < 4; ++j) { v[j] = v[j] * rs * Gv[j] + Sv[j]; am = fmaxf(am, fmaxf(fmaxf(fabsf(v[j][0]), fabsf(v[j][1])), fmaxf(fabsf(v[j][2]), fabsf(v[j][3])))); }
            am = wave_max(am); const float inv = am > 0.f ? 127.0f / am : 0.f;
            unsigned* o4 = (unsigned*)(U8 + row * 1024) + F.lane;
#pragma unroll
            for (int j = 0; j < 4; ++j) o4[64 * j] = q8s(v[j][0] * inv) | (q8s(v[j][1] * inv) << 8) | (q8s(v[j][2] * inv) << 16) | (q8s(v[j][3] * inv) << 24);
            if (F.lane == 0) SU[row] = am * (1.0f / 127.0f); }
    }
}

__device__ __forceinline__ float wave_sum_dpp(float v) {
    int x = __float_as_int(v);
    x = __float_as_int(__int_as_float(x) + __int_as_float(__builtin_amdgcn_update_dpp(0, x, 0xB1, 0xF, 0xF, true)));
    x = __float_as_int(__int_as_float(x) + __int_as_float(__builtin_amdgcn_update_dpp(0, x, 0x4E, 0xF, 0xF, true)));
    x = __float_as_int(__int_as_float(x) + __int_as_float(__builtin_amdgcn_update_dpp(0, x, 0x141, 0xF, 0xF, true)));
    x = __float_as_int(__int_as_float(x) + __int_as_float(__builtin_amdgcn_update_dpp(0, x, 0x140, 0xF, 0xF, true)));
    x = __float_as_int(__int_as_float(x) + __int_as_float(__builtin_amdgcn_update_dpp(0, x, 0x142, 0xA, 0xF, false)));
    x = __float_as_int(__int_as_float(x) + __int_as_float(__builtin_amdgcn_update_dpp(0, x, 0x143, 0xC, 0xF, false)));
    return __int_as_float(__builtin_amdgcn_readlane(x, 63));
}
constexpr int RT_WPH = 0, RT_WPL = 74304, RT_LCNT = 148608, RT_LBASE = RT_LCNT + 128, RT_INFO = RT_LBASE + 128, RT_CVEC = RT_INFO + 4096, RT_STG = RT_CVEC + 256;
__device__ __forceinline__ int wp_off(int n, int k) { return n * 2064 + k * 2; }
__device__ __forceinline__ void p7_route(const Frame& F, const Args& a) {
    unsigned char* ws = a.ws; gu32* ctl = (gu32*)(ws + WS_CTL);
    const bf16_t* H = (const bf16_t*)(ws + WS_YT2); const float* MODF = (const float*)(ws + WS_MODF); const float* g = a.in[16];
    unsigned char* VM8 = (unsigned char*)(ws + WS_R1); u32x2* LIST = (u32x2*)(ws + WS_LIST); u32x4* TOKINFO = (u32x4*)(ws + WS_ROUTEW);
    LAS int* lcnt = (LAS int*)(F.lds + RT_LCNT); LAS int* lbase = (LAS int*)(F.lds + RT_LBASE); LAS unsigned* info = (LAS unsigned*)(F.lds + RT_INFO); LAS float* winfo = (LAS float*)(F.lds + RT_INFO + 1024); LAS float* sinfo = (LAS float*)(F.lds + RT_INFO + 3072);
    LAS float* cvec = (LAS float*)(F.lds + RT_CVEC); LAS float* stg = (LAS float*)(F.lds + RT_STG + F.wave * 1152);
    const int l16 = F.lane & 15, fq = F.lane >> 4;
    int wb = -1;
    for (int ch = F.vcu; ch < T / 256; ch += F.G) {
        const int b = (ch * 256) >> 13;
        if (b != wb) {
            __syncthreads();
            const float* Gm = MODF + b * 8192 + 4096; const float* Sm = MODF + b * 8192 + 3072;
            float pg = 0.f, pe = 0.f;
            for (int i = F.tid; i < 1024 * 4; i += 512) { const int k = i >> 2, n = i & 3; const float w0 = a.in[17][i]; pg += Sm[k] * w0; const float w = w0 * (g[k] * (Gm[k] + 1.0f)); const unsigned h16 = f2bf(w);
                *(LAS unsigned short*)(F.lds + RT_WPH + wp_off(n, k)) = (unsigned short)h16; *(LAS unsigned short*)(F.lds + RT_WPL + wp_off(n, k)) = (unsigned short)f2bf(w - __uint_as_float(h16 << 16)); }
            for (int i = F.tid; i < 1024 * 32; i += 512) { const int k = i >> 5, n = 4 + (i & 31); const float w0 = a.in[19][i]; pe += Sm[k] * w0; const float w = w0 * (g[k] * (Gm[k] + 1.0f)); const unsigned h16 = f2bf(w);
                *(LAS unsigned short*)(F.lds + RT_WPH + wp_off(n, k)) = (unsigned short)h16; *(LAS unsigned short*)(F.lds + RT_WPL + wp_off(n, k)) = (unsigned short)f2bf(w - __uint_as_float(h16 << 16)); }
            { LAS float* part = (LAS float*)(F.lds + RT_STG);
              part[(F.tid & 3) * 128 + (F.tid >> 2)] = pg; part[512 + (F.tid & 31) * 16 + (F.tid >> 5)] = pe;
              __syncthreads();
              if (F.tid < 36) { float d = 0.f;
                  if (F.tid < 4) { for (int j = 0; j < 128; ++j) d += part[F.tid * 128 + j]; d += a.in[18][F.tid]; }
                  else { for (int j = 0; j < 16; ++j) d += part[512 + (F.tid - 4) * 16 + j]; d += a.in[20][F.tid - 4]; }
                  cvec[F.tid] = d; } }
            wb = b;
        }
        if (F.tid < 32) lcnt[F.tid] = 0;
        __syncthreads();
        f32x4 Gv[4], Sv[4];
#pragma unroll
        for (int j = 0; j < 4; ++j) { const int k = 4 * F.lane + 256 * j; Gv[j] = *(const f32x4*)(g + k) * (*(const f32x4*)(MODF + b * 8192 + 4096 + k) + 1.0f); Sv[j] = *(const f32x4*)(MODF + b * 8192 + 3072 + k); }
#pragma unroll 1
        for (int bi = 0; bi < 2; ++bi) {
            const size_t R0 = (size_t)ch * 256 + F.wave * 32 + bi * 16;
            f32x4 acc0 = f32x4{}, acc1 = f32x4{}, acc2 = f32x4{};
            { const bf16_t* hp = H + (R0 + l16) * 1024 + fq * 8;
              const int n0 = l16, n1 = 16 + l16, n2 = (32 + l16) < 36 ? 32 + l16 : 35;
              bf16x8 av[2][8];
#pragma unroll
              for (int i = 0; i < 8; ++i) av[0][i] = *reinterpret_cast<const bf16x8*>(hp + i * 32);
#pragma unroll
              for (int kb = 0; kb < 4; ++kb) {
                  if (kb < 3) {
#pragma unroll
                      for (int i = 0; i < 8; ++i) av[(kb + 1) & 1][i] = *reinterpret_cast<const bf16x8*>(hp + ((kb + 1) * 8 + i) * 32); }
#pragma unroll
                  for (int i = 0; i < 8; ++i) { const int k = (kb * 8 + i) * 32 + fq * 8; const bf16x8 af = av[kb & 1][i];
                      const bf16x8 h0 = *(const LAS bf16x8*)(F.lds + RT_WPH + wp_off(n0, k)), h1 = *(const LAS bf16x8*)(F.lds + RT_WPH + wp_off(n1, k)), h2 = *(const LAS bf16x8*)(F.lds + RT_WPH + wp_off(n2, k));
                      const bf16x8 e0 = *(const LAS bf16x8*)(F.lds + RT_WPL + wp_off(n0, k)), e1 = *(const LAS bf16x8*)(F.lds + RT_WPL + wp_off(n1, k)), e2 = *(const LAS bf16x8*)(F.lds + RT_WPL + wp_off(n2, k));
                      acc0 = __builtin_amdgcn_mfma_f32_16x16x32_bf16(af, h0, acc0, 0, 0, 0); acc1 = __builtin_amdgcn_mfma_f32_16x16x32_bf16(af, h1, acc1, 0, 0, 0); acc2 = __builtin_amdgcn_mfma_f32_16x16x32_bf16(af, h2, acc2, 0, 0, 0);
                      acc0 = __builtin_amdgcn_mfma_f32_16x16x32_bf16(af, e0, acc0, 0, 0, 0); acc1 = __builtin_amdgcn_mfma_f32_16x16x32_bf16(af, e1, acc1, 0, 0, 0); acc2 = __builtin_amdgcn_mfma_f32_16x16x32_bf16(af, e2, acc2, 0, 0, 0); } }
            }
            u32x2 hn[4];
            { const u32x2* hr = (const u32x2*)(H + R0 * 1024) + F.lane;
#pragma unroll
              for (int j = 0; j < 4; ++j) hn[j] = hr[64 * j]; }
#pragma unroll 1
            for (int half = 0; half < 2; ++half) {
                if ((fq >> 1) == half) {
#pragma unroll
                    for (int r = 0; r < 4; ++r) { const int rl = (fq & 1) * 4 + r; stg[rl * 36 + l16] = acc0[r]; stg[rl * 36 + 16 + l16] = acc1[r]; if (l16 < 4) stg[rl * 36 + 32 + l16] = acc2[r]; } }
                LDS_WAIT(); asm volatile("" ::: "memory");
#pragma unroll 4
                for (int rr = 0; rr < 8; ++rr) { const int lr = F.wave * 32 + bi * 16 + half * 8 + rr; const size_t row = (size_t)ch * 256 + lr;
                    f32x4 v[4]; float s = 0.f;
                    u32x2 hc[4];
#pragma unroll
                    for (int j = 0; j < 4; ++j) hc[j] = hn[j];
                    { const u32x2* hr = (const u32x2*)(H + (row + ((half * 8 + rr) < 15 ? 1 : 0)) * 1024) + F.lane;
#pragma unroll
                      for (int j = 0; j < 4; ++j) hn[j] = hr[64 * j]; }
#pragma unroll
                    for (int j = 0; j < 4; ++j) { const u32x2 hw = hc[j]; v[j] = (f32x4){bf_lo(hw.x), bf_hi(hw.x), bf_lo(hw.y), bf_hi(hw.y)}; s += (v[j][0] * v[j][0] + v[j][1] * v[j][1]) + (v[j][2] * v[j][2] + v[j][3] * v[j][3]); }
                    const float rs = __builtin_amdgcn_rsqf(wave_sum_dpp(s) * (1.0f / 1024.0f) + EPS);
                    float am = 0.f;
#pragma unroll
                    for (int j = 0; j < 4; ++j) { v[j] = v[j] * rs * Gv[j] + Sv[j]; am = fmaxf(am, fmaxf(fmaxf(fabsf(v[j][0]), fabsf(v[j][1])), fmaxf(fabsf(v[j][2]), fabsf(v[j][3])))); }
                    am = wave_max(am); const float inv = am > 0.f ? 127.0f / am : 0.f;
                    { unsigned* o4 = (unsigned*)(VM8 + row * 1024) + F.lane;
#pragma unroll
                      for (int j = 0; j < 4; ++j) o4[64 * j] = q8s(v[j][0] * inv) | (q8s(v[j][1] * inv) << 8) | (q8s(v[j][2] * inv) << 16) | (q8s(v[j][3] * inv) << 24); }
                    const f32x4 graw = *(const LAS f32x4*)(stg + rr * 36), gc = *(const LAS f32x4*)cvec;
                    float gl[4];
#pragma unroll
                    for (int q = 0; q < 4; ++q) gl[q] = graw[q] * rs + gc[q];
                    int gs = 0; float gm = gl[0];
#pragma unroll
                    for (int q = 1; q < 4; ++q) if (gl[q] > gm) { gm = gl[q]; gs = q; }
                    gs = __builtin_amdgcn_readfirstlane(gs);
                    float gden = 0.f;
#pragma unroll
                    for (int q = 0; q < 4; ++q) gden += __expf(gl[q] - gm);
                    const float gp = 1.0f / gden;
                    const f32x4 er0 = *(const LAS f32x4*)(stg + rr * 36 + 4 + gs * 8), er1 = *(const LAS f32x4*)(stg + rr * 36 + 8 + gs * 8), ec0 = *(const LAS f32x4*)(cvec + 4 + gs * 8), ec1 = *(const LAS f32x4*)(cvec + 8 + gs * 8);
                    float b0 = -3.0e38f, b1 = -3.0e38f; int i0 = 0, i1 = 0;
#pragma unroll
                    for (int e = 0; e < 8; ++e) { const float el = (e < 4 ? er0[e & 3] : er1[e & 3]) * rs + (e < 4 ? ec0[e & 3] : ec1[e & 3]);
                        if (el > b0) { b1 = b0; i1 = i0; b0 = el; i0 = e; } else if (el > b1) { b1 = el; i1 = e; } }
                    const float w0 = 1.0f / (1.0f + __expf(b1 - b0)), w1 = 1.0f - w0;
                    if (F.lane == 0) { const int e0 = gs * 8 + i0, e1 = gs * 8 + i1;
                        const int rk0 = __hip_atomic_fetch_add(lcnt + e0, 1, __ATOMIC_RELAXED, __HIP_MEMORY_SCOPE_WORKGROUP);
                        const int rk1 = __hip_atomic_fetch_add(lcnt + e1, 1, __ATOMIC_RELAXED, __HIP_MEMORY_SCOPE_WORKGROUP);
                        info[lr] = (unsigned)e0 | ((unsigned)e1 << 5) | ((unsigned)rk0 << 10) | ((unsigned)rk1 << 20);
                        winfo[2 * lr] = gp * w0; winfo[2 * lr + 1] = gp * w1; sinfo[lr] = am * (1.0f / 127.0f); }
                }
                LDS_WAIT(); asm volatile("" ::: "memory");
            }
        }
        __syncthreads();
        if (F.tid < 32) lbase[F.tid] = (int)__hip_atomic_fetch_add((unsigned*)(ctl + CW_CNT) + F.tid, (unsigned)lcnt[F.tid], __ATOMIC_RELAXED, __HIP_MEMORY_SCOPE_AGENT);
        __syncthreads();
        if (F.tid < 256) { const unsigned w = info[F.tid]; const int e0 = w & 31, e1 = (w >> 5) & 31, rk0 = (w >> 10) & 1023, rk1 = (w >> 20) & 1023; const int t = ch * 256 + F.tid;
            const int p0 = lbase[e0] + rk0, p1 = lbase[e1] + rk1;
            const unsigned sb_ = __float_as_uint(sinfo[F.tid]);
            LIST[(size_t)e0 * 65536 + p0] = (u32x2){(unsigned)t, sb_}; LIST[(size_t)e1 * 65536 + p1] = (u32x2){(unsigned)t, sb_};
            TOKINFO[t] = (u32x4){((unsigned)e0 << 16) | (unsigned)p0, ((unsigned)e1 << 16) | (unsigned)p1, __float_as_uint(winfo[2 * F.tid]), __float_as_uint(winfo[2 * F.tid + 1])}; }
        __syncthreads();
    }
}

__device__ __forceinline__ void p10_final(const Frame& F, const Args& a) {
    unsigned char* ws = a.ws; const float* MODF = (const float*)(ws + WS_MODF); const float* g = a.in[26];
    const bf16_t* Y2 = (const bf16_t*)(ws + WS_GATE); const bf16_t* H = (const bf16_t*)(ws + WS_YT2); float* out = a.out; const u32x4* TOKINFO = (const u32x4*)(ws + WS_ROUTEW);
    LAS int* tst = (LAS int*)(F.lds + MISC_OFF + 256);
    { gu32* ctl = (gu32*)(ws + WS_CTL); LAS int* cntl = (LAS int*)(F.lds + MISC_OFF + 64);
      if (F.tid < 32) cntl[F.tid] = (int)__hip_atomic_load((unsigned*)(ctl + CW_CNT) + F.tid, __ATOMIC_RELAXED, __HIP_MEMORY_SCOPE_AGENT);
      __syncthreads();
      if (F.tid == 0) { int sacc = 0; for (int e = 0; e < 32; ++e) { tst[e] = sacc; sacc += (cntl[e] + 255) >> 8; } tst[32] = sacc; }
      __syncthreads(); }
    const int gw = F.vcu * NWAVES + F.wave, NGW = F.G * NWAVES;
    for (int ch = gw; ch < T / 32; ch += NGW) {
        const int b = (ch * 32) >> 13;
        f32x4 Gv[4], Sv[4], Tv[4];
#pragma unroll
        for (int j = 0; j < 4; ++j) { const int k = 4 * F.lane + 256 * j; Gv[j] = *(const f32x4*)(g + k) * (*(const f32x4*)(MODF + b * 8192 + 6144 + 1024 + k) + 1.0f); Sv[j] = *(const f32x4*)(MODF + b * 8192 + 6144 + k); Tv[j] = *(const f32x4*)(MODF + b * 8192 + 5120 + k); }
        unsigned my_r0, my_r1, my_w0, my_w1;
        { const u32x4 ti = TOKINFO[(size_t)ch * 32 + (F.lane & 31)];
          my_r0 = (unsigned)tst[ti.x >> 16] * 256u + (ti.x & 0xffffu); my_r1 = (unsigned)tst[ti.y >> 16] * 256u + (ti.y & 0xffffu); my_w0 = ti.z; my_w1 = ti.w; }
#pragma unroll 4
        for (int rr = 0; rr < 32; ++rr) { const size_t row = (size_t)ch * 32 + rr; f32x4* hr = (f32x4*)(out + row * 1024) + F.lane; const u32x2* hb = (const u32x2*)(H + row * 1024) + F.lane;
            const size_t r0 = (size_t)__builtin_amdgcn_readlane(my_r0, rr), r1 = (size_t)__builtin_amdgcn_readlane(my_r1, rr);
            const float w0 = __uint_as_float(__builtin_amdgcn_readlane(my_w0, rr)), w1 = __uint_as_float(__builtin_amdgcn_readlane(my_w1, rr));
            const u32x2* y0 = (const u32x2*)(Y2 + r0 * 1024) + F.lane; const u32x2* y1 = (const u32x2*)(Y2 + r1 * 1024) + F.lane;
            f32x4 v[4]; float s = 0.f;
#pragma unroll
            for (int j = 0; j < 4; ++j) { const u32x2 p = y0[64 * j], q = y1[64 * j], hw = hb[64 * j]; v[j] = (f32x4){bf_lo(hw.x), bf_hi(hw.x), bf_lo(hw.y), bf_hi(hw.y)};
                v[j][0] += Tv[j][0] * (w0 * bf_lo(p.x) + w1 * bf_lo(q.x)); v[j][1] += Tv[j][1] * (w0 * bf_hi(p.x) + w1 * bf_hi(q.x)); v[j][2] += Tv[j][2] * (w0 * bf_lo(p.y) + w1 * bf_lo(q.y)); v[j][3] += Tv[j][3] * (w0 * bf_hi(p.y) + w1 * bf_hi(q.y));
                s += (v[j][0] * v[j][0] + v[j][1] * v[j][1]) + (v[j][2] * v[j][2] + v[j][3] * v[j][3]); }
            const float rs = __builtin_amdgcn_rsqf(wave_sum(s) * (1.0f / 1024.0f) + EPS);
#pragma unroll
            for (int j = 0; j < 4; ++j) hr[64 * j] = v[j] * rs * Gv[j] + Sv[j]; }
    }
}

constexpr int N_PHASES = 11;
constexpr int MISC_BAR = MISC_OFF + 32, MISC_CNT = MISC_OFF + 64, MISC_TST = MISC_OFF + 256;

__global__ void __launch_bounds__(NWAVES * 64, 2) fwd(Args args) {
    extern __shared__ __attribute__((aligned(16))) unsigned char lds[];
    Frame F;
    F.lds = (LAS unsigned char*)lds;
    F.tid = threadIdx.x; F.lane = F.tid & 63; F.wave = __builtin_amdgcn_readfirstlane(F.tid >> 6);
    F.G = gridDim.x; { const int bx = blockIdx.x; F.vcu = (F.G % 8 == 0) ? (bx % 8) * (F.G / 8) + bx / 8 : bx; }
    unsigned char* ws = args.ws;
    gu32* ctl = (gu32*)(ws + WS_CTL);
    for (int u = F.tid; u < 1024 / 4; u += NWAVES * 64) ((LAS unsigned*)(F.lds + MISC_OFF))[u] = 0u;
    __syncthreads();
#if MK_PER_PHASE
#define GRID_BAR() do { } while (0)
#else
    XcdBarrier bar = xcd_barrier_post((unsigned*)(ctl + CW_BAR), (volatile LAS unsigned*)(F.lds + MISC_BAR));
#define GRID_BAR() xcd_barrier(bar)
#endif
#ifdef DBG_SYSFENCE
    __builtin_amdgcn_fence(__ATOMIC_ACQUIRE, ""); asm volatile("s_waitcnt vmcnt(0)" ::: "memory"); __syncthreads();
#endif
    const int lo = args.ph_lo, hi = args.ph_hi;
#ifndef PH_MASK
#define PH_MASK 0x7ff
#endif
#define IN(k) ((((PH_MASK) >> (k)) & 1) && lo <= (k) && (k) < hi)
#define BOTH(k) (IN(k) && IN((k) + 1))
    LAS unsigned char* ring = F.lds + RING_OFF;
#define REFRESH_F() do { int t_ = threadIdx.x; asm volatile("" : "+v"(t_)); F.tid = t_; F.lane = t_ & 63; } while (0)
    const int bx = (int)blockIdx.x;

    if (IN(0)) { REFRESH_F(); p0_prologue(F, args); if (BOTH(0)) GRID_BAR(); }
    if (IN(1)) { REFRESH_F(); p1_norm(F, args); if (BOTH(1)) GRID_BAR(); }
    if (IN(2)) {
#ifdef WG_STAGGER
        if (bx & 1) { for (int q = 0; q < WG_STAGGER; ++q) __builtin_amdgcn_s_sleep(127); }
#endif
#ifndef NO_G1M
        { pg8::PlainOrder8 S{(const char*)(ws + WS_R1), (const char*)(ws + WS_W8IN), 1024, T / 256, NWIN / 256, F.G, bx};
          EpiZ8 E{ws, args.in[14]};
          pg8::gemm_phase(ring, 1024, S, E); }
#endif
#ifdef PROBE_KLOOP
        { pg8::PlainOrder S{(const char*)(ws + WS_R1), (const char*)(ws + WS_WIN), 1024, T / 256, NWIN / 256, F.G, bx};
          EpiNull E{(float*)(ws + WS_SSQQ), args.ph_lo};
          pg8::gemm_phase(ring, 1024, S, E); }
#endif
#ifndef NO_G1F
        { F1Order8 S{(const char*)(ws + WS_W8FY), (const char*)(ws + WS_R1), F.G, bx};
          EpiF18 E{ws};
          pg8::gemm_phase(ring, 1024, S, E); }
#endif
        if (BOTH(2)) GRID_BAR();
    }
    if (IN(3)) {
#ifndef NO_P3A
        { pg8::PlainOrder S{(const char*)(ws + WS_QL), (const char*)(ws + WS_WUQ), 256, T / 256, 3, F.G, bx};
          EpiQ E{(bf16_t*)(ws + WS_Q), (const float*)(ws + WS_SSQQ), (const float*)(ws + WS_ROPEC), (const float*)(ws + WS_ROPES)};
          pg8::gemm_phase(ring, 256, S, E); }
#endif
#ifndef NO_P3B
        { pg8::PlainOrder S{(const char*)(ws + WS_KVL), (const char*)(ws + WS_WUKV), 256, T / 256, 4, F.G, bx};
          EpiKV E{(bf16_t*)(ws + WS_K), (bf16_t*)(ws + WS_V), (const float*)(ws + WS_SSQKV)};
          pg8::gemm_phase(ring, 256, S, E); }
#endif
#ifndef NO_P3C
        { pg8::PlainOrder S{(const char*)(ws + WS_DFTA), (const char*)(ws + WS_YT2), 256, 1, 1024, F.G, bx};
          EpiFA E{(bf16_t*)(ws + WS_R1)};
          pg8::gemm_phase(ring, 256, S, E); }
#endif
        if (BOTH(3)) GRID_BAR();
    }
    if (IN(4)) {
        { FBOrder S{(const char*)(ws + WS_TB2), (const char*)(ws + WS_R1), F.G, bx};
          EpiFB E{(bf16_t*)(ws + WS_YT2)};
          pg8::gemm_phase(ring, 256, S, E); }
        __syncthreads();
        { const bf16_t* Q = (const bf16_t*)(ws + WS_Q); const bf16_t* KB = (const bf16_t*)(ws + WS_K); const bf16_t* VB = (const bf16_t*)(ws + WS_V); bf16_t* O = (bf16_t*)(ws + WS_QL);
#define ATT_LOOP \
          for (int i = 0;; ++i) { const int unit = i * F.G + F.vcu; if (unit >= 1024) break; const int bh = unit >> 4, qb = unit & 15, b = bh >> 3, h = bh & 7; \
              att::attn_unit(Q + ((size_t)b * 8192 + qb * 512) * QC + h * 96, KB + (size_t)bh * 8192 * 96, VB + (size_t)bh * 8192 * 64, O + ((size_t)b * 8192 + qb * 512) * 512 + h * 64, ring); }
          ATT_LOOP
        }
        if (BOTH(4)) GRID_BAR();
    }
    if (IN(5)) {
        { MergeOrder S{(const char*)(ws + WS_QL), (const char*)(ws + WS_YT2), (const char*)(ws + WS_WBA), F.G, bx};
          EpiMerge2 E{(bf16_t*)(ws + WS_R1), (const unsigned char*)(ws + WS_GATE)};
          pg8::gemm_phase(ring, 1024, S, E); }
        if (BOTH(5)) GRID_BAR();
    }
    if (IN(6)) {
        { pg8::PlainOrder S{(const char*)(ws + WS_R1), (const char*)(ws + WS_WOUT), 1024, T / 256, 4, F.G, bx};
          EpiH E{args.in[0], (bf16_t*)(ws + WS_YT2), (const float*)(ws + WS_MODF)};
          pg8::gemm_phase(ring, 1024, S, E); }
        if (BOTH(6)) GRID_BAR();
    }
    if (IN(7)) { REFRESH_F(); p7_route(F, args); if (BOTH(7)) GRID_BAR(); }
    if (IN(8) || IN(9)) {
        REFRESH_F();
        LAS int* tst = (LAS int*)(F.lds + MISC_TST); LAS int* cntl = (LAS int*)(F.lds + MISC_CNT);
        if (F.tid < 32) cntl[F.tid] = (int)__hip_atomic_load((unsigned*)(ctl + CW_CNT) + F.tid, __ATOMIC_RELAXED, __HIP_MEMORY_SCOPE_AGENT);
        __syncthreads();
        if (F.tid == 0) { int s = 0; for (int e = 0; e < 32; ++e) { tst[e] = s; s += (cntl[e] + 255) >> 8; } tst[32] = s; }
        __syncthreads();
        { LAS unsigned char* texp = (LAS unsigned char*)(tst + 40); const int e = F.tid >> 4; if (F.tid < 512) for (int tl = tst[e] + (F.tid & 15); tl < tst[e + 1]; tl += 16) texp[tl] = (unsigned char)e; }
        __syncthreads();
        if (IN(8)) {
            MoeUpOrder8 S{(const char*)(ws + WS_R1), (const char*)(ws + WS_W8GU), (const u32x2*)(ws + WS_LIST), tst, cntl, F.G, bx};
            EpiUp8 E{ws};
            pg8::gemm_phase(ring, 1024, S, E);
            if (BOTH(8)) GRID_BAR();
        }
        if (IN(9)) {
            MoeDownOrder S{(const char*)(ws + WS_Q), (const char*)(ws + WS_WDN), tst, cntl, F.G, bx};
            EpiDown E{(bf16_t*)(ws + WS_GATE)};
            pg8::gemm_phase(ring, 256, S, E);
            if (BOTH(9)) GRID_BAR();
        }
    }
    if (IN(10)) { REFRESH_F(); p10_final(F, args); }
#ifdef DBG_SYSFENCE
    asm volatile("s_waitcnt vmcnt(0)" ::: "memory"); __syncthreads(); __builtin_amdgcn_fence(__ATOMIC_RELEASE, ""); asm volatile("s_waitcnt vmcnt(0)" ::: "memory");
#endif
#undef IN
#undef BOTH
}

extern "C" void kernel_launch(void* const* d_in, const int* in_sizes, int n_in, void* d_out, int out_size, void* d_ws, size_t ws_size, hipStream_t stream) {
    static int grid = 0;
    if (grid == 0) {
        if (n_in != 27 || in_sizes[0] != T * D || out_size != T * D || ws_size < WS_END) { fprintf(stderr, "kernel_launch: shape/workspace mismatch: n_in %d in0 %d out %d ws %zu (need %zu)\n", n_in, n_in > 0 ? in_sizes[0] : -1, out_size, ws_size, (size_t)WS_END); grid = -1; return; }
        int dev = 0, cus = 0;
        if (hipGetDevice(&dev) != hipSuccess || hipDeviceGetAttribute(&cus, hipDeviceAttributeMultiprocessorCount, dev) != hipSuccess) { fprintf(stderr, "kernel_launch: device query failed\n"); grid = -1; return; }
        if (hipFuncSetAttribute((const void*)fwd, hipFuncAttributeMaxDynamicSharedMemorySize, LDS_BYTES) != hipSuccess) { fprintf(stderr, "kernel_launch: hipFuncSetAttribute failed\n"); grid = -1; return; }
        int per_cu = 0;
        if (hipOccupancyMaxActiveBlocksPerMultiprocessor(&per_cu, (const void*)fwd, NWAVES * 64, LDS_BYTES) != hipSuccess || per_cu < 1) fprintf(stderr, "kernel_launch: note: occupancy query reports %d workgroups per CU\n", per_cu);
        (void)hipGetLastError();
        grid = cus;
    }
    if (grid < 0) return;
    if (hipMemsetAsync((char*)d_ws + WS_CTL, 0, CTL_ZERO_BYTES, stream) != hipSuccess) { fprintf(stderr, "kernel_launch: memset failed\n"); return; }
    Args a{};
    for (int i = 0; i < 27; ++i) a.in[i] = (const float*)d_in[i];
    a.out = (float*)d_out; a.ws = (unsigned char*)d_ws;
#if MK_PER_PHASE
    for (int p = 0; p < N_PHASES; ++p) { a.ph_lo = p; a.ph_hi = p + 1; a.li = p;
        hipLaunchKernelGGL(fwd, dim3(grid), dim3(NWAVES * 64), LDS_BYTES, stream, a);
        const hipError_t le = hipPeekAtLastError(); if (le != hipSuccess) { fprintf(stderr, "kernel_launch: launch %d failed: %s\n", p, hipGetErrorName(le)); break; } }
#else
#ifdef PROBE_MASK
    { bool first = true;
      for (int k = 0; k < N_PHASES; ++k) for (int rep = 0; rep < (((PROBE_MASK) >> k) & 1 ? 2 : 1); ++rep) { a.ph_lo = k; a.ph_hi = k + 1; a.li = 0;
        if (!first) (void)hipMemsetAsync((char*)d_ws + WS_CTL + CW_BAR * 4, 0, XCD_BAR_WORDS * 4, stream);
        first = false;
        hipLaunchKernelGGL(fwd, dim3(grid), dim3(NWAVES * 64), LDS_BYTES, stream, a); } }
#else
    a.ph_lo = 0; a.ph_hi = N_PHASES; a.li = 0;
    hipLaunchKernelGGL(fwd, dim3(grid), dim3(NWAVES * 64), LDS_BYTES, stream, a);
    { const hipError_t le = hipPeekAtLastError(); if (le != hipSuccess) fprintf(stderr, "kernel_launch: launch failed: %s\n", hipGetErrorName(le)); }
#endif
#endif
}
```

```cpp
#include <hip/hip_runtime.h>
#include <cstdio>
#include <cstdint>

#ifndef MK_PER_PHASE
#define MK_PER_PHASE 0
#endif

#define LAS __attribute__((address_space(3)))
#define GAS __attribute__((address_space(1)))
typedef unsigned short bf16_t;
typedef short bf16x8 __attribute__((ext_vector_type(8)));
typedef short s16x4 __attribute__((ext_vector_type(4)));
typedef float f32x4 __attribute__((ext_vector_type(4)));
typedef float f32x16 __attribute__((ext_vector_type(16)));
typedef unsigned u32x4 __attribute__((ext_vector_type(4)));
typedef unsigned u32x2 __attribute__((ext_vector_type(2)));
typedef GAS unsigned gu32;
typedef int i32x4 __attribute__((ext_vector_type(4)));

constexpr int NB = 8, SEQ = 8192, T = NB * SEQ, D = 1024;
constexpr int NH = 8, DQK = 96, DV = 64, QC = NH * DQK;
constexpr float EPS = 1e-6f;
constexpr float C2 = 0.14724444602590306f;
constexpr float FNORM = 0.0013810679320049755f;
constexpr int NEXP = 32, DEXP = 256;
constexpr int NWAVES = 8;

constexpr size_t MiB = 1u << 20;
constexpr size_t WS_CTL = 0, CTL_ZERO_BYTES = 1 * MiB;
constexpr size_t WS_SSQQ = 1 * MiB, WS_SSQKV = 2 * MiB, WS_ROUTEW = 3 * MiB, WS_MODF = 4 * MiB;
constexpr size_t WS_ROPEC = 8 * MiB, WS_ROPES = 12 * MiB, WS_LIST = 16 * MiB;
constexpr size_t WS_WIN = 32 * MiB, WS_WFY = 38 * MiB, WS_WUQ = 40 * MiB, WS_WUKV = 40 * MiB + 512 * 1024, WS_WBA = 41 * MiB, WS_WBF = 42 * MiB, WS_WOUT = 43 * MiB;
constexpr size_t WS_DFTA = 45 * MiB, WS_TB2 = 46 * MiB, WS_WGU = 50 * MiB, WS_WDN = 82 * MiB;
constexpr size_t WS_R1 = 100 * MiB;
constexpr size_t WS_GATE = 228 * MiB;
constexpr size_t WS_QL = 484 * MiB, WS_KVL = 516 * MiB;
constexpr size_t WS_Q = 548 * MiB, WS_K = 644 * MiB, WS_V = 740 * MiB;
constexpr size_t WS_YT2 = 804 * MiB;
constexpr size_t WS_W8IN = 932 * MiB, WS_W8FY = 935 * MiB, WS_W8GU = 936 * MiB;
constexpr size_t WS_SU = 5 * MiB;
constexpr size_t WS_END = 1024 * MiB;
constexpr int CW_TMO = 0;
constexpr int CW_BAR = 4096;
constexpr int CW_CNT = 8192;
constexpr int CW_WMAX = 8256;
constexpr int CW_MOD = 16384;
constexpr int NWIN = 2816;

constexpr int LDS_BYTES = 163840;
constexpr int MISC_OFF = 163840 - 1024;
constexpr int RING_OFF = 0;

#define LDS_WAIT() asm volatile("s_waitcnt lgkmcnt(0)" ::: "memory")
#define VM_WAIT() asm volatile("s_waitcnt vmcnt(0)" ::: "memory")
typedef float f32x2_t __attribute__((ext_vector_type(2))); typedef __bf16 bf16x2_t __attribute__((ext_vector_type(2)));
__device__ __forceinline__ unsigned cvt_pk_bf16(float lo, float hi) { f32x2_t v = {lo, hi}; bf16x2_t b = __builtin_convertvector(v, bf16x2_t); return __builtin_bit_cast(unsigned, b); }
__device__ __forceinline__ float bf_lo(unsigned w) { return __uint_as_float(w << 16); }
__device__ __forceinline__ float bf_hi(unsigned w) { return __uint_as_float(w & 0xffff0000u); }
__device__ __forceinline__ u32x4 pack8(const f32x4 a, const f32x4 b) { u32x4 w; w.x = cvt_pk_bf16(a[0], a[1]); w.y = cvt_pk_bf16(a[2], a[3]); w.z = cvt_pk_bf16(b[0], b[1]); w.w = cvt_pk_bf16(b[2], b[3]); return w; }
__device__ __forceinline__ u32x2 pack4(const f32x4 a) { u32x2 w; w.x = cvt_pk_bf16(a[0], a[1]); w.y = cvt_pk_bf16(a[2], a[3]); return w; }
__device__ __forceinline__ float sigmoidf_(float x) { return __builtin_amdgcn_rcpf(1.0f + __builtin_amdgcn_exp2f(-1.4426950408889634f * x)); }
__device__ __forceinline__ float wave_sum(float v) {
#pragma unroll
    for (int o = 1; o < 64; o <<= 1) v += __shfl_xor(v, o);
    return v;
}

#define XB_TMO      128
#define XB_XCNT(j)  (256  + 64 * (j))
#define XB_XSUB(j)  (1280 + 64 * (j))
#define XB_XGEN(j)  (2304 + 64 * (j))
#define XB_TOP      3328
#define XB_TOPGEN   3392
#define XCD_BAR_WORDS 3456
#define XB_SPIN_CAP (1u << 18)
__device__ __forceinline__ unsigned xb_ld(unsigned* p)              { return __hip_atomic_load(p, __ATOMIC_RELAXED, __HIP_MEMORY_SCOPE_AGENT); }
__device__ __forceinline__ unsigned xb_add(unsigned* p, unsigned v) { return __hip_atomic_fetch_add(p, v, __ATOMIC_RELAXED, __HIP_MEMORY_SCOPE_AGENT); }
__device__ __forceinline__ unsigned xb_xcc_id() { return (unsigned)__builtin_amdgcn_s_getreg((3 << 11) | 20) & 0xFu; }
#define XB_SPIN(cond, bar) do { unsigned _sp = 0; while (cond) { __builtin_amdgcn_s_sleep(1); \
    if ((++_sp & 255u) == 0u) { if (xb_ld(&(bar)[XB_TMO])) break; if (_sp > XB_SPIN_CAP) { atomicAdd(&(bar)[XB_TMO], 1u); break; } } } } while (0)
struct XcdBarrier { unsigned* bar; unsigned x; volatile LAS unsigned* st; };
__device__ __forceinline__ XcdBarrier xcd_barrier_post(unsigned* bar, volatile LAS unsigned* st) {
    XcdBarrier b; b.bar = bar; b.x = xb_xcc_id(); b.st = st;
    if (threadIdx.x == 0) (void)xb_add(&bar[XB_XCNT(b.x)], 1u);
    return b;
}
__device__ __forceinline__ void xcd_barrier_complete(unsigned* bar, unsigned x, unsigned& nloc, unsigned& nx) {
    const unsigned G = gridDim.x * gridDim.y * gridDim.z;
    unsigned sum, cnt, mine, sp = 0u;
    for (;;) {
        sum = 0u; cnt = 0u; mine = 0u;
#pragma unroll
        for (unsigned j = 0; j < 16; ++j) { const unsigned c = xb_ld(&bar[XB_XCNT(j)]); sum += c; cnt += (c > 0u) ? 1u : 0u; mine = (j == x) ? c : mine; }
        if (sum == G) break;
        __builtin_amdgcn_s_sleep(1);
        if ((++sp & 255u) == 0u) { if (xb_ld(&bar[XB_TMO])) break; if (sp > XB_SPIN_CAP) { atomicAdd(&bar[XB_TMO], 1u); break; } }
    }
    nloc = mine > 0u ? mine : 1u; nx = cnt > 0u ? cnt : 1u;
}
__device__ __forceinline__ void xcd_barrier(const XcdBarrier& b) {
    asm volatile("s_waitcnt vmcnt(0)" ::: "memory");
    __syncthreads();
    if (threadIdx.x == 0) {
        unsigned* bar = b.bar;
        __builtin_amdgcn_s_waitcnt(0);
        unsigned nloc = b.st[0], nx = b.st[1];
        if (nloc == 0u) { xcd_barrier_complete(bar, b.x, nloc, nx); b.st[0] = nloc; b.st[1] = nx; }
        const unsigned old = xb_add(&bar[XB_XSUB(b.x)], 1u);
        const unsigned gen = old / nloc;
        if (old + 1u == (gen + 1u) * nloc) {
            __builtin_amdgcn_fence(__ATOMIC_RELEASE, "agent");
            asm volatile("s_waitcnt vmcnt(0)" ::: "memory");
            const unsigned og = xb_add(&bar[XB_TOP], 1u);
            const unsigned tg = og / nx;
            if (og + 1u == (tg + 1u) * nx) xb_add(&bar[XB_TOPGEN], 1u);
            else XB_SPIN(xb_ld(&bar[XB_TOPGEN]) == tg, bar);
            __builtin_amdgcn_fence(__ATOMIC_ACQUIRE, "agent");
            xb_add(&bar[XB_XGEN(b.x)], 1u);
            asm volatile("s_waitcnt vmcnt(0)" ::: "memory");
        } else {
            XB_SPIN(xb_ld(&bar[XB_XGEN(b.x)]) == gen, bar);
            __builtin_amdgcn_fence(__ATOMIC_ACQUIRE, "agent");
            asm volatile("s_waitcnt vmcnt(0)" ::: "memory");
        }
    }
    __syncthreads();
}

namespace pg8 {
constexpr int BM = 256, BK = 64, HALF = 128, HTB = HALF * BK * 2, STAGE_BYTES = 8 * HTB, NXCD = 8, WGM = 4;
__host__ __device__ __forceinline__ int lds_byte(int r, int c) { const int st = (r >> 4) * 2 + (c >> 5), rr = r & 15, cc = c & 31, ob = rr * 64 + cc * 2; return st * 1024 + (ob ^ (((ob >> 9) & 1) << 5)); }
__host__ __device__ __forceinline__ void stage_rc(int b, int& R, int& C) { const int st = b / 1024, sb = b % 1024, swz = sb ^ (((sb >> 9) & 1) << 5); R = (st >> 1) * 16 + swz / 64; C = (st & 1) * 32 + (swz % 64) / 2; }
__host__ __device__ __forceinline__ int perm32(int rho) { const int n = rho >> 4, i = rho & 15; return 8 * (i >> 2) + 4 * n + (i & 3); }

struct UnitPN { int pm, pn; };
__device__ __forceinline__ bool static_next(int i, int G, int c, int nM, int nN, int& pm, int& pn) {
    const int nwg = nM * nN; const long L = (long)i * G + c; if (L >= nwg) return false;
    int wgid = (int)L; { const int q = nwg / NXCD, r = nwg % NXCD, xcd = wgid % NXCD, off = wgid / NXCD; wgid = (xcd < r ? xcd * (q + 1) : r * (q + 1) + (xcd - r) * q) + off; }
    const int nig = WGM * nN, gid = wgid / nig, fm = gid * WGM, gsz = (nM - fm) < WGM ? (nM - fm) : WGM;
    pm = fm + ((wgid % nig) % gsz); pn = (wgid % nig) / gsz; return true;
}
struct PlainOrder {
    typedef UnitPN Unit; static constexpr bool VARA = false, VARB = false;
    const char* A; const char* B; int K, nM, nN, G, c;
    __device__ __forceinline__ bool next(int i, Unit& u) const { return static_next(i, G, c, nM, nN, u.pm, u.pn); }
    __device__ __forceinline__ const char* baseA(const Unit& u) const { return A + (size_t)u.pm * 256 * K * 2; }
    __device__ __forceinline__ const char* baseB(const Unit& u) const { return B + (size_t)u.pn * 256 * K * 2; }
    __device__ __forceinline__ unsigned hstepA() const { return (unsigned)(128 * K * 2); }
    __device__ __forceinline__ unsigned hstepB() const { return (unsigned)(128 * K * 2); }
    __device__ __forceinline__ size_t koffA(int t) const { return (size_t)t * 128; }
    __device__ __forceinline__ void offA(const Unit&, const int (&R)[2], const int (&C)[2], unsigned (&o)[2][2]) const {
#pragma unroll
        for (int h = 0; h < 2; ++h)
#pragma unroll
            for (int i = 0; i < 2; ++i) o[h][i] = (unsigned)((h * 128 + R[i]) * K + C[i]) * 2u; }
    __device__ __forceinline__ void offB(const Unit& u, const int (&R)[2], const int (&C)[2], unsigned (&o)[2][2]) const { offA(u, R, C, o); }
};

struct PlainOrder8 {
    typedef UnitPN Unit; static constexpr bool VARA = false, VARB = false;
    const char* A; const char* B; int K, nM, nN, G, c;
    __device__ __forceinline__ bool next(int i, Unit& u) const { return static_next(i, G, c, nM, nN, u.pm, u.pn); }
    __device__ __forceinline__ const char* baseA(const Unit& u) const { return A + (size_t)u.pm * 256 * K; }
    __device__ __forceinline__ const char* baseB(const Unit& u) const { return B + (size_t)u.pn * 256 * K; }
    __device__ __forceinline__ unsigned hstepA() const { return (unsigned)(128 * K); }
    __device__ __forceinline__ unsigned hstepB() const { return (unsigned)(128 * K); }
    __device__ __forceinline__ size_t koffA(int t) const { return (size_t)t * 128; }
    __device__ __forceinline__ void offA(const Unit&, const int (&R)[2], const int (&C)[2], unsigned (&o)[2][2]) const {
#pragma unroll
        for (int h = 0; h < 2; ++h)
#pragma unroll
            for (int i = 0; i < 2; ++i) o[h][i] = (unsigned)((h * 128 + R[i]) * K + C[i] * 2); }
    __device__ __forceinline__ void offB(const Unit& u, const int (&R)[2], const int (&C)[2], unsigned (&o)[2][2]) const { offA(u, R, C, o); }
};
__device__ __forceinline__ const char* uni_ptr(const char* p) { const unsigned long long v = (unsigned long long)(uintptr_t)p; return (const char*)(uintptr_t)(((unsigned long long)(unsigned)__builtin_amdgcn_readfirstlane((int)(v >> 32)) << 32) | (unsigned)__builtin_amdgcn_readfirstlane((int)(unsigned)v)); }
template <bool B, class X, class Y> struct sel_t { typedef X type; };
template <class X, class Y> struct sel_t<false, X, Y> { typedef Y type; };
template <class Epi, class Sched>
__device__ __forceinline__ void gemm_phase(LAS unsigned char* lds, const int K, const Sched& S, const Epi& E) {
    typedef typename Sched::Unit Unit;
    int tid_ = threadIdx.x; asm volatile("" : "+v"(tid_));
    const int tid = tid_, wid = __builtin_amdgcn_readfirstlane(tid >> 6), lane = tid & 63, wr = wid >> 2, wc = wid & 3, fr = lane & 15, fq = lane >> 4;
    typedef typename sel_t<Epi::I8, i32x4, f32x4>::type acc_t;
    const int nt = K / (Epi::I8 ? 2 * BK : BK);
    int Rr[2], Cc[2], Rb[2];
#pragma unroll
    for (int i = 0; i < 2; ++i) { stage_rc(tid * 16 + i * 8192, Rr[i], Cc[i]); Rb[i] = Epi::PERM ? ((Rr[i] & ~31) + perm32(Rr[i] & 31)) : Rr[i]; }
    const size_t kstep = (size_t)(BK * 2);
    const unsigned ldsw = (unsigned)wid * 1024u, ldsb = (unsigned)(uintptr_t)lds;
    const unsigned hsA = S.hstepA(), hsB = S.hstepB();
    const int aoff = lds_byte(wr * 64 + fr, fq * 8), boff = lds_byte(wc * 32 + fr, fq * 8);
#define PG8_SA(b, h) (((b) * 2 + (h)) * HTB)
#define PG8_SB(b, h) ((4 + (b) * 2 + (h)) * HTB)
#ifdef PG8_BUILTIN_GLDS
#define PG8_STAGE_A(bufoff, gbase, O, h) do { _Pragma("unroll") for (int _i = 0; _i < 2; ++_i) \
        __builtin_amdgcn_global_load_lds((const unsigned*)(Sched::VARA ? (const char*)(gbase) + (O)[h][_i] : (const char*)(gbase) + (size_t)(h) * hsA + (O)[0][_i]), (LAS unsigned*)(lds + (bufoff) + ldsw + _i * 8192), 16, 0, 0); } while (0)
#define PG8_STAGE_B(bufoff, gbase, O, h) do { _Pragma("unroll") for (int _i = 0; _i < 2; ++_i) \
        __builtin_amdgcn_global_load_lds((const unsigned*)(Sched::VARB ? (const char*)(gbase) + (O)[h][_i] : (const char*)(gbase) + (size_t)(h) * hsB + (O)[0][_i]), (LAS unsigned*)(lds + (bufoff) + ldsw + _i * 8192), 16, 0, 0); } while (0)
#else
#define PG8_GLDS(ubase, voff, ldsaddr) do { unsigned keep_; asm volatile("s_mov_b32 %0, m0\n\ts_mov_b32 m0, %3\n\ts_nop 0\n\tglobal_load_lds_dwordx4 %1, %2\n\ts_mov_b32 m0, %0" \
        : "=&s"(keep_) : "v"(voff), "s"(uni_ptr(ubase)), "s"((unsigned)(ldsaddr)) : "memory"); } while (0)
#define PG8_STAGE_A(bufoff, gbase, O, h) do { _Pragma("unroll") for (int _i = 0; _i < 2; ++_i) \
        PG8_GLDS(Sched::VARA ? (const char*)(gbase) : (const char*)(gbase) + (size_t)(h) * hsA, Sched::VARA ? (O)[h][_i] : (O)[0][_i], ldsb + (unsigned)(bufoff) + ldsw + _i * 8192u); } while (0)
#define PG8_STAGE_B(bufoff, gbase, O, h) do { _Pragma("unroll") for (int _i = 0; _i < 2; ++_i) \
        PG8_GLDS(Sched::VARB ? (const char*)(gbase) : (const char*)(gbase) + (size_t)(h) * hsB, Sched::VARB ? (O)[h][_i] : (O)[0][_i], ldsb + (unsigned)(bufoff) + ldsw + _i * 8192u); } while (0)
#endif
#define PG8_LDA(dst, b, h) do { _Pragma("unroll") for (int m = 0; m < 4; ++m) _Pragma("unroll") for (int k = 0; k < 2; ++k) dst[m][k] = *(const LAS bf16x8*)(lds + PG8_SA(b, h) + aoff + m * 2048 + k * 1024); } while (0)
#define PG8_LDB(dst, b, h) do { _Pragma("unroll") for (int n = 0; n < 2; ++n) _Pragma("unroll") for (int k = 0; k < 2; ++k) dst[n][k] = *(const LAS bf16x8*)(lds + PG8_SB(b, h) + boff + n * 2048 + k * 1024); } while (0)
#define PG8_MMA(ai, bj, At, Bt) do { __builtin_amdgcn_s_setprio(1); _Pragma("unroll") for (int m = 0; m < 4; ++m) _Pragma("unroll") for (int n = 0; n < 2; ++n) _Pragma("unroll") for (int k = 0; k < 2; ++k) \
        { if constexpr (Epi::I8) acc[ai][bj][m][n] = __builtin_bit_cast(acc_t, __builtin_amdgcn_mfma_i32_16x16x64_i8(__builtin_bit_cast(i32x4, Bt[n][k]), __builtin_bit_cast(i32x4, At[m][k]), __builtin_bit_cast(i32x4, acc[ai][bj][m][n]), 0, 0, 0)); \
          else acc[ai][bj][m][n] = __builtin_bit_cast(acc_t, __builtin_amdgcn_mfma_f32_16x16x32_bf16(Bt[n][k], At[m][k], __builtin_bit_cast(f32x4, acc[ai][bj][m][n]), 0, 0, 0)); } __builtin_amdgcn_s_setprio(0); } while (0)
#ifdef DBG_WAIT0
#define PG8_WAIT_V(n) asm volatile("s_waitcnt vmcnt(0)" ::: "memory")
#else
#define PG8_WAIT_V(n) asm volatile("s_waitcnt vmcnt(" #n ")" ::: "memory")
#endif
#define PG8_WAIT_L(n) asm volatile("s_waitcnt lgkmcnt(" #n ")" ::: "memory")
#define PG8_BAR __builtin_amdgcn_s_barrier()
#define PG8_SCHED __builtin_amdgcn_sched_barrier(0)
    Unit cur, nxt; int ui = 0;
    if (!S.next(0, cur)) return;
    acc_t acc[2][2][4][2];
#pragma unroll
    for (int a = 0; a < 2; ++a)
#pragma unroll
        for (int b = 0; b < 2; ++b)
#pragma unroll
            for (int m = 0; m < 4; ++m)
#pragma unroll
                for (int n = 0; n < 2; ++n) acc[a][b][m][n] = acc_t{};
    bf16x8 At[4][2], B0[2][2], B1[2][2];
    unsigned oA[2][2], oB[2][2];
    S.offA(cur, Rr, Cc, oA); S.offB(cur, Rb, Cc, oB);
    const char* cA = S.baseA(cur); const char* cB = S.baseB(cur);
    PG8_STAGE_B(PG8_SB(0, 0), cB, oB, 0); PG8_STAGE_B(PG8_SB(0, 1), cB, oB, 1); PG8_STAGE_A(PG8_SA(0, 0), cA, oA, 0); PG8_STAGE_A(PG8_SA(0, 1), cA, oA, 1);
    if (wr == 1) PG8_BAR;
    PG8_WAIT_V(2); PG8_BAR;
    PG8_STAGE_B(PG8_SB(1, 0), cB + kstep, oB, 0); PG8_STAGE_A(PG8_SA(1, 0), cA + S.koffA(1), oA, 0); PG8_STAGE_B(PG8_SB(1, 1), cB + kstep, oB, 1);
    PG8_WAIT_V(6); PG8_BAR;
    for (;;) {
        const bool has_next = S.next(ui + 1, nxt);
        const char* nA = has_next ? S.baseA(nxt) : cA; const char* nB = has_next ? S.baseB(nxt) : cB;
        unsigned nOA[2][2], nOB[2][2];
#pragma unroll
        for (int h = 0; h < 2; ++h)
#pragma unroll
            for (int i = 0; i < 2; ++i) { nOA[h][i] = oA[h][i]; nOB[h][i] = oB[h][i]; }
        if constexpr (Sched::VARA) { if (has_next) S.offA(nxt, Rr, Cc, nOA); }
        if constexpr (Sched::VARB) { if (has_next) S.offB(nxt, Rb, Cc, nOB); }
#pragma unroll 1
        for (int t = 0; t < nt; t += 2) {
            const bool last = (t == nt - 2);
            if constexpr (Epi::MIDK) { if (t == nt / 2) E.mid(acc, cur, wr, wc, fr, fq); }
            const char* a1 = cA + S.koffA(t + 1);
            const char* a2 = last ? nA : cA + S.koffA(t + 2); const char* b2 = last ? nB : cB + (size_t)(t + 2) * kstep;
            const char* a3 = last ? nA + S.koffA(1) : cA + S.koffA(t + 3); const char* b3 = b2 + kstep;
            unsigned sA[2][2], sB[2][2];
#pragma unroll
            for (int h = 0; h < 2; ++h)
#pragma unroll
                for (int i = 0; i < 2; ++i) { sA[h][i] = (Sched::VARA && last) ? nOA[h][i] : oA[h][i]; sB[h][i] = (Sched::VARB && last) ? nOB[h][i] : oB[h][i]; }
            PG8_LDB(B0, 0, 0); PG8_LDB(B1, 0, 1); PG8_SCHED; PG8_LDA(At, 0, 0); PG8_STAGE_A(PG8_SA(1, 1), a1, oA, 1);
            PG8_WAIT_V(8); PG8_WAIT_L(0); PG8_BAR; PG8_MMA(0, 0, At, B0); PG8_MMA(0, 1, At, B1); PG8_BAR; PG8_SCHED;
            PG8_LDA(At, 0, 1); PG8_STAGE_B(PG8_SB(0, 0), b2, sB, 0); PG8_STAGE_B(PG8_SB(0, 1), b2, sB, 1); PG8_STAGE_A(PG8_SA(0, 0), a2, sA, 0);
            PG8_WAIT_V(8); PG8_WAIT_L(0); PG8_BAR; PG8_MMA(1, 0, At, B0); PG8_MMA(1, 1, At, B1); PG8_BAR; PG8_SCHED;
            PG8_LDB(B0, 1, 0); PG8_LDB(B1, 1, 1); PG8_SCHED; PG8_LDA(At, 1, 0); PG8_STAGE_A(PG8_SA(0, 1), a2, sA, 1);
            PG8_WAIT_V(8); PG8_WAIT_L(0); PG8_BAR; PG8_MMA(0, 0, At, B0); PG8_MMA(0, 1, At, B1); PG8_BAR; PG8_SCHED;
            PG8_LDA(At, 1, 1); PG8_STAGE_B(PG8_SB(1, 0), b3, sB, 0); PG8_STAGE_B(PG8_SB(1, 1), b3, sB, 1); PG8_STAGE_A(PG8_SA(1, 0), a3, sA, 0);
            PG8_WAIT_V(8); PG8_WAIT_L(0); PG8_BAR; PG8_MMA(1, 0, At, B0); PG8_MMA(1, 1, At, B1); PG8_BAR; PG8_SCHED;
        }
        if (wr == 0) PG8_BAR;
        E(acc, cur, wr, wc, fr, fq);
        if (!has_next) break;
#pragma unroll
        for (int a = 0; a < 2; ++a)
#pragma unroll
            for (int b = 0; b < 2; ++b)
#pragma unroll
                for (int m = 0; m < 4; ++m)
#pragma unroll
                    for (int n = 0; n < 2; ++n) acc[a][b][m][n] = acc_t{};
        cur = nxt; cA = nA; cB = nB; ++ui;
#pragma unroll
        for (int h = 0; h < 2; ++h)
#pragma unroll
            for (int i = 0; i < 2; ++i) { oA[h][i] = nOA[h][i]; oB[h][i] = nOB[h][i]; }
        if (wr == 1) PG8_BAR;
    }
    PG8_WAIT_V(0);
    PG8_BAR;
#undef PG8_SA
#undef PG8_SB
#undef PG8_STAGE_A
#undef PG8_STAGE_B
#ifdef PG8_GLDS
#undef PG8_GLDS
#endif
#undef PG8_LDA
#undef PG8_LDB
#undef PG8_MMA
#undef PG8_WAIT_V
#undef PG8_WAIT_L
#undef PG8_BAR
#undef PG8_SCHED
}
}
using pg8::UnitPN;

struct F1Order {
    typedef UnitPN Unit; static constexpr bool VARA = false, VARB = false;
    const char* A; const char* B; int G, c;
    __device__ __forceinline__ bool next(int i, Unit& u) const { const int L = i * G + c; if (L >= 1024) return false; u.pn = L >> 2; u.pm = L & 3; return true; }
    __device__ __forceinline__ const char* baseA(const Unit& u) const { return A + (size_t)u.pm * 256 * 2048; }
    __device__ __forceinline__ const char* baseB(const Unit& u) const { return B + ((size_t)(u.pn >> 5) * 8192 + 2 * (u.pn & 31)) * 2048; }
    __device__ __forceinline__ unsigned hstepA() const { return 128u * 2048u; }
    __device__ __forceinline__ unsigned hstepB() const { return 2048u; }
    __device__ __forceinline__ size_t koffA(int t) const { return (size_t)t * 128; }
    __device__ __forceinline__ void offA(const Unit&, const int (&R)[2], const int (&C)[2], unsigned (&o)[2][2]) const {
#pragma unroll
        for (int h = 0; h < 2; ++h)
#pragma unroll
            for (int i = 0; i < 2; ++i) o[h][i] = (unsigned)((h * 128 + R[i]) * 1024 + C[i]) * 2u; }
    __device__ __forceinline__ void offB(const Unit&, const int (&R)[2], const int (&C)[2], unsigned (&o)[2][2]) const {
#pragma unroll
        for (int h = 0; h < 2; ++h)
#pragma unroll
            for (int i = 0; i < 2; ++i) o[h][i] = (unsigned)((h + 64 * R[i]) * 1024 + C[i]) * 2u; }
};
struct FBOrder {
    typedef UnitPN Unit; static constexpr bool VARA = false, VARB = false;
    const char* A; const char* B; int G, c;
    __device__ __forceinline__ bool next(int i, Unit& u) const { const int L = i * G + c; if (L >= 1024) return false; u.pm = L >> 4; u.pn = L & 15; return true; }
    __device__ __forceinline__ const char* baseA(const Unit& u) const { return A + (size_t)u.pm * 65536; }
    __device__ __forceinline__ const char* baseB(const Unit& u) const { return B + ((size_t)u.pm * 4096 + (size_t)u.pn * 256) * 512; }
    __device__ __forceinline__ unsigned hstepA() const { return 0u; }
    __device__ __forceinline__ unsigned hstepB() const { return 128u * 512u; }
    __device__ __forceinline__ size_t koffA(int t) const { return (size_t)t * 128; }
    __device__ __forceinline__ void offA(const Unit&, const int (&R)[2], const int (&C)[2], unsigned (&o)[2][2]) const {
#pragma unroll
        for (int h = 0; h < 2; ++h)
#pragma unroll
            for (int i = 0; i < 2; ++i) o[h][i] = (unsigned)(R[i] * 256 + C[i]) * 2u; }
    __device__ __forceinline__ void offB(const Unit&, const int (&R)[2], const int (&C)[2], unsigned (&o)[2][2]) const {
#pragma unroll
        for (int h = 0; h < 2; ++h)
#pragma unroll
            for (int i = 0; i < 2; ++i) o[h][i] = (unsigned)((h * 128 + R[i]) * 256 + C[i]) * 2u; }
};
struct MergeOrder {
    typedef UnitPN Unit; static constexpr bool VARA = false, VARB = false;
    const char* A; const char* A2; const char* B; int G, c;
    __device__ __forceinline__ bool next(int i, Unit& u) const { return pg8::static_next(i, G, c, T / 256, 4, u.pm, u.pn); }
    __device__ __forceinline__ const char* baseA(const Unit& u) const { return A + (size_t)u.pm * 256 * 1024; }
    __device__ __forceinline__ const char* baseB(const Unit& u) const { return B + (size_t)u.pn * 256 * 2048; }
    __device__ __forceinline__ unsigned hstepA() const { return 128u * 1024u; }
    __device__ __forceinline__ unsigned hstepB() const { return 128u * 2048u; }
    __device__ __forceinline__ size_t koffA(int t) const { return t < 8 ? (size_t)t * 128 : (size_t)(A2 - A) + (size_t)(t - 8) * 128; }
    __device__ __forceinline__ void offA(const Unit&, const int (&R)[2], const int (&C)[2], unsigned (&o)[2][2]) const {
#pragma unroll
        for (int h = 0; h < 2; ++h)
#pragma unroll
            for (int i = 0; i < 2; ++i) o[h][i] = (unsigned)((h * 128 + R[i]) * 512 + C[i]) * 2u; }
    __device__ __forceinline__ void offB(const Unit&, const int (&R)[2], const int (&C)[2], unsigned (&o)[2][2]) const {
#pragma unroll
        for (int h = 0; h < 2; ++h)
#pragma unroll
            for (int i = 0; i < 2; ++i) o[h][i] = (unsigned)((h * 128 + R[i]) * 1024 + C[i]) * 2u; }
};
struct F1Order8 {
    typedef UnitPN Unit; static constexpr bool VARA = false, VARB = false;
    const char* A; const char* B; int G, c;
    __device__ __forceinline__ bool next(int i, Unit& u) const { const int L = i * G + c; if (L >= 1024) return false; u.pn = L >> 2; u.pm = L & 3; return true; }
    __device__ __forceinline__ const char* baseA(const Unit& u) const { return A + (size_t)u.pm * 256 * 1024; }
    __device__ __forceinline__ const char* baseB(const Unit& u) const { return B + ((size_t)(u.pn >> 5) * 8192 + 2 * (u.pn & 31)) * 1024; }
    __device__ __forceinline__ unsigned hstepA() const { return 128u * 1024u; }
    __device__ __forceinline__ unsigned hstepB() const { return 1024u; }
    __device__ __forceinline__ size_t koffA(int t) const { return (size_t)t * 128; }
    __device__ __forceinline__ void offA(const Unit&, const int (&R)[2], const int (&C)[2], unsigned (&o)[2][2]) const {
#pragma unroll
        for (int h = 0; h < 2; ++h)
#pragma unroll
            for (int i = 0; i < 2; ++i) o[h][i] = (unsigned)((h * 128 + R[i]) * 1024 + C[i] * 2); }
    __device__ __forceinline__ void offB(const Unit&, const int (&R)[2], const int (&C)[2], unsigned (&o)[2][2]) const {
#pragma unroll
        for (int h = 0; h < 2; ++h)
#pragma unroll
            for (int i = 0; i < 2; ++i) o[h][i] = (unsigned)((h + 64 * R[i]) * 1024 + C[i] * 2); }
};
struct MoeUnit { int e, row0, cnt, orow, pn; };
template <int NPN> __device__ __forceinline__ bool moe_next(int i, int G, int c, const LAS int* tst, const LAS int* cntl, MoeUnit& u) {
    const int L = i * G + c; const int tile = L / NPN; const int total = __builtin_amdgcn_readfirstlane(tst[32]);
    if (tile >= total) return false;
    const LAS unsigned char* texp = (const LAS unsigned char*)(tst + 40);
    const int e = __builtin_amdgcn_readfirstlane((int)texp[tile]);
    u.e = e; u.row0 = (tile - __builtin_amdgcn_readfirstlane(tst[e])) * 256; u.cnt = __builtin_amdgcn_readfirstlane(cntl[e]); u.orow = tile * 256; u.pn = L % NPN; return true;
}
struct MoeUpOrder {
    typedef MoeUnit Unit; static constexpr bool VARA = true, VARB = false;
    const char* A; const char* B; const u32x2* list; const LAS int* tst; const LAS int* cntl; int G, c;
    __device__ __forceinline__ bool next(int i, Unit& u) const { return moe_next<2>(i, G, c, tst, cntl, u); }
    __device__ __forceinline__ const char* baseA(const Unit&) const { return A; }
    __device__ __forceinline__ const char* baseB(const Unit& u) const { return B + ((size_t)u.e * 512 + (size_t)u.pn * 256) * 2048; }
    __device__ __forceinline__ unsigned hstepA() const { return 0u; }
    __device__ __forceinline__ unsigned hstepB() const { return 128u * 2048u; }
    __device__ __forceinline__ size_t koffA(int t) const { return (size_t)t * 128; }
    __device__ __forceinline__ void offA(const Unit& u, const int (&R)[2], const int (&C)[2], unsigned (&o)[2][2]) const {
#pragma unroll
        for (int h = 0; h < 2; ++h)
#pragma unroll
            for (int i = 0; i < 2; ++i) { const int li = u.row0 + h * 128 + R[i]; const int tok = (li < u.cnt) ? (int)(list[(size_t)u.e * 65536 + li].x & 0x7fffffffu) : 0; o[h][i] = (unsigned)tok * 2048u + (unsigned)C[i] * 2u; } }
    __device__ __forceinline__ void offB(const Unit&, const int (&R)[2], const int (&C)[2], unsigned (&o)[2][2]) const {
#pragma unroll
        for (int h = 0; h < 2; ++h)
#pragma unroll
            for (int i = 0; i < 2; ++i) o[h][i] = (unsigned)((h * 128 + R[i]) * 1024 + C[i]) * 2u; }
};
struct MoeUpOrder8 {
    typedef MoeUnit Unit; static constexpr bool VARA = true, VARB = false;
    const char* A; const char* B; const u32x2* list; const LAS int* tst; const LAS int* cntl; int G, c;
    __device__ __forceinline__ bool next(int i, Unit& u) const { return moe_next<2>(i, G, c, tst, cntl, u); }
    __device__ __forceinline__ const char* baseA(const Unit&) const { return A; }
    __device__ __forceinline__ const char* baseB(const Unit& u) const { return B + ((size_t)u.e * 512 + (size_t)u.pn * 256) * 1024; }
    __device__ __forceinline__ unsigned hstepA() const { return 0u; }
    __device__ __forceinline__ unsigned hstepB() const { return 128u * 1024u; }
    __device__ __forceinline__ size_t koffA(int t) const { return (size_t)t * 128; }
    __device__ __forceinline__ void offA(const Unit& u, const int (&R)[2], const int (&C)[2], unsigned (&o)[2][2]) const {
#pragma unroll
        for (int h = 0; h < 2; ++h)
#pragma unroll
            for (int i = 0; i < 2; ++i) { const int li = u.row0 + h * 128 + R[i]; const int tok = (li < u.cnt) ? (int)(list[(size_t)u.e * 65536 + li].x & 0x7fffffffu) : 0; o[h][i] = (unsigned)tok * 1024u + (unsigned)C[i] * 2u; } }
    __device__ __forceinline__ void offB(const Unit&, const int (&R)[2], const int (&C)[2], unsigned (&o)[2][2]) const {
#pragma unroll
        for (int h = 0; h < 2; ++h)
#pragma unroll
            for (int i = 0; i < 2; ++i) o[h][i] = (unsigned)((h * 128 + R[i]) * 1024 + C[i] * 2); }
};
struct MoeDownOrder {
    typedef MoeUnit Unit; static constexpr bool VARA = false, VARB = false;
    const char* A; const char* B; const LAS int* tst; const LAS int* cntl; int G, c;
    __device__ __forceinline__ bool next(int i, Unit& u) const { return moe_next<4>(i, G, c, tst, cntl, u); }
    __device__ __forceinline__ const char* baseA(const Unit& u) const { return A + (size_t)u.orow * 512; }
    __device__ __forceinline__ const char* baseB(const Unit& u) const { return B + ((size_t)u.e * 1024 + (size_t)u.pn * 256) * 512; }
    __device__ __forceinline__ unsigned hstepA() const { return 128u * 512u; }
    __device__ __forceinline__ unsigned hstepB() const { return 128u * 512u; }
    __device__ __forceinline__ size_t koffA(int t) const { return (size_t)t * 128; }
    __device__ __forceinline__ void offA(const Unit&, const int (&R)[2], const int (&C)[2], unsigned (&o)[2][2]) const {
#pragma unroll
        for (int h = 0; h < 2; ++h)
#pragma unroll
            for (int i = 0; i < 2; ++i) o[h][i] = (unsigned)((h * 128 + R[i]) * 256 + C[i]) * 2u; }
    __device__ __forceinline__ void offB(const Unit& u, const int (&R)[2], const int (&C)[2], unsigned (&o)[2][2]) const { offA(u, R, C, o); }
};

typedef const f32x4 (&AccRef)[2][2][4][2];
#ifdef EPI_NT_STORES
#define EPI_ST(TY, P, V) __builtin_nontemporal_store((V), (TY*)(P))
#else
#define EPI_ST(TY, P, V) (*(TY*)(P) = (V))
#endif
#ifndef EPI_FENCE
#define EPI_FENCE do { } while (0)
#endif
#define EPI_LOOP_AM _Pragma("unroll") for (int ai = 0; ai < 2; ++ai) _Pragma("unroll") for (int m = 0; m < 4; ++m)

__device__ __forceinline__ unsigned q8(float x) { return (unsigned)(sigmoidf_(x) * 255.0f + 0.5f); }
__device__ __forceinline__ size_t gate_off(int pm, int which, int pn4, int wave, int ai, int bj, int m, int lane) { return ((((size_t)(pm * 2 + which) * 4 + pn4) * 8 + wave) * 16 + (ai * 2 + bj) * 4 + m) * 512 + lane * 8; }
struct EpiZ {
    static constexpr bool PERM = true, MIDK = false, I8 = false;
    bf16_t* __restrict__ QL; bf16_t* __restrict__ KVL; float* __restrict__ SSQQ; float* __restrict__ SSQKV; unsigned char* __restrict__ GATE; const float* __restrict__ bg; bf16_t* __restrict__ KB; const float* __restrict__ RC; const float* __restrict__ RS;
    __device__ __forceinline__ void operator()(AccRef acc, const UnitPN& u, int wr, int wc, int fr, int fq) const {
        const int row0 = u.pm * 256 + wr * 64 + fr, c0 = wc * 32 + 8 * fq;
        if (u.pn < 2) {
            bf16_t* O = u.pn ? KVL : QL; float* SS = u.pn ? SSQKV : SSQQ;
            EPI_LOOP_AM { const int row = row0 + ai * 128 + m * 16; float s = 0.f;
#pragma unroll
                for (int bj = 0; bj < 2; ++bj) { const f32x4 v0 = acc[ai][bj][m][0], v1 = acc[ai][bj][m][1];
                    s += (v0[0] * v0[0] + v0[1] * v0[1]) + (v0[2] * v0[2] + v0[3] * v0[3]) + (v1[0] * v1[0] + v1[1] * v1[1]) + (v1[2] * v1[2] + v1[3] * v1[3]);
                    EPI_ST(u32x4, O + (size_t)row * 256 + bj * 128 + c0, pack8(v0, v1)); }
                s += __shfl_xor(s, 16); s += __shfl_xor(s, 32);
                if (fq == 0) SS[(size_t)row * 4 + wc] = s; }
        } else if (u.pn < 10) {
            const int gc0 = (u.pn - 2) * 256 + c0;
            f32x4 bv[2][2];
#pragma unroll
            for (int bj = 0; bj < 2; ++bj)
#pragma unroll
                for (int n = 0; n < 2; ++n) bv[bj][n] = *(const f32x4*)(bg + gc0 + bj * 128 + 4 * n);
            EPI_LOOP_AM { const int row = row0 + ai * 128 + m * 16;
#pragma unroll
                for (int bj = 0; bj < 2; ++bj) { const f32x4 v0 = acc[ai][bj][m][0] + bv[bj][0], v1 = acc[ai][bj][m][1] + bv[bj][1];
                    u32x2 w;
                    w.x = q8(v0[0]) | (q8(v0[1]) << 8) | (q8(v0[2]) << 16) | (q8(v0[3]) << 24); w.y = q8(v1[0]) | (q8(v1[1]) << 8) | (q8(v1[2]) << 16) | (q8(v1[3]) << 24);
                    EPI_ST(u32x2, GATE + (size_t)row * 2048 + gc0 + bj * 128, w); }
                EPI_FENCE; }
        } else if (wc == 0) {
            f32x4 cs[2][4], sn[2][4];
            EPI_LOOP_AM { const int row = row0 + ai * 128 + m * 16; cs[ai][m] = *(const f32x4*)(RC + (size_t)row * 16 + 4 * fq); sn[ai][m] = *(const f32x4*)(RS + (size_t)row * 16 + 4 * fq); }
            EPI_LOOP_AM { const int row = row0 + ai * 128 + m * 16; const int b = row >> 13, s = row & 8191;
                const f32x4 x1 = acc[ai][0][m][0], x2 = acc[ai][0][m][1];
                const u32x2 p1 = pack4(x1 * cs[ai][m] - x2 * sn[ai][m]), p2 = pack4(x2 * cs[ai][m] + x1 * sn[ai][m]);
#pragma unroll
                for (int h = 0; h < 8; ++h) { bf16_t* kp = KB + (((size_t)(b * 8 + h) * 128 + (s >> 6)) * 12 + 8 + (fq >> 1)) * 512 + (s & 63) * 8 + 4 * (fq & 1); *(u32x2*)kp = p1; EPI_ST(u32x2, kp + 1024, p2); } }
        }
    }
};
struct EpiF1 {
    static constexpr bool PERM = true, MIDK = false, I8 = false;
    bf16_t* YT2;
    __device__ __forceinline__ void operator()(AccRef acc, const UnitPN& u, int wr, int wc, int fr, int fq) const {
        const int b = u.pn >> 5, tt = u.pn & 31;
        EPI_LOOP_AM { const int r = u.pm * 256 + ai * 128 + wr * 64 + m * 16 + fr; const int ri = r >> 9, gc = r & 511;
#pragma unroll
            for (int bj = 0; bj < 2; ++bj) { const int sa = 2 * tt + bj, sb = wc * 32 + 8 * fq;
                EPI_ST(u32x4, YT2 + ((((size_t)b * 512 + gc) * 64 + sa) * 2 + ri) * 128 + sb, pack8(acc[ai][bj][m][0], acc[ai][bj][m][1])); } }
    }
};
struct EpiFA {
    static constexpr bool PERM = true, MIDK = false, I8 = false;
    bf16_t* Z;
    __device__ __forceinline__ void operator()(AccRef acc, const UnitPN& u, int wr, int wc, int fr, int fq) const {
        EPI_LOOP_AM { const int kb = wr * 64 + m * 16 + fr;
#pragma unroll
            for (int bj = 0; bj < 2; ++bj) { const int gcb = u.pn * 4 + bj * 2 + (wc >> 1), sa = 32 * (wc & 1) + 8 * fq;
                EPI_ST(u32x4, Z + (((((size_t)(kb >> 1) * 4096 + gcb) * 2 + (kb & 1)) * 2 + ai) * 64 + sa), pack8(acc[ai][bj][m][0], acc[ai][bj][m][1])); } }
    }
};
struct EpiFB {
    static constexpr bool PERM = true, MIDK = false, I8 = false;
    bf16_t* FO;
    __device__ __forceinline__ void operator()(AccRef acc, const UnitPN& u, int wr, int wc, int fr, int fq) const {
        const int b = u.pn >> 1;
#pragma unroll
        for (int m = 0; m < 4; ++m) { const int ka = m * 16 + fr, s = 2 * u.pm + wr + 128 * ka;
#pragma unroll
            for (int bj = 0; bj < 2; ++bj) { const int gc = (u.pn & 1) * 256 + bj * 128 + wc * 32 + 8 * fq;
                EPI_ST(u32x4, FO + ((size_t)b * 8192 + s) * 512 + gc, pack8(acc[0][bj][m][0], acc[0][bj][m][1])); } }
    }
};
struct EpiQ {
    static constexpr bool PERM = true, MIDK = false, I8 = false;
    bf16_t* __restrict__ Q; const float* __restrict__ SSQ; const float* __restrict__ RC; const float* __restrict__ RS;
    __device__ __forceinline__ void operator()(AccRef acc, const UnitPN& u, int wr, int wc, int fr, int fq) const {
        const int g0 = u.pn * 8 + wc, g1 = g0 + 4; const bool rope = (g0 % 3 == 2) || (g1 % 3 == 2);
#pragma unroll
        for (int ai = 0; ai < 2; ++ai) {
            f32x4 sq[4], cs[4], sn[4];
#pragma unroll
            for (int m = 0; m < 4; ++m) { const int row = u.pm * 256 + ai * 128 + wr * 64 + m * 16 + fr; sq[m] = *(const f32x4*)(SSQ + (size_t)row * 4);
                if (rope) { cs[m] = *(const f32x4*)(RC + (size_t)row * 16 + 4 * fq); sn[m] = *(const f32x4*)(RS + (size_t)row * 16 + 4 * fq); } else { cs[m] = sq[m]; sn[m] = sq[m]; } }
#pragma unroll
            for (int m = 0; m < 4; ++m) { const int row = u.pm * 256 + ai * 128 + wr * 64 + m * 16 + fr;
                const float rs = C2 * __builtin_amdgcn_rsqf(((sq[m][0] + sq[m][1]) + (sq[m][2] + sq[m][3])) * (1.0f / 256.0f) + EPS);
#pragma unroll
                for (int bj = 0; bj < 2; ++bj) { const int g32 = u.pn * 8 + bj * 4 + wc; const int hh = g32 / 3, part = g32 - 3 * hh;
                    const f32x4 v0 = acc[ai][bj][m][0] * rs, v1 = acc[ai][bj][m][1] * rs;
                    if (part < 2) { EPI_ST(u32x4, Q + (size_t)row * QC + g32 * 32 + 8 * fq, pack8(v0, v1)); }
                    else { bf16_t* qp = Q + (size_t)row * QC + hh * 96 + 64 + 4 * fq;
                        *(u32x2*)qp = pack4(v0 * cs[m] - v1 * sn[m]); EPI_ST(u32x2, qp + 16, pack4(v1 * cs[m] + v0 * sn[m])); } } }
        }
    }
};
struct EpiKV {
    static constexpr bool PERM = true, MIDK = false, I8 = false;
    bf16_t* __restrict__ KB; bf16_t* __restrict__ VB; const float* __restrict__ SSQ;
    __device__ __forceinline__ void operator()(AccRef acc, const UnitPN& u, int wr, int wc, int fr, int fq) const {
        f32x4 sq[2][4];
        EPI_LOOP_AM { const int row = u.pm * 256 + ai * 128 + wr * 64 + m * 16 + fr; sq[ai][m] = *(const f32x4*)(SSQ + (size_t)row * 4); }
        EPI_LOOP_AM { const int row = u.pm * 256 + ai * 128 + wr * 64 + m * 16 + fr; const int b = row >> 13, s = row & 8191;
            const float rs = __builtin_amdgcn_rsqf(((sq[ai][m][0] + sq[ai][m][1]) + (sq[ai][m][2] + sq[ai][m][3])) * (1.0f / 256.0f) + EPS);
#pragma unroll
            for (int bj = 0; bj < 2; ++bj) { const int c = (u.pn & 1) * 256 + bj * 128 + wc * 32 + 8 * fq; const int hh = c >> 6, d = c & 63;
                const u32x4 w = pack8(acc[ai][bj][m][0] * rs, acc[ai][bj][m][1] * rs);
                if (u.pn < 2) EPI_ST(u32x4, KB + (((size_t)(b * 8 + hh) * 128 + (s >> 6)) * 12 + (d >> 3)) * 512 + (s & 63) * 8, w);
                else EPI_ST(u32x4, VB + (((size_t)(b * 8 + hh) * 128 + (s >> 6)) * 8 + (d >> 5) * 4 + ((s & 63) >> 4)) * 512 + (s & 15) * 32 + (d & 31), w); } }
    }
};
struct EpiMerge2 {
    static constexpr bool PERM = true, MIDK = true, I8 = false;
    bf16_t* __restrict__ MRG; const unsigned char* __restrict__ GATE;
    __device__ __forceinline__ void mid(f32x4 (&acc)[2][2][4][2], const UnitPN& u, int wr, int wc, int fr, int fq) const {
#pragma unroll
        for (int ai = 0; ai < 2; ++ai) {
            u32x2 ga[4][2], gf[4][2];
#pragma unroll
            for (int m = 0; m < 4; ++m)
#pragma unroll
                for (int bj = 0; bj < 2; ++bj) { ga[m][bj] = *(const u32x2*)(GATE + gate_off(u.pm, 0, u.pn, wr * 4 + wc, ai, bj, m, fq * 16 + fr)); gf[m][bj] = *(const u32x2*)(GATE + gate_off(u.pm, 1, u.pn, wr * 4 + wc, ai, bj, m, fq * 16 + fr)); }
#pragma unroll
            for (int m = 0; m < 4; ++m)
#pragma unroll
                for (int bj = 0; bj < 2; ++bj) { const u32x2 a = ga[m][bj], f = gf[m][bj];
#pragma unroll
                    for (int j = 0; j < 4; ++j) { const float fa0 = (float)((a.x >> (8 * j)) & 0xffu), fa1 = (float)((a.y >> (8 * j)) & 0xffu);
                        const float ff0 = fmaxf((float)((f.x >> (8 * j)) & 0xffu), 1.0f), ff1 = fmaxf((float)((f.y >> (8 * j)) & 0xffu), 1.0f);
                        acc[ai][bj][m][0][j] *= fa0 * __builtin_amdgcn_rcpf(ff0); acc[ai][bj][m][1][j] *= fa1 * __builtin_amdgcn_rcpf(ff1); } }
        }
    }
    __device__ __forceinline__ void operator()(AccRef acc, const UnitPN& u, int wr, int wc, int fr, int fq) const {
#pragma unroll
        for (int ai = 0; ai < 2; ++ai) {
            u32x2 gf[4][2];
#pragma unroll
            for (int m = 0; m < 4; ++m)
#pragma unroll
                for (int bj = 0; bj < 2; ++bj) gf[m][bj] = *(const u32x2*)(GATE + gate_off(u.pm, 1, u.pn, wr * 4 + wc, ai, bj, m, fq * 16 + fr));
#pragma unroll
            for (int m = 0; m < 4; ++m)
#pragma unroll
                for (int bj = 0; bj < 2; ++bj) { const int row = u.pm * 256 + ai * 128 + wr * 64 + m * 16 + fr, col = u.pn * 256 + bj * 128 + wc * 32 + 8 * fq; const u32x2 f = gf[m][bj];
                    f32x4 v0 = acc[ai][bj][m][0] * (1.0f / 255.0f), v1 = acc[ai][bj][m][1] * (1.0f / 255.0f);
#pragma unroll
                    for (int j = 0; j < 4; ++j) { v0[j] *= fmaxf((float)((f.x >> (8 * j)) & 0xffu), 1.0f); v1[j] *= fmaxf((float)((f.y >> (8 * j)) & 0xffu), 1.0f); }
                    EPI_ST(u32x4, MRG + (size_t)row * 1024 + col, pack8(v0, v1)); }
        }
    }
};
struct EpiH {
    static constexpr bool PERM = true, MIDK = false, I8 = false;
    const float* __restrict__ X; bf16_t* __restrict__ Hout; const float* __restrict__ MODF;
    __device__ __forceinline__ void operator()(AccRef acc, const UnitPN& u, int wr, int wc, int fr, int fq) const {
        const int b = u.pm >> 5; const int col0 = u.pn * 256 + wc * 32 + 8 * fq;
        f32x4 gt[2][2];
#pragma unroll
        for (int bj = 0; bj < 2; ++bj)
#pragma unroll
            for (int n = 0; n < 2; ++n) gt[bj][n] = *(const f32x4*)(MODF + (size_t)b * 8192 + 2048 + col0 + bj * 128 + n * 4);
#pragma unroll
        for (int ai = 0; ai < 2; ++ai)
#pragma unroll
            for (int mp = 0; mp < 2; ++mp) {
                f32x4 xv[2][2][2];
#pragma unroll
                for (int mm = 0; mm < 2; ++mm)
#pragma unroll
                    for (int bj = 0; bj < 2; ++bj) { const size_t off = (size_t)(u.pm * 256 + ai * 128 + wr * 64 + (2 * mp + mm) * 16 + fr) * 1024 + col0;
                        xv[mm][bj][0] = *(const f32x4*)(X + off + bj * 128); xv[mm][bj][1] = *(const f32x4*)(X + off + bj * 128 + 4); }
#pragma unroll
                for (int mm = 0; mm < 2; ++mm)
#pragma unroll
                    for (int bj = 0; bj < 2; ++bj) { const int m = 2 * mp + mm; const size_t off = (size_t)(u.pm * 256 + ai * 128 + wr * 64 + m * 16 + fr) * 1024 + col0;
                        EPI_ST(u32x4, Hout + off + bj * 128, pack8(xv[mm][bj][0] + gt[bj][0] * acc[ai][bj][m][0], xv[mm][bj][1] + gt[bj][1] * acc[ai][bj][m][1])); }
            }
    }
};
struct EpiUp {
    static constexpr bool PERM = true, MIDK = false, I8 = false;
    bf16_t* HID;
    __device__ __forceinline__ void operator()(AccRef acc, const MoeUnit& u, int wr, int wc, int fr, int fq) const {
        EPI_LOOP_AM { const int lr = ai * 128 + wr * 64 + m * 16 + fr;
#pragma unroll
            for (int bj = 0; bj < 2; ++bj) { const int hh = u.pn * 128 + bj * 64 + wc * 16 + 4 * fq;
                const f32x4 g = acc[ai][bj][m][0], uu = acc[ai][bj][m][1]; f32x4 o;
#pragma unroll
                for (int j = 0; j < 4; ++j) o[j] = g[j] * sigmoidf_(g[j]) * uu[j];
                EPI_ST(u32x2, HID + (size_t)(u.orow + lr) * 256 + hh, pack4(o)); } }
    }
};
struct EpiDown {
    static constexpr bool PERM = true, MIDK = false, I8 = false;
    bf16_t* __restrict__ Y2;
    __device__ __forceinline__ void operator()(AccRef acc, const MoeUnit& u, int wr, int wc, int fr, int fq) const {
        EPI_LOOP_AM { const size_t row = (size_t)u.orow + ai * 128 + wr * 64 + m * 16 + fr;
#pragma unroll
            for (int bj = 0; bj < 2; ++bj) { const int col = u.pn * 256 + bj * 128 + wc * 32 + 8 * fq;
                EPI_ST(u32x4, Y2 + row * 1024 + col, pack8(acc[ai][bj][m][0], acc[ai][bj][m][1])); } }
    }
};

#ifdef PROBE_KLOOP
struct EpiNull {
    static constexpr bool PERM = true, MIDK = false, I8 = false;
    float* sink; int never;
    __device__ __forceinline__ void operator()(AccRef acc, const UnitPN& u, int wr, int wc, int fr, int fq) const {
        if (never < 0) { f32x4 s = acc[0][0][0][0];
            EPI_LOOP_AM { s += acc[ai][0][m][0] + acc[ai][0][m][1] + acc[ai][1][m][0] + acc[ai][1][m][1]; }
            *(f32x4*)(sink + fr) = s; }
    }
};
#endif

typedef const i32x4 (&AccRefI)[2][2][4][2];
__device__ __forceinline__ f32x4 i2f(const i32x4 v, float s) { return (f32x4){(float)v[0] * s, (float)v[1] * s, (float)v[2] * s, (float)v[3] * s}; }
struct EpiZ8 {
    static constexpr bool PERM = true, MIDK = false, I8 = true;
    unsigned char* __restrict__ ws; const float* __restrict__ bg;
    __device__ __forceinline__ void operator()(AccRefI acc, const UnitPN& u, int wr, int wc, int fr_, int fq_) const {
        int fr = fr_, fq = fq_; asm volatile("" : "+v"(fr), "+v"(fq));
        const int row0 = u.pm * 256 + wr * 64 + fr, c0 = wc * 32 + 8 * fq;
        const float* SU = (const float*)(ws + WS_SU);
        const float sw = __uint_as_float(((const unsigned*)(ws + WS_CTL))[CW_WMAX]) * (1.0f / 127.0f);
        if (u.pn < 2) {
            bf16_t* O = (bf16_t*)(ws + (u.pn ? WS_KVL : WS_QL)); float* SS = (float*)(ws + (u.pn ? WS_SSQKV : WS_SSQQ));
            EPI_LOOP_AM { const int row = row0 + ai * 128 + m * 16; float s = 0.f; const float su_ = SU[row] * sw;
#pragma unroll
                for (int bj = 0; bj < 2; ++bj) { const f32x4 v0 = i2f(acc[ai][bj][m][0], su_), v1 = i2f(acc[ai][bj][m][1], su_);
                    s += (v0[0] * v0[0] + v0[1] * v0[1]) + (v0[2] * v0[2] + v0[3] * v0[3]) + (v1[0] * v1[0] + v1[1] * v1[1]) + (v1[2] * v1[2] + v1[3] * v1[3]);
                    EPI_ST(u32x4, O + (size_t)row * 256 + bj * 128 + c0, pack8(v0, v1)); }
                s += __shfl_xor(s, 16); s += __shfl_xor(s, 32);
                if (fq == 0) SS[(size_t)row * 4 + wc] = s; }
        } else if (u.pn < 10) {
            const int gc0 = (u.pn - 2) * 256 + c0;
#pragma unroll
            for (int bj = 0; bj < 2; ++bj) {
                const f32x4 bv0 = *(const f32x4*)(bg + gc0 + bj * 128), bv1 = *(const f32x4*)(bg + gc0 + bj * 128 + 4);
                EPI_LOOP_AM { const int row = row0 + ai * 128 + m * 16; const float su_ = SU[row] * sw;
                    const f32x4 v0 = i2f(acc[ai][bj][m][0], su_) + bv0, v1 = i2f(acc[ai][bj][m][1], su_) + bv1;
                    u32x2 w;
                    w.x = q8(v0[0]) | (q8(v0[1]) << 8) | (q8(v0[2]) << 16) | (q8(v0[3]) << 24); w.y = q8(v1[0]) | (q8(v1[1]) << 8) | (q8(v1[2]) << 16) | (q8(v1[3]) << 24);
                    EPI_ST(u32x2, ws + WS_GATE + gate_off(u.pm, (u.pn - 2) >> 2, (u.pn - 2) & 3, wr * 4 + wc, ai, bj, m, fq * 16 + fr), w); }
            }
        } else if (wc == 0) {
            f32x4 cs[2][4], sn[2][4];
            EPI_LOOP_AM { const int row = row0 + ai * 128 + m * 16; cs[ai][m] = *(const f32x4*)((const float*)(ws + WS_ROPEC) + (size_t)row * 16 + 4 * fq); sn[ai][m] = *(const f32x4*)((const float*)(ws + WS_ROPES) + (size_t)row * 16 + 4 * fq); }
            EPI_LOOP_AM { const int row = row0 + ai * 128 + m * 16; const int b = row >> 13, s = row & 8191; const float su_ = SU[row] * sw;
                const f32x4 x1 = i2f(acc[ai][0][m][0], su_), x2 = i2f(acc[ai][0][m][1], su_);
                const u32x2 p1 = pack4(x1 * cs[ai][m] - x2 * sn[ai][m]), p2 = pack4(x2 * cs[ai][m] + x1 * sn[ai][m]);
#pragma unroll
                for (int h = 0; h < 8; ++h) { bf16_t* kp = (bf16_t*)(ws + WS_K) + (((size_t)(b * 8 + h) * 128 + (s >> 6)) * 12 + 8 + (fq >> 1)) * 512 + (s & 63) * 8 + 4 * (fq & 1); EPI_ST(u32x2, kp, p1); EPI_ST(u32x2, kp + 1024, p2); } }
        }
    }
};
struct EpiF18 {
    static constexpr bool PERM = true, MIDK = false, I8 = true;
    unsigned char* __restrict__ ws;
    __device__ __forceinline__ void operator()(AccRefI acc, const UnitPN& u, int wr, int wc, int fr, int fq) const {
        const int b = u.pn >> 5, tt = u.pn & 31;
        const float* SU = (const float*)(ws + WS_SU); bf16_t* YT2 = (bf16_t*)(ws + WS_YT2);
        const float sw = __uint_as_float(((const unsigned*)(ws + WS_CTL))[CW_WMAX + 1]) * (1.0f / 127.0f);
#pragma unroll
        for (int bj = 0; bj < 2; ++bj) {
            float sc[8];
#pragma unroll
            for (int i = 0; i < 8; ++i) sc[i] = SU[(size_t)b * 8192 + (2 * tt + bj) + 64 * (wc * 32 + 8 * fq + i)] * sw;
            EPI_LOOP_AM { const int r = u.pm * 256 + ai * 128 + wr * 64 + m * 16 + fr; const int ri = r >> 9, gc = r & 511; const int sa = 2 * tt + bj, sb = wc * 32 + 8 * fq;
                const i32x4 a0 = acc[ai][bj][m][0], a1 = acc[ai][bj][m][1];
                const f32x4 v0 = {(float)a0[0] * sc[0], (float)a0[1] * sc[1], (float)a0[2] * sc[2], (float)a0[3] * sc[3]};
                const f32x4 v1 = {(float)a1[0] * sc[4], (float)a1[1] * sc[5], (float)a1[2] * sc[6], (float)a1[3] * sc[7]};
                EPI_ST(u32x4, YT2 + ((((size_t)b * 512 + gc) * 64 + sa) * 2 + ri) * 128 + sb, pack8(v0, v1)); }
        }
    }
};
struct EpiUp8 {
    static constexpr bool PERM = true, MIDK = false, I8 = true;
    unsigned char* __restrict__ ws;
    __device__ __forceinline__ void operator()(AccRefI acc, const MoeUnit& u, int wr, int wc, int fr, int fq) const {
        bf16_t* HID = (bf16_t*)(ws + WS_Q); const u32x2* list = (const u32x2*)(ws + WS_LIST);
        const float sw = __uint_as_float(((const unsigned*)(ws + WS_CTL))[CW_WMAX + 2 + u.e]) * (1.0f / 127.0f);
        float sr[2][4];
        EPI_LOOP_AM { const int li = u.row0 + ai * 128 + wr * 64 + m * 16 + fr; sr[ai][m] = __uint_as_float(list[(size_t)u.e * 65536 + (li < u.cnt ? li : 0)].y) * sw; }
        EPI_LOOP_AM { const int lr = ai * 128 + wr * 64 + m * 16 + fr; const int hh = u.pn * 128 + wc * 32 + 8 * fq;
            u32x2 w[2];
#pragma unroll
            for (int bj = 0; bj < 2; ++bj) { const f32x4 g = i2f(acc[ai][bj][m][0], sr[ai][m]), uu = i2f(acc[ai][bj][m][1], sr[ai][m]); f32x4 o;
#pragma unroll
                for (int j = 0; j < 4; ++j) o[j] = g[j] * sigmoidf_(g[j]) * uu[j];
                w[bj] = pack4(o); }
            EPI_ST(u32x4, HID + (size_t)(u.orow + lr) * 256 + hh, ((u32x4){w[0].x, w[0].y, w[1].x, w[1].y})); }
    }
};

namespace att {
constexpr int NW = 8, KVBLK = 64, NT = SEQ / KVBLK, UROWS = 512;
constexpr int KSLOT = 12288, VSLOT = 8192, NSK = 3, NSV = 4;
constexpr int L_K = 0, L_V = NSK * KSLOT, L_WS = L_V + NSV * VSLOT, L_Q = L_WS + NW * 64 * 4, L_OST = L_Q, BYTES = L_Q + NW * 6144;
#define SBAR() __builtin_amdgcn_sched_barrier(0)
typedef short v4i16_t __attribute__((ext_vector_type(4)));
__device__ __forceinline__ int crow(int r, int hi) { return (r & 3) + 8 * (r >> 2) + 4 * hi; }
__device__ __forceinline__ s16x4 vtr(const LAS unsigned char* p) { return __builtin_bit_cast(s16x4, __builtin_amdgcn_ds_read_tr16_b64_v4i16((LAS v4i16_t*)p)); }
#define MF(a, b, c) __builtin_amdgcn_mfma_f32_32x32x16_bf16(a, b, c, 0, 0, 0)

__device__ __forceinline__ void attn_unit(const bf16_t* __restrict__ Qb, const bf16_t* __restrict__ Kt, const bf16_t* __restrict__ Vt, bf16_t* __restrict__ Ob, LAS unsigned char* lds) {
    const int tid = threadIdx.x, lane = tid & 63, r32 = lane & 31, hi = lane >> 5; const int wid = __builtin_amdgcn_readfirstlane(tid >> 6);
    const bool late = false;
    LAS float* wsf = (LAS float*)(lds + L_WS) + wid * 64;
    const unsigned voff = (unsigned)lane * 16u; const unsigned ldsbase = (unsigned)(uintptr_t)lds;
    const char* kbA = (const char*)Kt + wid * 1024; const char* kbB = (const char*)Kt + (8 + (wid & 3)) * 1024; const char* vbs = (const char*)Vt + wid * 1024;
    const int kdA = L_K + wid * 1024, kdB = L_K + (8 + (wid & 3)) * 1024, vd = L_V + wid * 1024;
#define GLDS(base, ldsoff) do { unsigned keep_; asm volatile("s_mov_b32 %0, m0\n\ts_mov_b32 m0, %3\n\ts_nop 0\n\tglobal_load_lds_dwordx4 %1, %2\n\ts_mov_b32 m0, %0" \
        : "=&s"(keep_) : "v"(voff), "s"(base), "s"((unsigned)(ldsbase + (ldsoff))) : "memory"); } while (0)
#define DMA_K(t, s) do { const int t_ = (t) < NT ? (t) : NT - 1; GLDS(kbA + (size_t)t_ * 12288, kdA + (s) * KSLOT); GLDS(kbB + (size_t)t_ * 12288, kdB + (s) * KSLOT); } while (0)
#define DMA_V(t, s) do { const int t_ = (t) < NT ? (t) : NT - 1; GLDS(vbs + (size_t)t_ * 8192, vd + (s) * VSLOT); } while (0)
#define WAIT_BAR(N) do { asm volatile("s_waitcnt vmcnt(" #N ") lgkmcnt(0)" ::: "memory"); __builtin_amdgcn_s_barrier(); asm volatile("" ::: "memory"); } while (0)
    const LAS unsigned char* kp0 = lds + L_K + hi * 1024 + r32 * 16;
    const LAS unsigned char* vp0 = lds + L_V + ((lane >> 4) & 1) * 32 + (lane & 3) * 8 + (4 * hi + ((lane & 15) >> 2)) * 64;
    DMA_K(0, 0); DMA_V(0, 0); DMA_K(1, 1); DMA_V(1, 1);
    bf16x8 qa[6];
    const LAS unsigned char* qbp = lds + L_Q + wid * 6144 + hi * 512 + r32 * 16;
    { const bf16_t* Qw = Qb + (size_t)(wid * 64 + r32) * QC + hi * 8;
#pragma unroll
      for (int d0 = 0; d0 < 6; ++d0) { qa[d0] = *reinterpret_cast<const bf16x8*>(Qw + d0 * 16); const bf16x8 qv = *reinterpret_cast<const bf16x8*>(Qw + (size_t)32 * QC + d0 * 16);
          *(LAS bf16x8*)(lds + L_Q + wid * 6144 + hi * 512 + r32 * 16 + d0 * 1024) = qv; } }
    bf16x8 qb0, qb1, qb2, qb3, qb4, qb5;
    { const bf16_t* Qw = Qb + (size_t)(wid * 64 + 32 + r32) * QC + hi * 8; qb0 = *reinterpret_cast<const bf16x8*>(Qw); qb1 = *reinterpret_cast<const bf16x8*>(Qw + 16); qb2 = *reinterpret_cast<const bf16x8*>(Qw + 32); qb3 = *reinterpret_cast<const bf16x8*>(Qw + 48); qb4 = *reinterpret_cast<const bf16x8*>(Qw + 64); qb5 = *reinterpret_cast<const bf16x8*>(Qw + 80); }
    f32x16 oA0 = f32x16{}, oA1 = f32x16{}, oB0 = f32x16{}, oB1 = f32x16{};
    u32x4 pA0, pA1, pA2, pA3, pB0, pB1, pB2, pB3;
    float lA = 0.f, lB = 0.f;
    WAIT_BAR(0);
#define PKW(P, B) cvt_pk_bf16(P[B], P[B + 1])
#define PAF(w) __builtin_bit_cast(bf16x8, w)
#define EX4(X, B) do { X[B] = __builtin_amdgcn_exp2f(X[B]); X[B + 1] = __builtin_amdgcn_exp2f(X[B + 1]); X[B + 2] = __builtin_amdgcn_exp2f(X[B + 2]); X[B + 3] = __builtin_amdgcn_exp2f(X[B + 3]); } while (0)
#define EX16(X) do { EX4(X, 0); EX4(X, 4); EX4(X, 8); EX4(X, 12); } while (0)
#define SUM16(L, X) do { L += ((X[0] + X[1]) + (X[2] + X[3])) + ((X[4] + X[5]) + (X[6] + X[7])) + ((X[8] + X[9]) + (X[10] + X[11])) + ((X[12] + X[13]) + (X[14] + X[15])); } while (0)
#define PACK(W0, W1, X) do { W0 = (u32x4){PKW(X, 0), PKW(X, 2), PKW(X, 4), PKW(X, 6)}; W1 = (u32x4){PKW(X, 8), PKW(X, 10), PKW(X, 12), PKW(X, 14)}; } while (0)
#define KRD(d0) do { ka##d0 = *(const LAS bf16x8*)(kpn + (d0) * 2048); kb##d0 = *(const LAS bf16x8*)(kpn + (d0) * 2048 + 512); } while (0)
#define VRD(i) do { l##i = vtr(vp_ + (((i) >> 2) * 4096 + ((i) & 3) * 1024)); h##i = vtr(vp_ + (((i) >> 2) * 4096 + ((i) & 3) * 1024 + 512)); } while (0)
#define VFR(i) ((bf16x8){l##i[0], l##i[1], l##i[2], l##i[3], h##i[0], h##i[1], h##i[2], h##i[3]})
#define PV(vsl) do { const LAS unsigned char* vp_ = vp0 + (vsl) * VSLOT; s16x4 l0, h0, l1, h1, l2, h2, l3, h3, l4, h4, l5, h5, l6, h6, l7, h7; \
    VRD(0); VRD(4); VRD(1); __builtin_amdgcn_s_setprio(1); SBAR(); \
    oA0 = MF(PAF(pA0), VFR(0), oA0); oB0 = MF(PAF(pB0), VFR(0), oB0); VRD(5); SBAR(); \
    oA1 = MF(PAF(pA0), VFR(4), oA1); oB1 = MF(PAF(pB0), VFR(4), oB1); VRD(2); SBAR(); \
    oA0 = MF(PAF(pA1), VFR(1), oA0); oB0 = MF(PAF(pB1), VFR(1), oB0); VRD(6); SBAR(); \
    oA1 = MF(PAF(pA1), VFR(5), oA1); oB1 = MF(PAF(pB1), VFR(5), oB1); VRD(3); SBAR(); \
    oA0 = MF(PAF(pA2), VFR(2), oA0); oB0 = MF(PAF(pB2), VFR(2), oB0); VRD(7); SBAR(); \
    oA1 = MF(PAF(pA2), VFR(6), oA1); oB1 = MF(PAF(pB2), VFR(6), oB1); SBAR(); \
    oA0 = MF(PAF(pA3), VFR(3), oA0); oB0 = MF(PAF(pB3), VFR(3), oB0); SBAR(); \
    oA1 = MF(PAF(pA3), VFR(7), oA1); oB1 = MF(PAF(pB3), VFR(7), oB1); __builtin_amdgcn_s_setprio(0); SBAR(); } while (0)
#define STEP(t, ks, vs, HASP) do { \
    if (late && (HASP)) { PV(((vs) + 3) & 3); } \
    { const LAS unsigned char* kpn = kp0 + (ks) * KSLOT; bf16x8 ka0, kb0, ka1, kb1, ka2, kb2, ka3, kb3, ka4, kb4, ka5, kb5; \
      f32x16 sA0, sA1, sB0, sB1; const f32x16 z16 = f32x16{}; \
      KRD(0); KRD(1); __builtin_amdgcn_s_setprio(1); SBAR(); \
      sA0 = MF(ka0, qa[0], z16); sB0 = MF(ka0, qb0, z16); sA1 = MF(kb0, qa[0], z16); sB1 = MF(kb0, qb0, z16); KRD(2); SBAR(); \
      sA0 = MF(ka1, qa[1], sA0); sB0 = MF(ka1, qb1, sB0); sA1 = MF(kb1, qa[1], sA1); sB1 = MF(kb1, qb1, sB1); KRD(3); SBAR(); \
      sA0 = MF(ka2, qa[2], sA0); sB0 = MF(ka2, qb2, sB0); sA1 = MF(kb2, qa[2], sA1); sB1 = MF(kb2, qb2, sB1); KRD(4); SBAR(); \
      sA0 = MF(ka3, qa[3], sA0); sB0 = MF(ka3, qb3, sB0); sA1 = MF(kb3, qa[3], sA1); sB1 = MF(kb3, qb3, sB1); KRD(5); SBAR(); \
      sA0 = MF(ka4, qa[4], sA0); sB0 = MF(ka4, qb4, sB0); sA1 = MF(kb4, qa[4], sA1); sB1 = MF(kb4, qb4, sB1); SBAR(); \
      sA0 = MF(ka5, qa[5], sA0); sB0 = MF(ka5, qb5, sB0); sA1 = MF(kb5, qa[5], sA1); sB1 = MF(kb5, qb5, sB1); __builtin_amdgcn_s_setprio(0); SBAR(); \
      EX16(sA0); SUM16(lA, sA0); PACK(pA0, pA1, sA0); SBAR(); \
      EX16(sA1); SUM16(lA, sA1); PACK(pA2, pA3, sA1); SBAR(); \
      EX16(sB0); SUM16(lB, sB0); PACK(pB0, pB1, sB0); SBAR(); \
      EX16(sB1); SUM16(lB, sB1); PACK(pB2, pB3, sB1); SBAR(); } \
    if (!late) { PV(vs); } \
    DMA_V((t) + 2, ((vs) + 2) & 3); DMA_K((t) + 2, ((ks) == 0 ? 2 : (ks) - 1)); \
    WAIT_BAR(3); } while (0)
    int ks = 0, vs = 0;
#pragma unroll 1
    for (int t = 0; t < NT; ++t) {
        STEP(t, ks, vs, (t > 0));
        ks = (ks == 2) ? 0 : ks + 1; vs = (vs + 1) & 3;
    }
    if (late) { PV(3); }
    LAS bf16_t* stg = (LAS bf16_t*)(lds + L_OST) + wid * 2048;
#define OUT_BLOCK(O0, O1, L, blk) do { float l_ = (L); { auto rr = __builtin_amdgcn_permlane32_swap(__float_as_uint(l_), __float_as_uint(l_), false, false); l_ = __uint_as_float(rr[0]) + __uint_as_float(rr[1]); } \
    if (hi == 0) wsf[r32] = l_; \
    asm volatile("s_waitcnt lgkmcnt(0)" ::: "memory"); \
    _Pragma("unroll") for (int r = 0; r < 16; ++r) { const int orow = crow(r, hi); const float rl = __builtin_amdgcn_rcpf(wsf[orow]); \
        stg[orow * 64 + r32] = (bf16_t)(cvt_pk_bf16(O0[r] * rl, 0.f) & 0xffffu); stg[orow * 64 + 32 + r32] = (bf16_t)(cvt_pk_bf16(O1[r] * rl, 0.f) & 0xffffu); } \
    asm volatile("s_waitcnt lgkmcnt(0)" ::: "memory"); \
    { bf16_t* Ow = Ob + (size_t)(wid * 64 + (blk) * 32) * 512; \
      _Pragma("unroll") for (int i = 0; i < 4; ++i) { const int row = i * 8 + (lane >> 3), ch = lane & 7; const u32x4 v = *(const LAS u32x4*)(stg + row * 64 + ch * 8); *(u32x4*)(Ow + (size_t)row * 512 + ch * 8) = v; } } \
    asm volatile("s_waitcnt lgkmcnt(0)" ::: "memory"); } while (0)
    OUT_BLOCK(oA0, oA1, lA, 0);
    OUT_BLOCK(oB0, oB1, lB, 1);
    WAIT_BAR(0);
#undef GLDS
#undef DMA_K
#undef DMA_V
#undef WAIT_BAR
#undef PKW
#undef PAF
#undef EX16
#undef EX4
#undef SUM16
#undef PACK
#undef KRD
#undef VRD
#undef VFR
#undef PV
#undef STEP
#undef OUT_BLOCK
}
#undef SBAR
#undef MF
}

struct Args { const float* in[27]; float* out; unsigned char* ws; int ph_lo, ph_hi, li, pad; };
struct Frame {
    LAS unsigned char* lds; int tid, lane, wave, vcu, G;
};
__device__ __forceinline__ unsigned f2bf(float f) { unsigned u = __builtin_bit_cast(unsigned, f); return (u + 0x7fffu + ((u >> 16) & 1u)) >> 16; }
__device__ __forceinline__ unsigned pk2(float lo, float hi) { return f2bf(lo) | (f2bf(hi) << 16); }

__device__ __forceinline__ float wave_max(float v) {
#pragma unroll
    for (int o = 1; o < 64; o <<= 1) v = fmaxf(v, __shfl_xor(v, o));
    return v;
}
template <class RM>
__device__ __forceinline__ void tr_item(const float* __restrict__ W, int ldw, int k0, int n0, const float* __restrict__ kscale, bf16_t* WT, int Kdst, const RM& rm, LAS float* scr, int lane, unsigned* wmaxp = nullptr) {
    float amax = 0.f;
    float v[32];
    { const float* wp = W + (size_t)(k0 + (lane >> 5)) * ldw + n0 + (lane & 31);
#pragma unroll
      for (int i = 0; i < 32; ++i) v[i] = wp[(size_t)(2 * i) * ldw]; }
    if (kscale) {
#pragma unroll
        for (int i = 0; i < 32; ++i) v[i] *= kscale[k0 + 2 * i + (lane >> 5)]; }
    asm volatile("" ::: "memory");
#pragma unroll
    for (int i = 0; i < 32; ++i) { const int kk = 2 * i + (lane >> 5); scr[kk * 33 + (lane & 31)] = v[i]; amax = fmaxf(amax, fabsf(v[i])); }
    if (wmaxp) { amax = wave_max(amax); if (lane == 0) atomicMax(wmaxp, __float_as_uint(amax)); }
    LDS_WAIT(); asm volatile("" ::: "memory");
    const int c = lane & 7;
#pragma unroll
    for (int j = 0; j < 4; ++j) { const int n = (lane >> 3) + 8 * j; const LAS float* s = scr + (8 * c) * 33 + n;
        u32x4 o; o.x = pk2(s[0 * 33], s[1 * 33]); o.y = pk2(s[2 * 33], s[3 * 33]); o.z = pk2(s[4 * 33], s[5 * 33]); o.w = pk2(s[6 * 33], s[7 * 33]);
        *(u32x4*)(WT + (size_t)rm(n0 + n) * Kdst + k0 + 8 * c) = o; }
    LDS_WAIT(); asm volatile("" ::: "memory");
}
__device__ __forceinline__ int rope_pos(int i) { return 8 * ((i & 15) >> 2) + 4 * (i >> 4) + (i & 3); }
struct RmIdent { int off; __device__ __forceinline__ int operator()(int n) const { return n + off; } };
struct RmWin { __device__ __forceinline__ int operator()(int n) const { return n < 512 ? n : (n < 544 ? 2560 + rope_pos(n - 512) : 512 + (n - 1056)); } };
struct RmUq { __device__ __forceinline__ int operator()(int n) const { const int h = n / 96, d = n - 96 * h; return d < 64 ? n : 96 * h + 64 + rope_pos(d - 64); } };
struct RmGu { int up; __device__ __forceinline__ int operator()(int hh) const { return 256 * (hh >> 7) + 128 * ((hh >> 2) & 1) + 32 * ((hh >> 5) & 3) + 8 * ((hh >> 3) & 3) + (hh & 3) + 4 * up; } };

__device__ const double INVF[16] = {1.0, 0.5623413251903491, 0.31622776601683794, 0.1778279410038923, 0.1, 0.05623413251903491, 0.03162277660168379, 0.01778279410038923,
    0.01, 0.005623413251903491, 0.0031622776601683794, 0.0017782794100389228, 0.001, 0.0005623413251903491, 0.00031622776601683794, 0.00017782794100389227};

__device__ __forceinline__ void p0_prologue(const Frame& F, const Args& a) {
    unsigned char* ws = a.ws; unsigned* WMAX = (unsigned*)((gu32*)(ws + WS_CTL) + CW_WMAX);
    {
        LAS float* cact = (LAS float*)(F.lds);
        LAS float* red = (LAS float*)(F.lds + 32768);
        float* MODF = (float*)(ws + WS_MODF);
        const float* c = a.in[1];
        for (int i = F.tid; i < 8192; i += 512) { const int b = i >> 10, k = i & 1023; const float v = c[i]; cact[k * 8 + b] = v * sigmoidf_(v); }
        __syncthreads();
        for (int it = blockIdx.x; it < 128; it += F.G) {
            const int n = it * 64 + F.lane, kg = F.wave;
            const float* W = (n < 6144) ? (a.in[3] + n) : (a.in[24] + (n - 6144)); const int ldw = (n < 6144) ? 6144 : 2048;
            float acc[8];
#pragma unroll
            for (int b = 0; b < 8; ++b) acc[b] = 0.f;
#pragma unroll 8
            for (int k = kg * 128; k < kg * 128 + 128; ++k) { const float w = W[(size_t)k * ldw]; const f32x4 c0 = *(const LAS f32x4*)(cact + k * 8), c1 = *(const LAS f32x4*)(cact + k * 8 + 4);
                acc[0] += c0[0] * w; acc[1] += c0[1] * w; acc[2] += c0[2] * w; acc[3] += c0[3] * w; acc[4] += c1[0] * w; acc[5] += c1[1] * w; acc[6] += c1[2] * w; acc[7] += c1[3] * w; }
#pragma unroll
            for (int b = 0; b < 8; ++b) red[(kg * 8 + b) * 64 + F.lane] = acc[b];
            __syncthreads();
            { const int b = F.tid >> 6, cl = F.tid & 63, nn = it * 64 + cl; float s = 0.f;
#pragma unroll
              for (int q = 0; q < 8; ++q) s += red[(q * 8 + b) * 64 + cl];
              MODF[b * 8192 + nn] = s + (nn < 6144 ? a.in[4][nn] : a.in[25][nn - 6144]); }
            __syncthreads();
        }
        __syncthreads();
    }
    LAS float* scr = (LAS float*)(F.lds + F.wave * 16384);
    const int gw = F.vcu * NWAVES + F.wave, NGW = F.G * NWAVES;
    bf16_t* WIN = (bf16_t*)(ws + WS_WIN); bf16_t* WFY = (bf16_t*)(ws + WS_WFY); bf16_t* WUQ = (bf16_t*)(ws + WS_WUQ); bf16_t* WUKV = (bf16_t*)(ws + WS_WUKV);
    bf16_t* WBA = (bf16_t*)(ws + WS_WBA); bf16_t* WBF = (bf16_t*)(ws + WS_WBF); bf16_t* WOUT = (bf16_t*)(ws + WS_WOUT);
    bf16_t* WGU = (bf16_t*)(ws + WS_WGU); bf16_t* WDN = (bf16_t*)(ws + WS_WDN);
    constexpr int I_WIN = 81 * 16, I_UQ = 24 * 4, I_UK = 16 * 4, I_UV = 16 * 4, I_BA = 32 * 8, I_BF = 32 * 8, I_OUT = 32 * 16, I_G = 32 * 8 * 16, I_U = I_G, I_D = 32 * 32 * 4;
    constexpr int I_FY = 16 * 8 * 4;
    constexpr int NITEMS = I_WIN + I_UQ + I_UK + I_UV + I_BA + I_BF + I_OUT + I_G + I_U + I_D + I_FY;
    for (int it = gw; it < NITEMS; it += NGW) {
        int r = it;
        if (r < I_WIN) { const int kb = r / 81, nbi = r % 81; const int n0 = nbi < 17 ? nbi * 32 : 1056 + (nbi - 17) * 32;
            tr_item(a.in[6], 3104, kb * 64, n0, nullptr, WIN, 1024, RmWin{}, scr, F.lane, WMAX + 0); continue; } r -= I_WIN;
        if (r < I_UQ) { tr_item(a.in[9], 768, (r / 24) * 64, (r % 24) * 32, a.in[7], WUQ, 256, RmUq{}, scr, F.lane); continue; } r -= I_UQ;
        if (r < I_UK) { tr_item(a.in[10], 512, (r / 16) * 64, (r % 16) * 32, a.in[8], WUKV, 256, RmIdent{0}, scr, F.lane); continue; } r -= I_UK;
        if (r < I_UV) { tr_item(a.in[11], 512, (r / 16) * 64, (r % 16) * 32, a.in[8], WUKV, 256, RmIdent{512}, scr, F.lane); continue; } r -= I_UV;
        if (r < I_BA) { tr_item(a.in[12], 1024, (r / 32) * 64, (r % 32) * 32, nullptr, WBA, 1024, RmIdent{0}, scr, F.lane); continue; } r -= I_BA;
        if (r < I_BF) { tr_item(a.in[13], 1024, (r / 32) * 64, (r % 32) * 32, nullptr, WBA + 512, 1024, RmIdent{0}, scr, F.lane); continue; } r -= I_BF;
        if (r < I_OUT) { tr_item(a.in[15], 1024, (r / 32) * 64, (r % 32) * 32, nullptr, WOUT, 1024, RmIdent{0}, scr, F.lane); continue; } r -= I_OUT;
        if (r < I_G) { const int e = r / 128, q = r % 128; tr_item(a.in[21] + (size_t)e * 1024 * 256, 256, (q / 8) * 64, (q % 8) * 32, nullptr, WGU + (size_t)e * 512 * 1024, 1024, RmGu{0}, scr, F.lane, WMAX + 2 + e); continue; } r -= I_G;
        if (r < I_U) { const int e = r / 128, q = r % 128; tr_item(a.in[22] + (size_t)e * 1024 * 256, 256, (q / 8) * 64, (q % 8) * 32, nullptr, WGU + (size_t)e * 512 * 1024, 1024, RmGu{1}, scr, F.lane, WMAX + 2 + e); continue; } r -= I_U;
        if (r < I_D) { const int e = r / 128, q = r % 128; tr_item(a.in[23] + (size_t)e * 256 * 1024, 1024, (q / 32) * 64, (q % 32) * 32, nullptr, WDN + (size_t)e * 1024 * 256, 256, RmIdent{0}, scr, F.lane); continue; } r -= I_D;
        {
            const int kb = r >> 5, g = (r >> 2) & 7, jq = r & 3;
            const float* W = a.in[6] + (size_t)(kb * 64) * 3104 + 544 + 64 * g;
#pragma unroll 8
            for (int kk = 0; kk < 64; ++kk) scr[F.lane * 64 + kk] = W[(size_t)kk * 3104 + F.lane];
            LDS_WAIT(); asm volatile("" ::: "memory");
            float ar[16], ai_[16];
#pragma unroll
            for (int j = 0; j < 16; ++j) { ar[j] = 0.f; ai_[j] = 0.f; }
#pragma unroll 2
            for (int cI = 0; cI < 64; ++cI) { const float xv = scr[cI * 64 + F.lane];
#pragma unroll
                for (int j = 0; j < 16; ++j) { const float ph = (float)((cI * (jq * 16 + j)) & 63) * (1.0f / 64.0f);
                    ar[j] += xv * __builtin_amdgcn_cosf(ph); ai_[j] -= xv * __builtin_amdgcn_sinf(ph); } }
            float amax = 0.f;
#pragma unroll
            for (int j = 0; j < 16; ++j) { const int jj = jq * 16 + j; amax = fmaxf(amax, fmaxf(fabsf(ar[j]), fabsf(ai_[j])) * FNORM);
                WFY[(size_t)(g * 64 + jj) * 1024 + kb * 64 + F.lane] = (bf16_t)f2bf(ar[j] * FNORM);
                WFY[(size_t)(512 + g * 64 + jj) * 1024 + kb * 64 + F.lane] = (bf16_t)f2bf(ai_[j] * FNORM); }
            amax = wave_max(amax); if (F.lane == 0) atomicMax(WMAX + 1, __float_as_uint(amax));
            LDS_WAIT(); asm volatile("" ::: "memory");
        }
    }
    const int gt = F.vcu * 512 + F.tid, NGT = F.G * 512;
    { float* RC = (float*)(ws + WS_ROPEC); float* RS = (float*)(ws + WS_ROPES); const int* pos = (const int*)a.in[2];
        for (int i = gt; i < T * 16; i += NGT) { const int t = i >> 4, f = i & 15; const double rev = (double)pos[t] * INVF[f] * 0.15915494309189535; const float fr = (float)(rev - __builtin_floor(rev));
            RC[i] = __builtin_amdgcn_cosf(fr); RS[i] = __builtin_amdgcn_sinf(fr); } }
    { bf16_t* DFTA = (bf16_t*)(ws + WS_DFTA);
        for (int i = gt; i < 256 * 256; i += NGT) { const int r = i >> 8, cI = i & 255; const int rip = r >> 7, kb = r & 127, ri = cI >> 7, sb = cI & 127;
            const float ph = (float)((sb * kb) & 127) * (1.0f / 128.0f); const float cs = __builtin_amdgcn_cosf(ph), sn = __builtin_amdgcn_sinf(ph);
            const float v = (rip == ri) ? cs : (rip == 0 ? sn : -sn); DFTA[i] = (bf16_t)f2bf(v); } }
    { bf16_t* TB2 = (bf16_t*)(ws + WS_TB2);
        for (int i = gt; i < 64 * 128 * 256; i += NGT) { const int pair = i >> 15, r = (i >> 8) & 127, cI = i & 255; const int kbp = r >> 6, ka = r & 63, kbpp = cI >> 7, ri = (cI >> 6) & 1, sa = cI & 63;
            const int kbb = 2 * pair + kbp; const float ph = (float)((sa * (kbb + 128 * ka)) & 8191) * (1.0f / 8192.0f);
            const float v = (kbp == kbpp) ? (ri ? __builtin_amdgcn_sinf(ph) : __builtin_amdgcn_cosf(ph)) : 0.f; TB2[i] = (bf16_t)f2bf(v); } }
}

__device__ __forceinline__ unsigned q8s(float v) { return (unsigned)(int)fminf(fmaxf(__builtin_rintf(v), -127.f), 127.f) & 0xffu; }
__device__ __forceinline__ void p1_norm(const Frame& F, const Args& a) {
    unsigned char* ws = a.ws; const float* MODF = (const float*)(ws + WS_MODF);
    const unsigned* WMAX = (const unsigned*)((gu32*)(ws + WS_CTL) + CW_WMAX);
    {
        const bf16_t* WIN = (const bf16_t*)(ws + WS_WIN); const bf16_t* WFY = (const bf16_t*)(ws + WS_WFY); const bf16_t* WGU = (const bf16_t*)(ws + WS_WGU);
        u32x2* W8IN = (u32x2*)(ws + WS_W8IN); u32x2* W8FY = (u32x2*)(ws + WS_W8FY); u32x2* W8GU = (u32x2*)(ws + WS_W8GU);
        constexpr int C_IN = NWIN * 1024 / 8, C_FY = 1024 * 1024 / 8, C_GU = 32 * 512 * 1024 / 8;
        const int gt = F.vcu * 512 + F.tid, NGT = F.G * 512;
        for (int i = gt; i < C_IN + C_FY + C_GU; i += NGT) {
            const bf16_t* src; u32x2* dst; float wm;
            if (i < C_IN) { src = WIN + (size_t)i * 8; dst = W8IN + i; wm = __uint_as_float(WMAX[0]); }
            else if (i < C_IN + C_FY) { const int j = i - C_IN; src = WFY + (size_t)j * 8; dst = W8FY + j; wm = __uint_as_float(WMAX[1]); }
            else { const int j = i - C_IN - C_FY; src = WGU + (size_t)j * 8; dst = W8GU + j; wm = __uint_as_float(WMAX[2 + (j >> 16)]); }
            const float inv = wm > 0.f ? 127.0f / wm : 0.f;
            const u32x4 w = *(const u32x4*)src;
            u32x2 o;
            o.x = q8s(bf_lo(w.x) * inv) | (q8s(bf_hi(w.x) * inv) << 8) | (q8s(bf_lo(w.y) * inv) << 16) | (q8s(bf_hi(w.y) * inv) << 24);
            o.y = q8s(bf_lo(w.z) * inv) | (q8s(bf_hi(w.z) * inv) << 8) | (q8s(bf_lo(w.w) * inv) << 16) | (q8s(bf_hi(w.w) * inv) << 24);
            *dst = o; }
    }
    const float* x = a.in[0]; const float* g = a.in[5]; unsigned char* U8 = (unsigned char*)(ws + WS_R1); float* SU = (float*)(ws + WS_SU);
    const int gw = F.vcu * NWAVES + F.wave, NGW = F.G * NWAVES;
    for (int ch = gw; ch < T / 32; ch += NGW) {
        const int b = (ch * 32) >> 13;
        f32x4 Gv[4], Sv[4];
#pragma unroll
        for (int j = 0; j < 4; ++j) { const int k = 4 * F.lane + 256 * j; Gv[j] = *(const f32x4*)(g + k) * (*(const f32x4*)(MODF + b * 8192 + 1024 + k) + 1.0f); Sv[j] = *(const f32x4*)(MODF + b * 8192 + k); }
#pragma unroll 2
        for (int rr = 0; rr < 32; ++rr) { const size_t row = (size_t)ch * 32 + rr; const f32x4* xr = (const f32x4*)(x + row * 1024) + F.lane;
            f32x4 v[4]; float s = 0.f;
#pragma unroll
            for (int j = 0; j < 4; ++j) { v[j] = xr[64 * j]; s += (v[j][0] * v[j][0] + v[j][1] * v[j][1]) + (v[j][2] * v[j][2] + v[j][3] * v[j][3]); }
            const float rs = __builtin_amdgcn_rsqf(wave_sum(s) * (1.0f / 1024.0f) + EPS);
            float am = 0.f;
#pragma unroll
            for (int j = 0; j < 4; ++j) { v[j] = v[j] * rs * Gv[j] + Sv[j]; am = fmaxf(am, fmaxf(fmaxf(fabsf(v[j][0]), fabsf(v[j][1])), fmaxf(fabsf(v[j][2]), fabsf(v[j][3])))); }
            am = wave_max(am); const float inv = am > 0.f ? 127.0f / am : 0.f;
            unsigned* o4 = (unsigned*)(U8 + row * 1024) + F.lane;
#pragma unroll
            for (int j = 0; j < 4; ++j) o4[64 * j] = q8s(v[j][0] * inv) | (q8s(v[j][1] * inv) << 8) | (q8s(v[j][2] * inv) << 16) | (q8s(v[j][3] * inv) << 24);
            if (F.lane == 0) SU[row] = am * (1.0f / 127.0f); }
    }
}

__device__ __forceinline__ float wave_sum_dpp(float v) {
    int x = __float_as_int(v);
    x = __float_as_int(__int_as_float(x) + __int_as_float(__builtin_amdgcn_update_dpp(0, x, 0xB1, 0xF, 0xF, true)));
    x = __float_as_int(__int_as_float(x) + __int_as_float(__builtin_amdgcn_update_dpp(0, x, 0x4E, 0xF, 0xF, true)));
    x = __float_as_int(__int_as_float(x) + __int_as_float(__builtin_amdgcn_update_dpp(0, x, 0x141, 0xF, 0xF, true)));
    x = __float_as_int(__int_as_float(x) + __int_as_float(__builtin_amdgcn_update_dpp(0, x, 0x140, 0xF, 0xF, true)));
    x = __float_as_int(__int_as_float(x) + __int_as_float(__builtin_amdgcn_update_dpp(0, x, 0x142, 0xA, 0xF, false)));
    x = __float_as_int(__int_as_float(x) + __int_as_float(__builtin_amdgcn_update_dpp(0, x, 0x143, 0xC, 0xF, false)));
    return __int_as_float(__builtin_amdgcn_readlane(x, 63));
}
constexpr int RT_WPH = 0, RT_WPL = 74304, RT_LCNT = 148608, RT_LBASE = RT_LCNT + 128, RT_INFO = RT_LBASE + 128, RT_CVEC = RT_INFO + 4096, RT_STG = RT_CVEC + 256;
__device__ __forceinline__ int wp_off(int n, int k) { return n * 2064 + k * 2; }
__device__ __forceinline__ void p7_route(const Frame& F, const Args& a) {
    unsigned char* ws = a.ws; gu32* ctl = (gu32*)(ws + WS_CTL);
    const bf16_t* H = (const bf16_t*)(ws + WS_YT2); const float* MODF = (const float*)(ws + WS_MODF); const float* g = a.in[16];
    unsigned char* VM8 = (unsigned char*)(ws + WS_R1); u32x2* LIST = (u32x2*)(ws + WS_LIST); u32x4* TOKINFO = (u32x4*)(ws + WS_ROUTEW);
    LAS int* lcnt = (LAS int*)(F.lds + RT_LCNT); LAS int* lbase = (LAS int*)(F.lds + RT_LBASE); LAS unsigned* info = (LAS unsigned*)(F.lds + RT_INFO); LAS float* winfo = (LAS float*)(F.lds + RT_INFO + 1024); LAS float* sinfo = (LAS float*)(F.lds + RT_INFO + 3072);
    LAS float* cvec = (LAS float*)(F.lds + RT_CVEC); LAS float* stg = (LAS float*)(F.lds + RT_STG + F.wave * 1152);
    const int l16 = F.lane & 15, fq = F.lane >> 4;
    int wb = -1;
    for (int ch = F.vcu; ch < T / 256; ch += F.G) {
        const int b = (ch * 256) >> 13;
        if (b != wb) {
            __syncthreads();
            const float* Gm = MODF + b * 8192 + 4096; const float* Sm = MODF + b * 8192 + 3072;
            float pg = 0.f, pe = 0.f;
            for (int i = F.tid; i < 1024 * 4; i += 512) { const int k = i >> 2, n = i & 3; const float w0 = a.in[17][i]; pg += Sm[k] * w0; const float w = w0 * (g[k] * (Gm[k] + 1.0f)); const unsigned h16 = f2bf(w);
                *(LAS unsigned short*)(F.lds + RT_WPH + wp_off(n, k)) = (unsigned short)h16; *(LAS unsigned short*)(F.lds + RT_WPL + wp_off(n, k)) = (unsigned short)f2bf(w - __uint_as_float(h16 << 16)); }
            for (int i = F.tid; i < 1024 * 32; i += 512) { const int k = i >> 5, n = 4 + (i & 31); const float w0 = a.in[19][i]; pe += Sm[k] * w0; const float w = w0 * (g[k] * (Gm[k] + 1.0f)); const unsigned h16 = f2bf(w);
                *(LAS unsigned short*)(F.lds + RT_WPH + wp_off(n, k)) = (unsigned short)h16; *(LAS unsigned short*)(F.lds + RT_WPL + wp_off(n, k)) = (unsigned short)f2bf(w - __uint_as_float(h16 << 16)); }
            { LAS float* part = (LAS float*)(F.lds + RT_STG);
              part[(F.tid & 3) * 128 + (F.tid >> 2)] = pg; part[512 + (F.tid & 31) * 16 + (F.tid >> 5)] = pe;
              __syncthreads();
              if (F.tid < 36) { float d = 0.f;
                  if (F.tid < 4) { for (int j = 0; j < 128; ++j) d += part[F.tid * 128 + j]; d += a.in[18][F.tid]; }
                  else { for (int j = 0; j < 16; ++j) d += part[512 + (F.tid - 4) * 16 + j]; d += a.in[20][F.tid - 4]; }
                  cvec[F.tid] = d; } }
            wb = b;
        }
        if (F.tid < 32) lcnt[F.tid] = 0;
        __syncthreads();
        f32x4 Gv[4], Sv[4];
#pragma unroll
        for (int j = 0; j < 4; ++j) { const int k = 4 * F.lane + 256 * j; Gv[j] = *(const f32x4*)(g + k) * (*(const f32x4*)(MODF + b * 8192 + 4096 + k) + 1.0f); Sv[j] = *(const f32x4*)(MODF + b * 8192 + 3072 + k); }
#pragma unroll 1
        for (int bi = 0; bi < 2; ++bi) {
            const size_t R0 = (size_t)ch * 256 + F.wave * 32 + bi * 16;
            f32x4 acc0 = f32x4{}, acc1 = f32x4{}, acc2 = f32x4{};
            { const bf16_t* hp = H + (R0 + l16) * 1024 + fq * 8;
              const int n0 = l16, n1 = 16 + l16, n2 = (32 + l16) < 36 ? 32 + l16 : 35;
              bf16x8 av[2][8];
#pragma unroll
              for (int i = 0; i < 8; ++i) av[0][i] = *reinterpret_cast<const bf16x8*>(hp + i * 32);
#pragma unroll
              for (int kb = 0; kb < 4; ++kb) {
                  if (kb < 3) {
#pragma unroll
                      for (int i = 0; i < 8; ++i) av[(kb + 1) & 1][i] = *reinterpret_cast<const bf16x8*>(hp + ((kb + 1) * 8 + i) * 32); }
#pragma unroll
                  for (int i = 0; i < 8; ++i) { const int k = (kb * 8 + i) * 32 + fq * 8; const bf16x8 af = av[kb & 1][i];
                      const bf16x8 h0 = *(const LAS bf16x8*)(F.lds + RT_WPH + wp_off(n0, k)), h1 = *(const LAS bf16x8*)(F.lds + RT_WPH + wp_off(n1, k)), h2 = *(const LAS bf16x8*)(F.lds + RT_WPH + wp_off(n2, k));
                      const bf16x8 e0 = *(const LAS bf16x8*)(F.lds + RT_WPL + wp_off(n0, k)), e1 = *(const LAS bf16x8*)(F.lds + RT_WPL + wp_off(n1, k)), e2 = *(const LAS bf16x8*)(F.lds + RT_WPL + wp_off(n2, k));
                      acc0 = __builtin_amdgcn_mfma_f32_16x16x32_bf16(af, h0, acc0, 0, 0, 0); acc1 = __builtin_amdgcn_mfma_f32_16x16x32_bf16(af, h1, acc1, 0, 0, 0); acc2 = __builtin_amdgcn_mfma_f32_16x16x32_bf16(af, h2, acc2, 0, 0, 0);
                      acc0 = __builtin_amdgcn_mfma_f32_16x16x32_bf16(af, e0, acc0, 0, 0, 0); acc1 = __builtin_amdgcn_mfma_f32_16x16x32_bf16(af, e1, acc1, 0, 0, 0); acc2 = __builtin_amdgcn_mfma_f32_16x16x32_bf16(af, e2, acc2, 0, 0, 0); } }
            }
            u32x2 hn[4];
            { const u32x2* hr = (const u32x2*)(H + R0 * 1024) + F.lane;
#pragma unroll
              for (int j = 0; j < 4; ++j) hn[j] = hr[64 * j]; }
#pragma unroll 1
            for (int half = 0; half < 2; ++half) {
                if ((fq >> 1) == half) {
#pragma unroll
                    for (int r = 0; r < 4; ++r) { const int rl = (fq & 1) * 4 + r; stg[rl * 36 + l16] = acc0[r]; stg[rl * 36 + 16 + l16] = acc1[r]; if (l16 < 4) stg[rl * 36 + 32 + l16] = acc2[r]; } }
                LDS_WAIT(); asm volatile("" ::: "memory");
#pragma unroll 4
                for (int rr = 0; rr < 8; ++rr) { const int lr = F.wave * 32 + bi * 16 + half * 8 + rr; const size_t row = (size_t)ch * 256 + lr;
                    f32x4 v[4]; float s = 0.f;
                    u32x2 hc[4];
#pragma unroll
                    for (int j = 0; j < 4; ++j) hc[j] = hn[j];
                    { const u32x2* hr = (const u32x2*)(H + (row + ((half * 8 + rr) < 15 ? 1 : 0)) * 1024) + F.lane;
#pragma unroll
                      for (int j = 0; j < 4; ++j) hn[j] = hr[64 * j]; }
#pragma unroll
                    for (int j = 0; j < 4; ++j) { const u32x2 hw = hc[j]; v[j] = (f32x4){bf_lo(hw.x), bf_hi(hw.x), bf_lo(hw.y), bf_hi(hw.y)}; s += (v[j][0] * v[j][0] + v[j][1] * v[j][1]) + (v[j][2] * v[j][2] + v[j][3] * v[j][3]); }
                    const float rs = __builtin_amdgcn_rsqf(wave_sum_dpp(s) * (1.0f / 1024.0f) + EPS);
                    float am = 0.f;
#pragma unroll
                    for (int j = 0; j < 4; ++j) { v[j] = v[j] * rs * Gv[j] + Sv[j]; am = fmaxf(am, fmaxf(fmaxf(fabsf(v[j][0]), fabsf(v[j][1])), fmaxf(fabsf(v[j][2]), fabsf(v[j][3])))); }
                    am = wave_max(am); const float inv = am > 0.f ? 127.0f / am : 0.f;
                    { unsigned* o4 = (unsigned*)(VM8 + row * 1024) + F.lane;
#pragma unroll
                      for (int j = 0; j < 4; ++j) o4[64 * j] = q8s(v[j][0] * inv) | (q8s(v[j][1] * inv) << 8) | (q8s(v[j][2] * inv) << 16) | (q8s(v[j][3] * inv) << 24); }
                    const f32x4 graw = *(const LAS f32x4*)(stg + rr * 36), gc = *(const LAS f32x4*)cvec;
                    float gl[4];
#pragma unroll
                    for (int q = 0; q < 4; ++q) gl[q] = graw[q] * rs + gc[q];
                    int gs = 0; float gm = gl[0];
#pragma unroll
                    for (int q = 1; q < 4; ++q) if (gl[q] > gm) { gm = gl[q]; gs = q; }
                    gs = __builtin_amdgcn_readfirstlane(gs);
                    float gden = 0.f;
#pragma unroll
                    for (int q = 0; q < 4; ++q) gden += __expf(gl[q] - gm);
                    const float gp = 1.0f / gden;
                    const f32x4 er0 = *(const LAS f32x4*)(stg + rr * 36 + 4 + gs * 8), er1 = *(const LAS f32x4*)(stg + rr * 36 + 8 + gs * 8), ec0 = *(const LAS f32x4*)(cvec + 4 + gs * 8), ec1 = *(const LAS f32x4*)(cvec + 8 + gs * 8);
                    float b0 = -3.0e38f, b1 = -3.0e38f; int i0 = 0, i1 = 0;
#pragma unroll
                    for (int e = 0; e < 8; ++e) { const float el = (e < 4 ? er0[e & 3] : er1[e & 3]) * rs + (e < 4 ? ec0[e & 3] : ec1[e & 3]);
                        if (el > b0) { b1 = b0; i1 = i0; b0 = el; i0 = e; } else if (el > b1) { b1 = el; i1 = e; } }
                    const float w0 = 1.0f / (1.0f + __expf(b1 - b0)), w1 = 1.0f - w0;
                    if (F.lane == 0) { const int e0 = gs * 8 + i0, e1 = gs * 8 + i1;
                        const int rk0 = __hip_atomic_fetch_add(lcnt + e0, 1, __ATOMIC_RELAXED, __HIP_MEMORY_SCOPE_WORKGROUP);
                        const int rk1 = __hip_atomic_fetch_add(lcnt + e1, 1, __ATOMIC_RELAXED, __HIP_MEMORY_SCOPE_WORKGROUP);
                        info[lr] = (unsigned)e0 | ((unsigned)e1 << 5) | ((unsigned)rk0 << 10) | ((unsigned)rk1 << 20);
                        winfo[2 * lr] = gp * w0; winfo[2 * lr + 1] = gp * w1; sinfo[lr] = am * (1.0f / 127.0f); }
                }
                LDS_WAIT(); asm volatile("" ::: "memory");
            }
        }
        __syncthreads();
        if (F.tid < 32) lbase[F.tid] = (int)__hip_atomic_fetch_add((unsigned*)(ctl + CW_CNT) + F.tid, (unsigned)lcnt[F.tid], __ATOMIC_RELAXED, __HIP_MEMORY_SCOPE_AGENT);
        __syncthreads();
        if (F.tid < 256) { const unsigned w = info[F.tid]; const int e0 = w & 31, e1 = (w >> 5) & 31, rk0 = (w >> 10) & 1023, rk1 = (w >> 20) & 1023; const int t = ch * 256 + F.tid;
            const int p0 = lbase[e0] + rk0, p1 = lbase[e1] + rk1;
            const unsigned sb_ = __float_as_uint(sinfo[F.tid]);
            LIST[(size_t)e0 * 65536 + p0] = (u32x2){(unsigned)t, sb_}; LIST[(size_t)e1 * 65536 + p1] = (u32x2){(unsigned)t, sb_};
            TOKINFO[t] = (u32x4){((unsigned)e0 << 16) | (unsigned)p0, ((unsigned)e1 << 16) | (unsigned)p1, __float_as_uint(winfo[2 * F.tid]), __float_as_uint(winfo[2 * F.tid + 1])}; }
        __syncthreads();
    }
}

__device__ __forceinline__ void p10_final(const Frame& F, const Args& a) {
    unsigned char* ws = a.ws; const float* MODF = (const float*)(ws + WS_MODF); const float* g = a.in[26];
    const bf16_t* Y2 = (const bf16_t*)(ws + WS_GATE); const bf16_t* H = (const bf16_t*)(ws + WS_YT2); float* out = a.out; const u32x4* TOKINFO = (const u32x4*)(ws + WS_ROUTEW);
    LAS int* tst = (LAS int*)(F.lds + MISC_OFF + 256);
    { gu32* ctl = (gu32*)(ws + WS_CTL); LAS int* cntl = (LAS int*)(F.lds + MISC_OFF + 64);
      if (F.tid < 32) cntl[F.tid] = (int)__hip_atomic_load((unsigned*)(ctl + CW_CNT) + F.tid, __ATOMIC_RELAXED, __HIP_MEMORY_SCOPE_AGENT);
      __syncthreads();
      if (F.tid == 0) { int sacc = 0; for (int e = 0; e < 32; ++e) { tst[e] = sacc; sacc += (cntl[e] + 255) >> 8; } tst[32] = sacc; }
      __syncthreads(); }
    const int gw = F.vcu * NWAVES + F.wave, NGW = F.G * NWAVES;
    for (int ch = gw; ch < T / 32; ch += NGW) {
        const int b = (ch * 32) >> 13;
        f32x4 Gv[4], Sv[4], Tv[4];
#pragma unroll
        for (int j = 0; j < 4; ++j) { const int k = 4 * F.lane + 256 * j; Gv[j] = *(const f32x4*)(g + k) * (*(const f32x4*)(MODF + b * 8192 + 6144 + 1024 + k) + 1.0f); Sv[j] = *(const f32x4*)(MODF + b * 8192 + 6144 + k); Tv[j] = *(const f32x4*)(MODF + b * 8192 + 5120 + k); }
        unsigned my_r0, my_r1, my_w0, my_w1;
        { const u32x4 ti = TOKINFO[(size_t)ch * 32 + (F.lane & 31)];
          my_r0 = (unsigned)tst[ti.x >> 16] * 256u + (ti.x & 0xffffu); my_r1 = (unsigned)tst[ti.y >> 16] * 256u + (ti.y & 0xffffu); my_w0 = ti.z; my_w1 = ti.w; }
#pragma unroll 4
        for (int rr = 0; rr < 32; ++rr) { const size_t row = (size_t)ch * 32 + rr; f32x4* hr = (f32x4*)(out + row * 1024) + F.lane; const u32x2* hb = (const u32x2*)(H + row * 1024) + F.lane;
            const size_t r0 = (size_t)__builtin_amdgcn_readlane(my_r0, rr), r1 = (size_t)__builtin_amdgcn_readlane(my_r1, rr);
            const float w0 = __uint_as_float(__builtin_amdgcn_readlane(my_w0, rr)), w1 = __uint_as_float(__builtin_amdgcn_readlane(my_w1, rr));
            const u32x2* y0 = (const u32x2*)(Y2 + r0 * 1024) + F.lane; const u32x2* y1 = (const u32x2*)(Y2 + r1 * 1024) + F.lane;
            f32x4 v[4]; float s = 0.f;
#pragma unroll
            for (int j = 0; j < 4; ++j) { const u32x2 p = y0[64 * j], q = y1[64 * j], hw = hb[64 * j]; v[j] = (f32x4){bf_lo(hw.x), bf_hi(hw.x), bf_lo(hw.y), bf_hi(hw.y)};
                v[j][0] += Tv[j][0] * (w0 * bf_lo(p.x) + w1 * bf_lo(q.x)); v[j][1] += Tv[j][1] * (w0 * bf_hi(p.x) + w1 * bf_hi(q.x)); v[j][2] += Tv[j][2] * (w0 * bf_lo(p.y) + w1 * bf_lo(q.y)); v[j][3] += Tv[j][3] * (w0 * bf_hi(p.y) + w1 * bf_hi(q.y));
                s += (v[j][0] * v[j][0] + v[j][1] * v[j][1]) + (v[j][2] * v[j][2] + v[j][3] * v[j][3]); }
            const float rs = __builtin_amdgcn_rsqf(wave_sum(s) * (1.0f / 1024.0f) + EPS);
#pragma unroll
            for (int j = 0; j < 4; ++j) hr[64 * j] = v[j] * rs * Gv[j] + Sv[j]; }
    }
}

constexpr int N_PHASES = 11;
constexpr int MISC_BAR = MISC_OFF + 32, MISC_CNT = MISC_OFF + 64, MISC_TST = MISC_OFF + 256;

__global__ void __launch_bounds__(NWAVES * 64, 2) fwd(Args args) {
    extern __shared__ __attribute__((aligned(16))) unsigned char lds[];
    Frame F;
    F.lds = (LAS unsigned char*)lds;
    F.tid = threadIdx.x; F.lane = F.tid & 63; F.wave = __builtin_amdgcn_readfirstlane(F.tid >> 6);
    F.G = gridDim.x; { const int bx = blockIdx.x; F.vcu = (F.G % 8 == 0) ? (bx % 8) * (F.G / 8) + bx / 8 : bx; }
    unsigned char* ws = args.ws;
    gu32* ctl = (gu32*)(ws + WS_CTL);
    for (int u = F.tid; u < 1024 / 4; u += NWAVES * 64) ((LAS unsigned*)(F.lds + MISC_OFF))[u] = 0u;
    __syncthreads();
#if MK_PER_PHASE
#define GRID_BAR() do { } while (0)
#else
    XcdBarrier bar = xcd_barrier_post((unsigned*)(ctl + CW_BAR), (volatile LAS unsigned*)(F.lds + MISC_BAR));
#define GRID_BAR() xcd_barrier(bar)
#endif
#ifdef DBG_SYSFENCE
    __builtin_amdgcn_fence(__ATOMIC_ACQUIRE, ""); asm volatile("s_waitcnt vmcnt(0)" ::: "memory"); __syncthreads();
#endif
    const int lo = args.ph_lo, hi = args.ph_hi;
#ifndef PH_MASK
#define PH_MASK 0x7ff
#endif
#define IN(k) ((((PH_MASK) >> (k)) & 1) && lo <= (k) && (k) < hi)
#define BOTH(k) (IN(k) && IN((k) + 1))
    LAS unsigned char* ring = F.lds + RING_OFF;
#define REFRESH_F() do { int t_ = threadIdx.x; asm volatile("" : "+v"(t_)); F.tid = t_; F.lane = t_ & 63; } while (0)
    const int bx = (int)blockIdx.x;

    if (IN(0)) { REFRESH_F(); p0_prologue(F, args); if (BOTH(0)) GRID_BAR(); }
    if (IN(1)) { REFRESH_F(); p1_norm(F, args); if (BOTH(1)) GRID_BAR(); }
    if (IN(2)) {
#ifdef WG_STAGGER
        if (bx & 1) { for (int q = 0; q < WG_STAGGER; ++q) __builtin_amdgcn_s_sleep(127); }
#endif
#ifndef NO_G1M
        { pg8::PlainOrder8 S{(const char*)(ws + WS_R1), (const char*)(ws + WS_W8IN), 1024, T / 256, NWIN / 256, F.G, bx};
          EpiZ8 E{ws, args.in[14]};
          pg8::gemm_phase(ring, 1024, S, E); }
#endif
#ifdef PROBE_KLOOP
        { pg8::PlainOrder S{(const char*)(ws + WS_R1), (const char*)(ws + WS_WIN), 1024, T / 256, NWIN / 256, F.G, bx};
          EpiNull E{(float*)(ws + WS_SSQQ), args.ph_lo};
          pg8::gemm_phase(ring, 1024, S, E); }
#endif
#ifndef NO_G1F
        { F1Order8 S{(const char*)(ws + WS_W8FY), (const char*)(ws + WS_R1), F.G, bx};
          EpiF18 E{ws};
          pg8::gemm_phase(ring, 1024, S, E); }
#endif
        if (BOTH(2)) GRID_BAR();
    }
    if (IN(3)) {
#ifndef NO_P3A
        { pg8::PlainOrder S{(const char*)(ws + WS_QL), (const char*)(ws + WS_WUQ), 256, T / 256, 3, F.G, bx};
          EpiQ E{(bf16_t*)(ws + WS_Q), (const float*)(ws + WS_SSQQ), (const float*)(ws + WS_ROPEC), (const float*)(ws + WS_ROPES)};
          pg8::gemm_phase(ring, 256, S, E); }
#endif
#ifndef NO_P3B
        { pg8::PlainOrder S{(const char*)(ws + WS_KVL), (const char*)(ws + WS_WUKV), 256, T / 256, 4, F.G, bx};
          EpiKV E{(bf16_t*)(ws + WS_K), (bf16_t*)(ws + WS_V), (const float*)(ws + WS_SSQKV)};
          pg8::gemm_phase(ring, 256, S, E); }
#endif
#ifndef NO_P3C
        { pg8::PlainOrder S{(const char*)(ws + WS_DFTA), (const char*)(ws + WS_YT2), 256, 1, 1024, F.G, bx};
          EpiFA E{(bf16_t*)(ws + WS_R1)};
          pg8::gemm_phase(ring, 256, S, E); }
#endif
        if (BOTH(3)) GRID_BAR();
    }
    if (IN(4)) {
        { FBOrder S{(const char*)(ws + WS_TB2), (const char*)(ws + WS_R1), F.G, bx};
          EpiFB E{(bf16_t*)(ws + WS_YT2)};
          pg8::gemm_phase(ring, 256, S, E); }
        __syncthreads();
        { const bf16_t* Q = (const bf16_t*)(ws + WS_Q); const bf16_t* KB = (const bf16_t*)(ws + WS_K); const bf16_t* VB = (const bf16_t*)(ws + WS_V); bf16_t* O = (bf16_t*)(ws + WS_QL);
#define ATT_LOOP \
          for (int i = 0;; ++i) { const int unit = i * F.G + F.vcu; if (unit >= 1024) break; const int bh = unit >> 4, qb = unit & 15, b = bh >> 3, h = bh & 7; \
              att::attn_unit(Q + ((size_t)b * 8192 + qb * 512) * QC + h * 96, KB + (size_t)bh * 8192 * 96, VB + (size_t)bh * 8192 * 64, O + ((size_t)b * 8192 + qb * 512) * 512 + h * 64, ring); }
          ATT_LOOP
        }
        if (BOTH(4)) GRID_BAR();
    }
    if (IN(5)) {
        { MergeOrder S{(const char*)(ws + WS_QL), (const char*)(ws + WS_YT2), (const char*)(ws + WS_WBA), F.G, bx};
          EpiMerge2 E{(bf16_t*)(ws + WS_R1), (const unsigned char*)(ws + WS_GATE)};
          pg8::gemm_phase(ring, 1024, S, E); }
        if (BOTH(5)) GRID_BAR();
    }
    if (IN(6)) {
        { pg8::PlainOrder S{(const char*)(ws + WS_R1), (const char*)(ws + WS_WOUT), 1024, T / 256, 4, F.G, bx};
          EpiH E{args.in[0], (bf16_t*)(ws + WS_YT2), (const float*)(ws + WS_MODF)};
          pg8::gemm_phase(ring, 1024, S, E); }
        if (BOTH(6)) GRID_BAR();
    }
    if (IN(7)) { REFRESH_F(); p7_route(F, args); if (BOTH(7)) GRID_BAR(); }
    if (IN(8) || IN(9)) {
        REFRESH_F();
        LAS int* tst = (LAS int*)(F.lds + MISC_TST); LAS int* cntl = (LAS int*)(F.lds + MISC_CNT);
        if (F.tid < 32) cntl[F.tid] = (int)__hip_atomic_load((unsigned*)(ctl + CW_CNT) + F.tid, __ATOMIC_RELAXED, __HIP_MEMORY_SCOPE_AGENT);
        __syncthreads();
        if (F.tid == 0) { int s = 0; for (int e = 0; e < 32; ++e) { tst[e] = s; s += (cntl[e] + 255) >> 8; } tst[32] = s; }
        __syncthreads();
        { LAS unsigned char* texp = (LAS unsigned char*)(tst + 40); const int e = F.tid >> 4; if (F.tid < 512) for (int tl = tst[e] + (F.tid & 15); tl < tst[e + 1]; tl += 16) texp[tl] = (unsigned char)e; }
        __syncthreads();
        if (IN(8)) {
            MoeUpOrder8 S{(const char*)(ws + WS_R1), (const char*)(ws + WS_W8GU), (const u32x2*)(ws + WS_LIST), tst, cntl, F.G, bx};
            EpiUp8 E{ws};
            pg8::gemm_phase(ring, 1024, S, E);
            if (BOTH(8)) GRID_BAR();
        }
        if (IN(9)) {
            MoeDownOrder S{(const char*)(ws + WS_Q), (const char*)(ws + WS_WDN), tst, cntl, F.G, bx};
            EpiDown E{(bf16_t*)(ws + WS_GATE)};
            pg8::gemm_phase(ring, 256, S, E);
            if (BOTH(9)) GRID_BAR();
        }
    }
    if (IN(10)) { REFRESH_F(); p10_final(F, args); }
#ifdef DBG_SYSFENCE
    asm volatile("s_waitcnt vmcnt(0)" ::: "memory"); __syncthreads(); __builtin_amdgcn_fence(__ATOMIC_RELEASE, ""); asm volatile("s_waitcnt vmcnt(0)" ::: "memory");
#endif
#undef IN
#undef BOTH
}

extern "C" void kernel_launch(void* const* d_in, const int* in_sizes, int n_in, void* d_out, int out_size, void* d_ws, size_t ws_size, hipStream_t stream) {
    static int grid = 0;
    if (grid == 0) {
        if (n_in != 27 || in_sizes[0] != T * D || out_size != T * D || ws_size < WS_END) { fprintf(stderr, "kernel_launch: shape/workspace mismatch: n_in %d in0 %d out %d ws %zu (need %zu)\n", n_in, n_in > 0 ? in_sizes[0] : -1, out_size, ws_size, (size_t)WS_END); grid = -1; return; }
        int dev = 0, cus = 0;
        if (hipGetDevice(&dev) != hipSuccess || hipDeviceGetAttribute(&cus, hipDeviceAttributeMultiprocessorCount, dev) != hipSuccess) { fprintf(stderr, "kernel_launch: device query failed\n"); grid = -1; return; }
        if (hipFuncSetAttribute((const void*)fwd, hipFuncAttributeMaxDynamicSharedMemorySize, LDS_BYTES) != hipSuccess) { fprintf(stderr, "kernel_launch: hipFuncSetAttribute failed\n"); grid = -1; return; }
        int per_cu = 0;
        if (hipOccupancyMaxActiveBlocksPerMultiprocessor(&per_cu, (const void*)fwd, NWAVES * 64, LDS_BYTES) != hipSuccess || per_cu < 1) fprintf(stderr, "kernel_launch: note: occupancy query reports %d workgroups per CU\n", per_cu);
        (void)hipGetLastError();
        grid = cus;
    }
    if (grid < 0) return;
    if (hipMemsetAsync((char*)d_ws + WS_CTL, 0, CTL_ZERO_BYTES, stream) != hipSuccess) { fprintf(stderr, "kernel_launch: memset failed\n"); return; }
    Args a{};
    for (int i = 0; i < 27; ++i) a.in[i] = (const float*)d_in[i];
    a.out = (float*)d_out; a.ws = (unsigned char*)d_ws;
#if MK_PER_PHASE
    for (int p = 0; p < N_PHASES; ++p) { a.ph_lo = p; a.ph_hi = p + 1; a.li = p;
        hipLaunchKernelGGL(fwd, dim3(grid), dim3(NWAVES * 64), LDS_BYTES, stream, a);
        const hipError_t le = hipPeekAtLastError(); if (le != hipSuccess) { fprintf(stderr, "kernel_launch: launch %d failed: %s\n", p, hipGetErrorName(le)); break; } }
#else
#ifdef PROBE_MASK
    { bool first = true;
      for (int k = 0; k < N_PHASES; ++k) for (int rep = 0; rep < (((PROBE_MASK) >> k) & 1 ? 2 : 1); ++rep) { a.ph_lo = k; a.ph_hi = k + 1; a.li = 0;
        if (!first) (void)hipMemsetAsync((char*)d_ws + WS_CTL + CW_BAR * 4, 0, XCD_BAR_WORDS * 4, stream);
        first = false;
        hipLaunchKernelGGL(fwd, dim3(grid), dim3(NWAVES * 64), LDS_BYTES, stream, a); } }
#else
    a.ph_lo = 0; a.ph_hi = N_PHASES; a.li = 0;
    hipLaunchKernelGGL(fwd, dim3(grid), dim3(NWAVES * 64), LDS_BYTES, stream, a);
    { const hipError_t le = hipPeekAtLastError(); if (le != hipSuccess) fprintf(stderr, "kernel_launch: launch failed: %s\n", hipGetErrorName(le)); }
#endif
#endif
}
```

```cpp
#include <hip/hip_runtime.h>
#include <cstdio>
#include <cstdint>

#ifndef MK_PER_PHASE
#define MK_PER_PHASE 0
#endif

#define LAS __attribute__((address_space(3)))
#define GAS __attribute__((address_space(1)))
typedef unsigned short bf16_t;
typedef short bf16x8 __attribute__((ext_vector_type(8)));
typedef short s16x4 __attribute__((ext_vector_type(4)));
typedef float f32x4 __attribute__((ext_vector_type(4)));
typedef float f32x16 __attribute__((ext_vector_type(16)));
typedef unsigned u32x4 __attribute__((ext_vector_type(4)));
typedef unsigned u32x2 __attribute__((ext_vector_type(2)));
typedef GAS unsigned gu32;
typedef int i32x4 __attribute__((ext_vector_type(4)));

constexpr int NB = 8, SEQ = 8192, T = NB * SEQ, D = 1024;
constexpr int NH = 8, DQK = 96, DV = 64, QC = NH * DQK;
constexpr float EPS = 1e-6f;
constexpr float C2 = 0.14724444602590306f;
constexpr float FNORM = 0.0013810679320049755f;
constexpr int NEXP = 32, DEXP = 256;
constexpr int NWAVES = 8;

constexpr size_t MiB = 1u << 20;
constexpr size_t WS_CTL = 0, CTL_ZERO_BYTES = 1 * MiB;
constexpr size_t WS_SSQQ = 1 * MiB, WS_SSQKV = 2 * MiB, WS_ROUTEW = 3 * MiB, WS_MODF = 4 * MiB;
constexpr size_t WS_ROPEC = 8 * MiB, WS_ROPES = 12 * MiB, WS_LIST = 16 * MiB;
constexpr size_t WS_WIN = 32 * MiB, WS_WFY = 38 * MiB, WS_WUQ = 40 * MiB, WS_WUKV = 40 * MiB + 512 * 1024, WS_WBA = 41 * MiB, WS_WBF = 42 * MiB, WS_WOUT = 43 * MiB;
constexpr size_t WS_DFTA = 45 * MiB, WS_TB2 = 46 * MiB, WS_WGU = 50 * MiB, WS_WDN = 82 * MiB;
constexpr size_t WS_R1 = 100 * MiB;
constexpr size_t WS_GATE = 228 * MiB;
constexpr size_t WS_QL = 484 * MiB, WS_KVL = 516 * MiB;
constexpr size_t WS_Q = 548 * MiB, WS_K = 644 * MiB, WS_V = 740 * MiB;
constexpr size_t WS_YT2 = 804 * MiB;
constexpr size_t WS_W8IN = 932 * MiB, WS_W8FY = 935 * MiB, WS_W8GU = 936 * MiB;
constexpr size_t WS_SU = 5 * MiB;
constexpr size_t WS_END = 1024 * MiB;
constexpr int CW_TMO = 0;
constexpr int CW_BAR = 4096;
constexpr int CW_CNT = 8192;
constexpr int CW_WMAX = 8256;
constexpr int CW_MOD = 16384;
constexpr int NWIN = 2816;

constexpr int LDS_BYTES = 163840;
constexpr int MISC_OFF = 163840 - 1024;
constexpr int RING_OFF = 0;

#define LDS_WAIT() asm volatile("s_waitcnt lgkmcnt(0)" ::: "memory")
#define VM_WAIT() asm volatile("s_waitcnt vmcnt(0)" ::: "memory")
typedef float f32x2_t __attribute__((ext_vector_type(2))); typedef __bf16 bf16x2_t __attribute__((ext_vector_type(2)));
__device__ __forceinline__ unsigned cvt_pk_bf16(float lo, float hi) { f32x2_t v = {lo, hi}; bf16x2_t b = __builtin_convertvector(v, bf16x2_t); return __builtin_bit_cast(unsigned, b); }
__device__ __forceinline__ float bf_lo(unsigned w) { return __uint_as_float(w << 16); }
__device__ __forceinline__ float bf_hi(unsigned w) { return __uint_as_float(w & 0xffff0000u); }
__device__ __forceinline__ u32x4 pack8(const f32x4 a, const f32x4 b) { u32x4 w; w.x = cvt_pk_bf16(a[0], a[1]); w.y = cvt_pk_bf16(a[2], a[3]); w.z = cvt_pk_bf16(b[0], b[1]); w.w = cvt_pk_bf16(b[2], b[3]); return w; }
__device__ __forceinline__ u32x2 pack4(const f32x4 a) { u32x2 w; w.x = cvt_pk_bf16(a[0], a[1]); w.y = cvt_pk_bf16(a[2], a[3]); return w; }
__device__ __forceinline__ float sigmoidf_(float x) { return __builtin_amdgcn_rcpf(1.0f + __builtin_amdgcn_exp2f(-1.4426950408889634f * x)); }
__device__ __forceinline__ float wave_sum(float v) {
#pragma unroll
    for (int o = 1; o < 64; o <<= 1) v += __shfl_xor(v, o);
    return v;
}

#define XB_TMO      128
#define XB_XCNT(j)  (256  + 64 * (j))
#define XB_XSUB(j)  (1280 + 64 * (j))
#define XB_XGEN(j)  (2304 + 64 * (j))
#define XB_TOP      3328
#define XB_TOPGEN   3392
#define XCD_BAR_WORDS 3456
#define XB_SPIN_CAP (1u << 18)
__device__ __forceinline__ unsigned xb_ld(unsigned* p)              { return __hip_atomic_load(p, __ATOMIC_RELAXED, __HIP_MEMORY_SCOPE_AGENT); }
__device__ __forceinline__ unsigned xb_add(unsigned* p, unsigned v) { return __hip_atomic_fetch_add(p, v, __ATOMIC_RELAXED, __HIP_MEMORY_SCOPE_AGENT); }
__device__ __forceinline__ unsigned xb_xcc_id() { return (unsigned)__builtin_amdgcn_s_getreg((3 << 11) | 20) & 0xFu; }
#define XB_SPIN(cond, bar) do { unsigned _sp = 0; while (cond) { __builtin_amdgcn_s_sleep(1); \
    if ((++_sp & 255u) == 0u) { if (xb_ld(&(bar)[XB_TMO])) break; if (_sp > XB_SPIN_CAP) { atomicAdd(&(bar)[XB_TMO], 1u); break; } } } } while (0)
struct XcdBarrier { unsigned* bar; unsigned x; volatile LAS unsigned* st; };
__device__ __forceinline__ XcdBarrier xcd_barrier_post(unsigned* bar, volatile LAS unsigned* st) {
    XcdBarrier b; b.bar = bar; b.x = xb_xcc_id(); b.st = st;
    if (threadIdx.x == 0) (void)xb_add(&bar[XB_XCNT(b.x)], 1u);
    return b;
}
__device__ __forceinline__ void xcd_barrier_complete(unsigned* bar, unsigned x, unsigned& nloc, unsigned& nx) {
    const unsigned G = gridDim.x * gridDim.y * gridDim.z;
    unsigned sum, cnt, mine, sp = 0u;
    for (;;) {
        sum = 0u; cnt = 0u; mine = 0u;
#pragma unroll
        for (unsigned j = 0; j < 16; ++j) { const unsigned c = xb_ld(&bar[XB_XCNT(j)]); sum += c; cnt += (c > 0u) ? 1u : 0u; mine = (j == x) ? c : mine; }
        if (sum == G) break;
        __builtin_amdgcn_s_sleep(1);
        if ((++sp & 255u) == 0u) { if (xb_ld(&bar[XB_TMO])) break; if (sp > XB_SPIN_CAP) { atomicAdd(&bar[XB_TMO], 1u); break; } }
    }
    nloc = mine > 0u ? mine : 1u; nx = cnt > 0u ? cnt : 1u;
}
__device__ __forceinline__ void xcd_barrier(const XcdBarrier& b) {
    asm volatile("s_waitcnt vmcnt(0)" ::: "memory");
    __syncthreads();
    if (threadIdx.x == 0) {
        unsigned* bar = b.bar;
        __builtin_amdgcn_s_waitcnt(0);
        unsigned nloc = b.st[0], nx = b.st[1];
        if (nloc == 0u) { xcd_barrier_complete(bar, b.x, nloc, nx); b.st[0] = nloc; b.st[1] = nx; }
        const unsigned old = xb_add(&bar[XB_XSUB(b.x)], 1u);
        const unsigned gen = old / nloc;
        if (old + 1u == (gen + 1u) * nloc) {
            __builtin_amdgcn_fence(__ATOMIC_RELEASE, "agent");
            asm volatile("s_waitcnt vmcnt(0)" ::: "memory");
            const unsigned og = xb_add(&bar[XB_TOP], 1u);
            const unsigned tg = og / nx;
            if (og + 1u == (tg + 1u) * nx) xb_add(&bar[XB_TOPGEN], 1u);
            else XB_SPIN(xb_ld(&bar[XB_TOPGEN]) == tg, bar);
            __builtin_amdgcn_fence(__ATOMIC_ACQUIRE, "agent");
            xb_add(&bar[XB_XGEN(b.x)], 1u);
            asm volatile("s_waitcnt vmcnt(0)" ::: "memory");
        } else {
            XB_SPIN(xb_ld(&bar[XB_XGEN(b.x)]) == gen, bar);
            __builtin_amdgcn_fence(__ATOMIC_ACQUIRE, "agent");
            asm volatile("s_waitcnt vmcnt(0)" ::: "memory");
        }
    }
    __syncthreads();
}

namespace pg8 {
constexpr int BM = 256, BK = 64, HALF = 128, HTB = HALF * BK * 2, STAGE_BYTES = 8 * HTB, NXCD = 8, WGM = 4;
__host__ __device__ __forceinline__ int lds_byte(int r, int c) { const int st = (r >> 4) * 2 + (c >> 5), rr = r & 15, cc = c & 31, ob = rr * 64 + cc * 2; return st * 1024 + (ob ^ (((ob >> 9) & 1) << 5)); }
__host__ __device__ __forceinline__ void stage_rc(int b, int& R, int& C) { const int st = b / 1024, sb = b % 1024, swz = sb ^ (((sb >> 9) & 1) << 5); R = (st >> 1) * 16 + swz / 64; C = (st & 1) * 32 + (swz % 64) / 2; }
__host__ __device__ __forceinline__ int perm32(int rho) { const int n = rho >> 4, i = rho & 15; return 8 * (i >> 2) + 4 * n + (i & 3); }

struct UnitPN { int pm, pn; };
__device__ __forceinline__ bool static_next(int i, int G, int c, int nM, int nN, int& pm, int& pn) {
    const int nwg = nM * nN; const long L = (long)i * G + c; if (L >= nwg) return false;
    int wgid = (int)L; { const int q = nwg / NXCD, r = nwg % NXCD, xcd = wgid % NXCD, off = wgid / NXCD; wgid = (xcd < r ? xcd * (q + 1) : r * (q + 1) + (xcd - r) * q) + off; }
    const int nig = WGM * nN, gid = wgid / nig, fm = gid * WGM, gsz = (nM - fm) < WGM ? (nM - fm) : WGM;
    pm = fm + ((wgid % nig) % gsz); pn = (wgid % nig) / gsz; return true;
}
struct PlainOrder {
    typedef UnitPN Unit; static constexpr bool VARA = false, VARB = false;
    const char* A; const char* B; int K, nM, nN, G, c;
    __device__ __forceinline__ bool next(int i, Unit& u) const { return static_next(i, G, c, nM, nN, u.pm, u.pn); }
    __device__ __forceinline__ const char* baseA(const Unit& u) const { return A + (size_t)u.pm * 256 * K * 2; }
    __device__ __forceinline__ const char* baseB(const Unit& u) const { return B + (size_t)u.pn * 256 * K * 2; }
    __device__ __forceinline__ unsigned hstepA() const { return (unsigned)(128 * K * 2); }
    __device__ __forceinline__ unsigned hstepB() const { return (unsigned)(128 * K * 2); }
    __device__ __forceinline__ size_t koffA(int t) const { return (size_t)t * 128; }
    __device__ __forceinline__ void offA(const Unit&, const int (&R)[2], const int (&C)[2], unsigned (&o)[2][2]) const {
#pragma unroll
        for (int h = 0; h < 2; ++h)
#pragma unroll
            for (int i = 0; i < 2; ++i) o[h][i] = (unsigned)((h * 128 + R[i]) * K + C[i]) * 2u; }
    __device__ __forceinline__ void offB(const Unit& u, const int (&R)[2], const int (&C)[2], unsigned (&o)[2][2]) const { offA(u, R, C, o); }
};

struct PlainOrder8 {
    typedef UnitPN Unit; static constexpr bool VARA = false, VARB = false;
    const char* A; const char* B; int K, nM, nN, G, c;
    __device__ __forceinline__ bool next(int i, Unit& u) const { return static_next(i, G, c, nM, nN, u.pm, u.pn); }
    __device__ __forceinline__ const char* baseA(const Unit& u) const { return A + (size_t)u.pm * 256 * K; }
    __device__ __forceinline__ const char* baseB(const Unit& u) const { return B + (size_t)u.pn * 256 * K; }
    __device__ __forceinline__ unsigned hstepA() const { return (unsigned)(128 * K); }
    __device__ __forceinline__ unsigned hstepB() const { return (unsigned)(128 * K); }
    __device__ __forceinline__ size_t koffA(int t) const { return (size_t)t * 128; }
    __device__ __forceinline__ void offA(const Unit&, const int (&R)[2], const int (&C)[2], unsigned (&o)[2][2]) const {
#pragma unroll
        for (int h = 0; h < 2; ++h)
#pragma unroll
            for (int i = 0; i < 2; ++i) o[h][i] = (unsigned)((h * 128 + R[i]) * K + C[i] * 2); }
    __device__ __forceinline__ void offB(const Unit& u, const int (&R)[2], const int (&C)[2], unsigned (&o)[2][2]) const { offA(u, R, C, o); }
};
__device__ __forceinline__ const char* uni_ptr(const char* p) { const unsigned long long v = (unsigned long long)(uintptr_t)p; return (const char*)(uintptr_t)(((unsigned long long)(unsigned)__builtin_amdgcn_readfirstlane((int)(v >> 32)) << 32) | (unsigned)__builtin_amdgcn_readfirstlane((int)(unsigned)v)); }
template <bool B, class X, class Y> struct sel_t { typedef X type; };
template <class X, class Y> struct sel_t<false, X, Y> { typedef Y type; };
template <class Epi, class Sched>
__device__ __forceinline__ void gemm_phase(LAS unsigned char* lds, const int K, const Sched& S, const Epi& E) {
    typedef typename Sched::Unit Unit;
    int tid_ = threadIdx.x; asm volatile("" : "+v"(tid_));
    const int tid = tid_, wid = __builtin_amdgcn_readfirstlane(tid >> 6), lane = tid & 63, wr = wid >> 2, wc = wid & 3, fr = lane & 15, fq = lane >> 4;
    typedef typename sel_t<Epi::I8, i32x4, f32x4>::type acc_t;
    const int nt = K / (Epi::I8 ? 2 * BK : BK);
    int Rr[2], Cc[2], Rb[2];
#pragma unroll
    for (int i = 0; i < 2; ++i) { stage_rc(tid * 16 + i * 8192, Rr[i], Cc[i]); Rb[i] = Epi::PERM ? ((Rr[i] & ~31) + perm32(Rr[i] & 31)) : Rr[i]; }
    const size_t kstep = (size_t)(BK * 2);
    const unsigned ldsw = (unsigned)wid * 1024u, ldsb = (unsigned)(uintptr_t)lds;
    const unsigned hsA = S.hstepA(), hsB = S.hstepB();
    const int aoff = lds_byte(wr * 64 + fr, fq * 8), boff = lds_byte(wc * 32 + fr, fq * 8);
#define PG8_SA(b, h) (((b) * 2 + (h)) * HTB)
#define PG8_SB(b, h) ((4 + (b) * 2 + (h)) * HTB)
#ifdef PG8_BUILTIN_GLDS
#define PG8_STAGE_A(bufoff, gbase, O, h) do { _Pragma("unroll") for (int _i = 0; _i < 2; ++_i) \
        __builtin_amdgcn_global_load_lds((const unsigned*)(Sched::VARA ? (const char*)(gbase) + (O)[h][_i] : (const char*)(gbase) + (size_t)(h) * hsA + (O)[0][_i]), (LAS unsigned*)(lds + (bufoff) + ldsw + _i * 8192), 16, 0, 0); } while (0)
#define PG8_STAGE_B(bufoff, gbase, O, h) do { _Pragma("unroll") for (int _i = 0; _i < 2; ++_i) \
        __builtin_amdgcn_global_load_lds((const unsigned*)(Sched::VARB ? (const char*)(gbase) + (O)[h][_i] : (const char*)(gbase) + (size_t)(h) * hsB + (O)[0][_i]), (LAS unsigned*)(lds + (bufoff) + ldsw + _i * 8192), 16, 0, 0); } while (0)
#else
#define PG8_GLDS(ubase, voff, ldsaddr) do { unsigned keep_; asm volatile("s_mov_b32 %0, m0\n\ts_mov_b32 m0, %3\n\ts_nop 0\n\tglobal_load_lds_dwordx4 %1, %2\n\ts_mov_b32 m0, %0" \
        : "=&s"(keep_) : "v"(voff), "s"(uni_ptr(ubase)), "s"((unsigned)(ldsaddr)) : "memory"); } while (0)
#define PG8_STAGE_A(bufoff, gbase, O, h) do { _Pragma("unroll") for (int _i = 0; _i < 2; ++_i) \
        PG8_GLDS(Sched::VARA ? (const char*)(gbase) : (const char*)(gbase) + (size_t)(h) * hsA, Sched::VARA ? (O)[h][_i] : (O)[0][_i], ldsb + (unsigned)(bufoff) + ldsw + _i * 8192u); } while (0)
#define PG8_STAGE_B(bufoff, gbase, O, h) do { _Pragma("unroll") for (int _i = 0; _i < 2; ++_i) \
        PG8_GLDS(Sched::VARB ? (const char*)(gbase) : (const char*)(gbase) + (size_t)(h) * hsB, Sched::VARB ? (O)[h][_i] : (O)[0][_i], ldsb + (unsigned)(bufoff) + ldsw + _i * 8192u); } while (0)
#endif
#define PG8_LDA(dst, b, h) do { _Pragma("unroll") for (int m = 0; m < 4; ++m) _Pragma("unroll") for (int k = 0; k < 2; ++k) dst[m][k] = *(const LAS bf16x8*)(lds + PG8_SA(b, h) + aoff + m * 2048 + k * 1024); } while (0)
#define PG8_LDB(dst, b, h) do { _Pragma("unroll") for (int n = 0; n < 2; ++n) _Pragma("unroll") for (int k = 0; k < 2; ++k) dst[n][k] = *(const LAS bf16x8*)(lds + PG8_SB(b, h) + boff + n * 2048 + k * 1024); } while (0)
#define PG8_MMA(ai, bj, At, Bt) do { __builtin_amdgcn_s_setprio(1); _Pragma("unroll") for (int m = 0; m < 4; ++m) _Pragma("unroll") for (int n = 0; n < 2; ++n) _Pragma("unroll") for (int k = 0; k < 2; ++k) \
        { if constexpr (Epi::I8) acc[ai][bj][m][n] = __builtin_bit_cast(acc_t, __builtin_amdgcn_mfma_i32_16x16x64_i8(__builtin_bit_cast(i32x4, Bt[n][k]), __builtin_bit_cast(i32x4, At[m][k]), __builtin_bit_cast(i32x4, acc[ai][bj][m][n]), 0, 0, 0)); \
          else acc[ai][bj][m][n] = __builtin_bit_cast(acc_t, __builtin_amdgcn_mfma_f32_16x16x32_bf16(Bt[n][k], At[m][k], __builtin_bit_cast(f32x4, acc[ai][bj][m][n]), 0, 0, 0)); } __builtin_amdgcn_s_setprio(0); } while (0)
#ifdef DBG_WAIT0
#define PG8_WAIT_V(n) asm volatile("s_waitcnt vmcnt(0)" ::: "memory")
#else
#define PG8_WAIT_V(n) asm volatile("s_waitcnt vmcnt(" #n ")" ::: "memory")
#endif
#define PG8_WAIT_L(n) asm volatile("s_waitcnt lgkmcnt(" #n ")" ::: "memory")
#define PG8_BAR __builtin_amdgcn_s_barrier()
#define PG8_SCHED __builtin_amdgcn_sched_barrier(0)
    Unit cur, nxt; int ui = 0;
    if (!S.next(0, cur)) return;
    acc_t acc[2][2][4][2];
#pragma unroll
    for (int a = 0; a < 2; ++a)
#pragma unroll
        for (int b = 0; b < 2; ++b)
#pragma unroll
            for (int m = 0; m < 4; ++m)
#pragma unroll
                for (int n = 0; n < 2; ++n) acc[a][b][m][n] = acc_t{};
    bf16x8 At[4][2], B0[2][2], B1[2][2];
    unsigned oA[2][2], oB[2][2];
    S.offA(cur, Rr, Cc, oA); S.offB(cur, Rb, Cc, oB);
    const char* cA = S.baseA(cur); const char* cB = S.baseB(cur);
    PG8_STAGE_B(PG8_SB(0, 0), cB, oB, 0); PG8_STAGE_B(PG8_SB(0, 1), cB, oB, 1); PG8_STAGE_A(PG8_SA(0, 0), cA, oA, 0); PG8_STAGE_A(PG8_SA(0, 1), cA, oA, 1);
    if (wr == 1) PG8_BAR;
    PG8_WAIT_V(2); PG8_BAR;
    PG8_STAGE_B(PG8_SB(1, 0), cB + kstep, oB, 0); PG8_STAGE_A(PG8_SA(1, 0), cA + S.koffA(1), oA, 0); PG8_STAGE_B(PG8_SB(1, 1), cB + kstep, oB, 1);
    PG8_WAIT_V(6); PG8_BAR;
    for (;;) {
        const bool has_next = S.next(ui + 1, nxt);
        const char* nA = has_next ? S.baseA(nxt) : cA; const char* nB = has_next ? S.baseB(nxt) : cB;
        unsigned nOA[2][2], nOB[2][2];
#pragma unroll
        for (int h = 0; h < 2; ++h)
#pragma unroll
            for (int i = 0; i < 2; ++i) { nOA[h][i] = oA[h][i]; nOB[h][i] = oB[h][i]; }
        if constexpr (Sched::VARA) { if (has_next) S.offA(nxt, Rr, Cc, nOA); }
        if constexpr (Sched::VARB) { if (has_next) S.offB(nxt, Rb, Cc, nOB); }
#pragma unroll 1
        for (int t = 0; t < nt; t += 2) {
            const bool last = (t == nt - 2);
            if constexpr (Epi::MIDK) { if (t == nt / 2) E.mid(acc, cur, wr, wc, fr, fq); }
            const char* a1 = cA + S.koffA(t + 1);
            const char* a2 = last ? nA : cA + S.koffA(t + 2); const char* b2 = last ? nB : cB + (size_t)(t + 2) * kstep;
            const char* a3 = last ? nA + S.koffA(1) : cA + S.koffA(t + 3); const char* b3 = b2 + kstep;
            unsigned sA[2][2], sB[2][2];
#pragma unroll
            for (int h = 0; h < 2; ++h)
#pragma unroll
                for (int i = 0; i < 2; ++i) { sA[h][i] = (Sched::VARA && last) ? nOA[h][i] : oA[h][i]; sB[h][i] = (Sched::VARB && last) ? nOB[h][i] : oB[h][i]; }
            PG8_LDB(B0, 0, 0); PG8_LDB(B1, 0, 1); PG8_SCHED; PG8_LDA(At, 0, 0); PG8_STAGE_A(PG8_SA(1, 1), a1, oA, 1);
            PG8_WAIT_V(8); PG8_WAIT_L(0); PG8_BAR; PG8_MMA(0, 0, At, B0); PG8_MMA(0, 1, At, B1); PG8_BAR; PG8_SCHED;
            PG8_LDA(At, 0, 1); PG8_STAGE_B(PG8_SB(0, 0), b2, sB, 0); PG8_STAGE_B(PG8_SB(0, 1), b2, sB, 1); PG8_STAGE_A(PG8_SA(0, 0), a2, sA, 0);
            PG8_WAIT_V(8); PG8_WAIT_L(0); PG8_BAR; PG8_MMA(1, 0, At, B0); PG8_MMA(1, 1, At, B1); PG8_BAR; PG8_SCHED;
            PG8_LDB(B0, 1, 0); PG8_LDB(B1, 1, 1); PG8_SCHED; PG8_LDA(At, 1, 0); PG8_STAGE_A(PG8_SA(0, 1), a2, sA, 1);
            PG8_WAIT_V(8); PG8_WAIT_L(0); PG8_BAR; PG8_MMA(0, 0, At, B0); PG8_MMA(0, 1, At, B1); PG8_BAR; PG8_SCHED;
            PG8_LDA(At, 1, 1); PG8_STAGE_B(PG8_SB(1, 0), b3, sB, 0); PG8_STAGE_B(PG8_SB(1, 1), b3, sB, 1); PG8_STAGE_A(PG8_SA(1, 0), a3, sA, 0);
            PG8_WAIT_V(8); PG8_WAIT_L(0); PG8_BAR; PG8_MMA(1, 0, At, B0); PG8_MMA(1, 1, At, B1); PG8_BAR; PG8_SCHED;
        }
        if (wr == 0) PG8_BAR;
        E(acc, cur, wr, wc, fr, fq);
        if (!has_next) break;
#pragma unroll
        for (int a = 0; a < 2; ++a)
#pragma unroll
            for (int b = 0; b < 2; ++b)
#pragma unroll
                for (int m = 0; m < 4; ++m)
#pragma unroll
                    for (int n = 0; n < 2; ++n) acc[a][b][m][n] = acc_t{};
        cur = nxt; cA = nA; cB = nB; ++ui;
#pragma unroll
        for (int h = 0; h < 2; ++h)
#pragma unroll
            for (int i = 0; i < 2; ++i) { oA[h][i] = nOA[h][i]; oB[h][i] = nOB[h][i]; }
        if (wr == 1) PG8_BAR;
    }
    PG8_WAIT_V(0);
    PG8_BAR;
#undef PG8_SA
#undef PG8_SB
#undef PG8_STAGE_A
#undef PG8_STAGE_B
#ifdef PG8_GLDS
#undef PG8_GLDS
#endif
#undef PG8_LDA
#undef PG8_LDB
#undef PG8_MMA
#undef PG8_WAIT_V
#undef PG8_WAIT_L
#undef PG8_BAR
#undef PG8_SCHED
}
}
using pg8::UnitPN;

struct F1Order {
    typedef UnitPN Unit; static constexpr bool VARA = false, VARB = false;
    const char* A; const char* B; int G, c;
    __device__ __forceinline__ bool next(int i, Unit& u) const { const int L = i * G + c; if (L >= 1024) return false; u.pn = L >> 2; u.pm = L & 3; return true; }
    __device__ __forceinline__ const char* baseA(const Unit& u) const { return A + (size_t)u.pm * 256 * 2048; }
    __device__ __forceinline__ const char* baseB(const Unit& u) const { return B + ((size_t)(u.pn >> 5) * 8192 + 2 * (u.pn & 31)) * 2048; }
    __device__ __forceinline__ unsigned hstepA() const { return 128u * 2048u; }
    __device__ __forceinline__ unsigned hstepB() const { return 2048u; }
    __device__ __forceinline__ size_t koffA(int t) const { return (size_t)t * 128; }
    __device__ __forceinline__ void offA(const Unit&, const int (&R)[2], const int (&C)[2], unsigned (&o)[2][2]) const {
#pragma unroll
        for (int h = 0; h < 2; ++h)
#pragma unroll
            for (int i = 0; i < 2; ++i) o[h][i] = (unsigned)((h * 128 + R[i]) * 1024 + C[i]) * 2u; }
    __device__ __forceinline__ void offB(const Unit&, const int (&R)[2], const int (&C)[2], unsigned (&o)[2][2]) const {
#pragma unroll
        for (int h = 0; h < 2; ++h)
#pragma unroll
            for (int i = 0; i < 2; ++i) o[h][i] = (unsigned)((h + 64 * R[i]) * 1024 + C[i]) * 2u; }
};
struct FBOrder {
    typedef UnitPN Unit; static constexpr bool VARA = false, VARB = false;
    const char* A; const char* B; int G, c;
    __device__ __forceinline__ bool next(int i, Unit& u) const { const int L = i * G + c; if (L >= 1024) return false; u.pm = L >> 4; u.pn = L & 15; return true; }
    __device__ __forceinline__ const char* baseA(const Unit& u) const { return A + (size_t)u.pm * 65536; }
    __device__ __forceinline__ const char* baseB(const Unit& u) const { return B + ((size_t)u.pm * 4096 + (size_t)u.pn * 256) * 512; }
    __device__ __forceinline__ unsigned hstepA() const { return 0u; }
    __device__ __forceinline__ unsigned hstepB() const { return 128u * 512u; }
    __device__ __forceinline__ size_t koffA(int t) const { return (size_t)t * 128; }
    __device__ __forceinline__ void offA(const Unit&, const int (&R)[2], const int (&C)[2], unsigned (&o)[2][2]) const {
#pragma unroll
        for (int h = 0; h < 2; ++h)
#pragma unroll
            for (int i = 0; i < 2; ++i) o[h][i] = (unsigned)(R[i] * 256 + C[i]) * 2u; }
    __device__ __forceinline__ void offB(const Unit&, const int (&R)[2], const int (&C)[2], unsigned (&o)[2][2]) const {
#pragma unroll
        for (int h = 0; h < 2; ++h)
#pragma unroll
            for (int i = 0; i < 2; ++i) o[h][i] = (unsigned)((h * 128 + R[i]) * 256 + C[i]) * 2u; }
};
struct MergeOrder {
    typedef UnitPN Unit; static constexpr bool VARA = false, VARB = false;
    const char* A; const char* A2; const char* B; int G, c;
    __device__ __forceinline__ bool next(int i, Unit& u) const { return pg8::static_next(i, G, c, T / 256, 4, u.pm, u.pn); }
    __device__ __forceinline__ const char* baseA(const Unit& u) const { return A + (size_t)u.pm * 256 * 1024; }
    __device__ __forceinline__ const char* baseB(const Unit& u) const { return B + (size_t)u.pn * 256 * 2048; }
    __device__ __forceinline__ unsigned hstepA() const { return 128u * 1024u; }
    __device__ __forceinline__ unsigned hstepB() const { return 128u * 2048u; }
    __device__ __forceinline__ size_t koffA(int t) const { return t < 8 ? (size_t)t * 128 : (size_t)(A2 - A) + (size_t)(t - 8) * 128; }
    __device__ __forceinline__ void offA(const Unit&, const int (&R)[2], const int (&C)[2], unsigned (&o)[2][2]) const {
#pragma unroll
        for (int h = 0; h < 2; ++h)
#pragma unroll
            for (int i = 0; i < 2; ++i) o[h][i] = (unsigned)((h * 128 + R[i]) * 512 + C[i]) * 2u; }
    __device__ __forceinline__ void offB(const Unit&, const int (&R)[2], const int (&C)[2], unsigned (&o)[2][2]) const {
#pragma unroll
        for (int h = 0; h < 2; ++h)
#pragma unroll
            for (int i = 0; i < 2; ++i) o[h][i] = (unsigned)((h * 128 + R[i]) * 1024 + C[i]) * 2u; }
};
struct F1Order8 {
    typedef UnitPN Unit; static constexpr bool VARA = false, VARB = false;
    const char* A; const char* B; int G, c;
    __device__ __forceinline__ bool next(int i, Unit& u) const { const int L = i * G + c; if (L >= 1024) return false; u.pn = L >> 2; u.pm = L & 3; return true; }
    __device__ __forceinline__ const char* baseA(const Unit& u) const { return A + (size_t)u.pm * 256 * 1024; }
    __device__ __forceinline__ const char* baseB(const Unit& u) const { return B + ((size_t)(u.pn >> 5) * 8192 + 2 * (u.pn & 31)) * 1024; }
    __device__ __forceinline__ unsigned hstepA() const { return 128u * 1024u; }
    __device__ __forceinline__ unsigned hstepB() const { return 1024u; }
    __device__ __forceinline__ size_t koffA(int t) const { return (size_t)t * 128; }
    __device__ __forceinline__ void offA(const Unit&, const int (&R)[2], const int (&C)[2], unsigned (&o)[2][2]) const {
#pragma unroll
        for (int h = 0; h < 2; ++h)
#pragma unroll
            for (int i = 0; i < 2; ++i) o[h][i] = (unsigned)((h * 128 + R[i]) * 1024 + C[i] * 2); }
    __device__ __forceinline__ void offB(const Unit&, const int (&R)[2], const int (&C)[2], unsigned (&o)[2][2]) const {
#pragma unroll
        for (int h = 0; h < 2; ++h)
#pragma unroll
            for (int i = 0; i < 2; ++i) o[h][i] = (unsigned)((h + 64 * R[i]) * 1024 + C[i] * 2); }
};
struct MoeUnit { int e, row0, cnt, orow, pn; };
template <int NPN> __device__ __forceinline__ bool moe_next(int i, int G, int c, const LAS int* tst, const LAS int* cntl, MoeUnit& u) {
    const int L = i * G + c; const int tile = L / NPN; const int total = __builtin_amdgcn_readfirstlane(tst[32]);
    if (tile >= total) return false;
    const LAS unsigned char* texp = (const LAS unsigned char*)(tst + 40);
    const int e = __builtin_amdgcn_readfirstlane((int)texp[tile]);
    u.e = e; u.row0 = (tile - __builtin_amdgcn_readfirstlane(tst[e])) * 256; u.cnt = __builtin_amdgcn_readfirstlane(cntl[e]); u.orow = tile * 256; u.pn = L % NPN; return true;
}
struct MoeUpOrder {
    typedef MoeUnit Unit; static constexpr bool VARA = true, VARB = false;
    const char* A; const char* B; const u32x2* list; const LAS int* tst; const LAS int* cntl; int G, c;
    __device__ __forceinline__ bool next(int i, Unit& u) const { return moe_next<2>(i, G, c, tst, cntl, u); }
    __device__ __forceinline__ const char* baseA(const Unit&) const { return A; }
    __device__ __forceinline__ const char* baseB(const Unit& u) const { return B + ((size_t)u.e * 512 + (size_t)u.pn * 256) * 2048; }
    __device__ __forceinline__ unsigned hstepA() const { return 0u; }
    __device__ __forceinline__ unsigned hstepB() const { return 128u * 2048u; }
    __device__ __forceinline__ size_t koffA(int t) const { return (size_t)t * 128; }
    __device__ __forceinline__ void offA(const Unit& u, const int (&R)[2], const int (&C)[2], unsigned (&o)[2][2]) const {
#pragma unroll
        for (int h = 0; h < 2; ++h)
#pragma unroll
            for (int i = 0; i < 2; ++i) { const int li = u.row0 + h * 128 + R[i]; const int tok = (li < u.cnt) ? (int)(list[(size_t)u.e * 65536 + li].x & 0x7fffffffu) : 0; o[h][i] = (unsigned)tok * 2048u + (unsigned)C[i] * 2u; } }
    __device__ __forceinline__ void offB(const Unit&, const int (&R)[2], const int (&C)[2], unsigned (&o)[2][2]) const {
#pragma unroll
        for (int h = 0; h < 2; ++h)
#pragma unroll
            for (int i = 0; i < 2; ++i) o[h][i] = (unsigned)((h * 128 + R[i]) * 1024 + C[i]) * 2u; }
};
struct MoeUpOrder8 {
    typedef MoeUnit Unit; static constexpr bool VARA = true, VARB = false;
    const char* A; const char* B; const u32x2* list; const LAS int* tst; const LAS int* cntl; int G, c;
    __device__ __forceinline__ bool next(int i, Unit& u) const { return moe_next<2>(i, G, c, tst, cntl, u); }
    __device__ __forceinline__ const char* baseA(const Unit&) const { return A; }
    __device__ __forceinline__ const char* baseB(const Unit& u) const { return B + ((size_t)u.e * 512 + (size_t)u.pn * 256) * 1024; }
    __device__ __forceinline__ unsigned hstepA() const { return 0u; }
    __device__ __forceinline__ unsigned hstepB() const { return 128u * 1024u; }
    __device__ __forceinline__ size_t koffA(int t) const { return (size_t)t * 128; }
    __device__ __forceinline__ void offA(const Unit& u, const int (&R)[2], const int (&C)[2], unsigned (&o)[2][2]) const {
#pragma unroll
        for (int h = 0; h < 2; ++h)
#pragma unroll
            for (int i = 0; i < 2; ++i) { const int li = u.row0 + h * 128 + R[i]; const int tok = (li < u.cnt) ? (int)(list[(size_t)u.e * 65536 + li].x & 0x7fffffffu) : 0; o[h][i] = (unsigned)tok * 1024u + (unsigned)C[i] * 2u; } }
    __device__ __forceinline__ void offB(const Unit&, const int (&R)[2], const int (&C)[2], unsigned (&o)[2][2]) const {
#pragma unroll
        for (int h = 0; h < 2; ++h)
#pragma unroll
            for (int i = 0; i < 2; ++i) o[h][i] = (unsigned)((h * 128 + R[i]) * 1024 + C[i] * 2); }
};
struct MoeDownOrder {
    typedef MoeUnit Unit; static constexpr bool VARA = false, VARB = false;
    const char* A; const char* B; const LAS int* tst; const LAS int* cntl; int G, c;
    __device__ __forceinline__ bool next(int i, Unit& u) const { return moe_next<4>(i, G, c, tst, cntl, u); }
    __device__ __forceinline__ const char* baseA(const Unit& u) const { return A + (size_t)u.orow * 512; }
    __device__ __forceinline__ const char* baseB(const Unit& u) const { return B + ((size_t)u.e * 1024 + (size_t)u.pn * 256) * 512; }
    __device__ __forceinline__ unsigned hstepA() const { return 128u * 512u; }
    __device__ __forceinline__ unsigned hstepB() const { return 128u * 512u; }
    __device__ __forceinline__ size_t koffA(int t) const { return (size_t)t * 128; }
    __device__ __forceinline__ void offA(const Unit&, const int (&R)[2], const int (&C)[2], unsigned (&o)[2][2]) const {
#pragma unroll
        for (int h = 0; h < 2; ++h)
#pragma unroll
            for (int i = 0; i < 2; ++i) o[h][i] = (unsigned)((h * 128 + R[i]) * 256 + C[i]) * 2u; }
    __device__ __forceinline__ void offB(const Unit& u, const int (&R)[2], const int (&C)[2], unsigned (&o)[2][2]) const { offA(u, R, C, o); }
};

typedef const f32x4 (&AccRef)[2][2][4][2];
#ifdef EPI_NT_STORES
#define EPI_ST(TY, P, V) __builtin_nontemporal_store((V), (TY*)(P))
#else
#define EPI_ST(TY, P, V) (*(TY*)(P) = (V))
#endif
#ifndef EPI_FENCE
#define EPI_FENCE do { } while (0)
#endif
#define EPI_LOOP_AM _Pragma("unroll") for (int ai = 0; ai < 2; ++ai) _Pragma("unroll") for (int m = 0; m < 4; ++m)

__device__ __forceinline__ unsigned q8(float x) { return (unsigned)(sigmoidf_(x) * 255.0f + 0.5f); }
__device__ __forceinline__ size_t gate_off(int pm, int which, int pn4, int wave, int ai, int bj, int m, int lane) { return ((((size_t)(pm * 2 + which) * 4 + pn4) * 8 + wave) * 16 + (ai * 2 + bj) * 4 + m) * 512 + lane * 8; }
struct EpiZ {
    static constexpr bool PERM = true, MIDK = false, I8 = false;
    bf16_t* __restrict__ QL; bf16_t* __restrict__ KVL; float* __restrict__ SSQQ; float* __restrict__ SSQKV; unsigned char* __restrict__ GATE; const float* __restrict__ bg; bf16_t* __restrict__ KB; const float* __restrict__ RC; const float* __restrict__ RS;
    __device__ __forceinline__ void operator()(AccRef acc, const UnitPN& u, int wr, int wc, int fr, int fq) const {
        const int row0 = u.pm * 256 + wr * 64 + fr, c0 = wc * 32 + 8 * fq;
        if (u.pn < 2) {
            bf16_t* O = u.pn ? KVL : QL; float* SS = u.pn ? SSQKV : SSQQ;
            EPI_LOOP_AM { const int row = row0 + ai * 128 + m * 16; float s = 0.f;
#pragma unroll
                for (int bj = 0; bj < 2; ++bj) { const f32x4 v0 = acc[ai][bj][m][0], v1 = acc[ai][bj][m][1];
                    s += (v0[0] * v0[0] + v0[1] * v0[1]) + (v0[2] * v0[2] + v0[3] * v0[3]) + (v1[0] * v1[0] + v1[1] * v1[1]) + (v1[2] * v1[2] + v1[3] * v1[3]);
                    EPI_ST(u32x4, O + (size_t)row * 256 + bj * 128 + c0, pack8(v0, v1)); }
                s += __shfl_xor(s, 16); s += __shfl_xor(s, 32);
                if (fq == 0) SS[(size_t)row * 4 + wc] = s; }
        } else if (u.pn < 10) {
            const int gc0 = (u.pn - 2) * 256 + c0;
            f32x4 bv[2][2];
#pragma unroll
            for (int bj = 0; bj < 2; ++bj)
#pragma unroll
                for (int n = 0; n < 2; ++n) bv[bj][n] = *(const f32x4*)(bg + gc0 + bj * 128 + 4 * n);
            EPI_LOOP_AM { const int row = row0 + ai * 128 + m * 16;
#pragma unroll
                for (int bj = 0; bj < 2; ++bj) { const f32x4 v0 = acc[ai][bj][m][0] + bv[bj][0], v1 = acc[ai][bj][m][1] + bv[bj][1];
                    u32x2 w;
                    w.x = q8(v0[0]) | (q8(v0[1]) << 8) | (q8(v0[2]) << 16) | (q8(v0[3]) << 24); w.y = q8(v1[0]) | (q8(v1[1]) << 8) | (q8(v1[2]) << 16) | (q8(v1[3]) << 24);
                    EPI_ST(u32x2, GATE + (size_t)row * 2048 + gc0 + bj * 128, w); }
                EPI_FENCE; }
        } else if (wc == 0) {
            f32x4 cs[2][4], sn[2][4];
            EPI_LOOP_AM { const int row = row0 + ai * 128 + m * 16; cs[ai][m] = *(const f32x4*)(RC + (size_t)row * 16 + 4 * fq); sn[ai][m] = *(const f32x4*)(RS + (size_t)row * 16 + 4 * fq); }
            EPI_LOOP_AM { const int row = row0 + ai * 128 + m * 16; const int b = row >> 13, s = row & 8191;
                const f32x4 x1 = acc[ai][0][m][0], x2 = acc[ai][0][m][1];
                const u32x2 p1 = pack4(x1 * cs[ai][m] - x2 * sn[ai][m]), p2 = pack4(x2 * cs[ai][m] + x1 * sn[ai][m]);
#pragma unroll
                for (int h = 0; h < 8; ++h) { bf16_t* kp = KB + (((size_t)(b * 8 + h) * 128 + (s >> 6)) * 12 + 8 + (fq >> 1)) * 512 + (s & 63) * 8 + 4 * (fq & 1); *(u32x2*)kp = p1; EPI_ST(u32x2, kp + 1024, p2); } }
        }
    }
};
struct EpiF1 {
    static constexpr bool PERM = true, MIDK = false, I8 = false;
    bf16_t* YT2;
    __device__ __forceinline__ void operator()(AccRef acc, const UnitPN& u, int wr, int wc, int fr, int fq) const {
        const int b = u.pn >> 5, tt = u.pn & 31;
        EPI_LOOP_AM { const int r = u.pm * 256 + ai * 128 + wr * 64 + m * 16 + fr; const int ri = r >> 9, gc = r & 511;
#pragma unroll
            for (int bj = 0; bj < 2; ++bj) { const int sa = 2 * tt + bj, sb = wc * 32 + 8 * fq;
                EPI_ST(u32x4, YT2 + ((((size_t)b * 512 + gc) * 64 + sa) * 2 + ri) * 128 + sb, pack8(acc[ai][bj][m][0], acc[ai][bj][m][1])); } }
    }
};
struct EpiFA {
    static constexpr bool PERM = true, MIDK = false, I8 = false;
    bf16_t* Z;
    __device__ __forceinline__ void operator()(AccRef acc, const UnitPN& u, int wr, int wc, int fr, int fq) const {
        EPI_LOOP_AM { const int kb = wr * 64 + m * 16 + fr;
#pragma unroll
            for (int bj = 0; bj < 2; ++bj) { const int gcb = u.pn * 4 + bj * 2 + (wc >> 1), sa = 32 * (wc & 1) + 8 * fq;
                EPI_ST(u32x4, Z + (((((size_t)(kb >> 1) * 4096 + gcb) * 2 + (kb & 1)) * 2 + ai) * 64 + sa), pack8(acc[ai][bj][m][0], acc[ai][bj][m][1])); } }
    }
};
struct EpiFB {
    static constexpr bool PERM = true, MIDK = false, I8 = false;
    bf16_t* FO;
    __device__ __forceinline__ void operator()(AccRef acc, const UnitPN& u, int wr, int wc, int fr, int fq) const {
        const int b = u.pn >> 1;
#pragma unroll
        for (int m = 0; m < 4; ++m) { const int ka = m * 16 + fr, s = 2 * u.pm + wr + 128 * ka;
#pragma unroll
            for (int bj = 0; bj < 2; ++bj) { const int gc = (u.pn & 1) * 256 + bj * 128 + wc * 32 + 8 * fq;
                EPI_ST(u32x4, FO + ((size_t)b * 8192 + s) * 512 + gc, pack8(acc[0][bj][m][0], acc[0][bj][m][1])); } }
    }
};
struct EpiQ {
    static constexpr bool PERM = true, MIDK = false, I8 = false;
    bf16_t* __restrict__ Q; const float* __restrict__ SSQ; const float* __restrict__ RC; const float* __restrict__ RS;
    __device__ __forceinline__ void operator()(AccRef acc, const UnitPN& u, int wr, int wc, int fr, int fq) const {
        const int g0 = u.pn * 8 + wc, g1 = g0 + 4; const bool rope = (g0 % 3 == 2) || (g1 % 3 == 2);
#pragma unroll
        for (int ai = 0; ai < 2; ++ai) {
            f32x4 sq[4], cs[4], sn[4];
#pragma unroll
            for (int m = 0; m < 4; ++m) { const int row = u.pm * 256 + ai * 128 + wr * 64 + m * 16 + fr; sq[m] = *(const f32x4*)(SSQ + (size_t)row * 4);
                if (rope) { cs[m] = *(const f32x4*)(RC + (size_t)row * 16 + 4 * fq); sn[m] = *(const f32x4*)(RS + (size_t)row * 16 + 4 * fq); } else { cs[m] = sq[m]; sn[m] = sq[m]; } }
#pragma unroll
            for (int m = 0; m < 4; ++m) { const int row = u.pm * 256 + ai * 128 + wr * 64 + m * 16 + fr;
                const float rs = C2 * __builtin_amdgcn_rsqf(((sq[m][0] + sq[m][1]) + (sq[m][2] + sq[m][3])) * (1.0f / 256.0f) + EPS);
#pragma unroll
                for (int bj = 0; bj < 2; ++bj) { const int g32 = u.pn * 8 + bj * 4 + wc; const int hh = g32 / 3, part = g32 - 3 * hh;
                    const f32x4 v0 = acc[ai][bj][m][0] * rs, v1 = acc[ai][bj][m][1] * rs;
                    if (part < 2) { EPI_ST(u32x4, Q + (size_t)row * QC + g32 * 32 + 8 * fq, pack8(v0, v1)); }
                    else { bf16_t* qp = Q + (size_t)row * QC + hh * 96 + 64 + 4 * fq;
                        *(u32x2*)qp = pack4(v0 * cs[m] - v1 * sn[m]); EPI_ST(u32x2, qp + 16, pack4(v1 * cs[m] + v0 * sn[m])); } } }
        }
    }
};
struct EpiKV {
    static constexpr bool PERM = true, MIDK = false, I8 = false;
    bf16_t* __restrict__ KB; bf16_t* __restrict__ VB; const float* __restrict__ SSQ;
    __device__ __forceinline__ void operator()(AccRef acc, const UnitPN& u, int wr, int wc, int fr, int fq) const {
        f32x4 sq[2][4];
        EPI_LOOP_AM { const int row = u.pm * 256 + ai * 128 + wr * 64 + m * 16 + fr; sq[ai][m] = *(const f32x4*)(SSQ + (size_t)row * 4); }
        EPI_LOOP_AM { const int row = u.pm * 256 + ai * 128 + wr * 64 + m * 16 + fr; const int b = row >> 13, s = row & 8191;
            const float rs = __builtin_amdgcn_rsqf(((sq[ai][m][0] + sq[ai][m][1]) + (sq[ai][m][2] + sq[ai][m][3])) * (1.0f / 256.0f) + EPS);
#pragma unroll
            for (int bj = 0; bj < 2; ++bj) { const int c = (u.pn & 1) * 256 + bj * 128 + wc * 32 + 8 * fq; const int hh = c >> 6, d = c & 63;
                const u32x4 w = pack8(acc[ai][bj][m][0] * rs, acc[ai][bj][m][1] * rs);
                if (u.pn < 2) EPI_ST(u32x4, KB + (((size_t)(b * 8 + hh) * 128 + (s >> 6)) * 12 + (d >> 3)) * 512 + (s & 63) * 8, w);
                else EPI_ST(u32x4, VB + (((size_t)(b * 8 + hh) * 128 + (s >> 6)) * 8 + (d >> 5) * 4 + ((s & 63) >> 4)) * 512 + (s & 15) * 32 + (d & 31), w); } }
    }
};
struct EpiMerge2 {
    static constexpr bool PERM = true, MIDK = true, I8 = false;
    bf16_t* __restrict__ MRG; const unsigned char* __restrict__ GATE;
    __device__ __forceinline__ void mid(f32x4 (&acc)[2][2][4][2], const UnitPN& u, int wr, int wc, int fr, int fq) const {
#pragma unroll
        for (int ai = 0; ai < 2; ++ai) {
            u32x2 ga[4][2], gf[4][2];
#pragma unroll
            for (int m = 0; m < 4; ++m)
#pragma unroll
                for (int bj = 0; bj < 2; ++bj) { ga[m][bj] = *(const u32x2*)(GATE + gate_off(u.pm, 0, u.pn, wr * 4 + wc, ai, bj, m, fq * 16 + fr)); gf[m][bj] = *(const u32x2*)(GATE + gate_off(u.pm, 1, u.pn, wr * 4 + wc, ai, bj, m, fq * 16 + fr)); }
#pragma unroll
            for (int m = 0; m < 4; ++m)
#pragma unroll
                for (int bj = 0; bj < 2; ++bj) { const u32x2 a = ga[m][bj], f = gf[m][bj];
#pragma unroll
                    for (int j = 0; j < 4; ++j) { const float fa0 = (float)((a.x >> (8 * j)) & 0xffu), fa1 = (float)((a.y >> (8 * j)) & 0xffu);
                        const float ff0 = fmaxf((float)((f.x >> (8 * j)) & 0xffu), 1.0f), ff1 = fmaxf((float)((f.y >> (8 * j)) & 0xffu), 1.0f);
                        acc[ai][bj][m][0][j] *= fa0 * __builtin_amdgcn_rcpf(ff0); acc[ai][bj][m][1][j] *= fa1 * __builtin_amdgcn_rcpf(ff1); } }
        }
    }
    __device__ __forceinline__ void operator()(AccRef acc, const UnitPN& u, int wr, int wc, int fr, int fq) const {
#pragma unroll
        for (int ai = 0; ai < 2; ++ai) {
            u32x2 gf[4][2];
#pragma unroll
            for (int m = 0; m < 4; ++m)
#pragma unroll
                for (int bj = 0; bj < 2; ++bj) gf[m][bj] = *(const u32x2*)(GATE + gate_off(u.pm, 1, u.pn, wr * 4 + wc, ai, bj, m, fq * 16 + fr));
#pragma unroll
            for (int m = 0; m < 4; ++m)
#pragma unroll
                for (int bj = 0; bj < 2; ++bj) { const int row = u.pm * 256 + ai * 128 + wr * 64 + m * 16 + fr, col = u.pn * 256 + bj * 128 + wc * 32 + 8 * fq; const u32x2 f = gf[m][bj];
                    f32x4 v0 = acc[ai][bj][m][0] * (1.0f / 255.0f), v1 = acc[ai][bj][m][1] * (1.0f / 255.0f);
#pragma unroll
                    for (int j = 0; j < 4; ++j) { v0[j] *= fmaxf((float)((f.x >> (8 * j)) & 0xffu), 1.0f); v1[j] *= fmaxf((float)((f.y >> (8 * j)) & 0xffu), 1.0f); }
                    EPI_ST(u32x4, MRG + (size_t)row * 1024 + col, pack8(v0, v1)); }
        }
    }
};
struct EpiH {
    static constexpr bool PERM = true, MIDK = false, I8 = false;
    const float* __restrict__ X; bf16_t* __restrict__ Hout; const float* __restrict__ MODF;
    __device__ __forceinline__ void operator()(AccRef acc, const UnitPN& u, int wr, int wc, int fr, int fq) const {
        const int b = u.pm >> 5; const int col0 = u.pn * 256 + wc * 32 + 8 * fq;
        f32x4 gt[2][2];
#pragma unroll
        for (int bj = 0; bj < 2; ++bj)
#pragma unroll
            for (int n = 0; n < 2; ++n) gt[bj][n] = *(const f32x4*)(MODF + (size_t)b * 8192 + 2048 + col0 + bj * 128 + n * 4);
#pragma unroll
        for (int ai = 0; ai < 2; ++ai)
#pragma unroll
            for (int mp = 0; mp < 2; ++mp) {
                f32x4 xv[2][2][2];
#pragma unroll
                for (int mm = 0; mm < 2; ++mm)
#pragma unroll
                    for (int bj = 0; bj < 2; ++bj) { const size_t off = (size_t)(u.pm * 256 + ai * 128 + wr * 64 + (2 * mp + mm) * 16 + fr) * 1024 + col0;
                        xv[mm][bj][0] = *(const f32x4*)(X + off + bj * 128); xv[mm][bj][1] = *(const f32x4*)(X + off + bj * 128 + 4); }
#pragma unroll
                for (int mm = 0; mm < 2; ++mm)
#pragma unroll
                    for (int bj = 0; bj < 2; ++bj) { const int m = 2 * mp + mm; const size_t off = (size_t)(u.pm * 256 + ai * 128 + wr * 64 + m * 16 + fr) * 1024 + col0;
                        EPI_ST(u32x4, Hout + off + bj * 128, pack8(xv[mm][bj][0] + gt[bj][0] * acc[ai][bj][m][0], xv[mm][bj][1] + gt[bj][1] * acc[ai][bj][m][1])); }
            }
    }
};
struct EpiUp {
    static constexpr bool PERM = true, MIDK = false, I8 = false;
    bf16_t* HID;
    __device__ __forceinline__ void operator()(AccRef acc, const MoeUnit& u, int wr, int wc, int fr, int fq) const {
        EPI_LOOP_AM { const int lr = ai * 128 + wr * 64 + m * 16 + fr;
#pragma unroll
            for (int bj = 0; bj < 2; ++bj) { const int hh = u.pn * 128 + bj * 64 + wc * 16 + 4 * fq;
                const f32x4 g = acc[ai][bj][m][0], uu = acc[ai][bj][m][1]; f32x4 o;
#pragma unroll
                for (int j = 0; j < 4; ++j) o[j] = g[j] * sigmoidf_(g[j]) * uu[j];
                EPI_ST(u32x2, HID + (size_t)(u.orow + lr) * 256 + hh, pack4(o)); } }
    }
};
struct EpiDown {
    static constexpr bool PERM = true, MIDK = false, I8 = false;
    bf16_t* __restrict__ Y2;
    __device__ __forceinline__ void operator()(AccRef acc, const MoeUnit& u, int wr, int wc, int fr, int fq) const {
        EPI_LOOP_AM { const size_t row = (size_t)u.orow + ai * 128 + wr * 64 + m * 16 + fr;
#pragma unroll
            for (int bj = 0; bj < 2; ++bj) { const int col = u.pn * 256 + bj * 128 + wc * 32 + 8 * fq;
                EPI_ST(u32x4, Y2 + row * 1024 + col, pack8(acc[ai][bj][m][0], acc[ai][bj][m][1])); } }
    }
};

#ifdef PROBE_KLOOP
struct EpiNull {
    static constexpr bool PERM = true, MIDK = false, I8 = false;
    float* sink; int never;
    __device__ __forceinline__ void operator()(AccRef acc, const UnitPN& u, int wr, int wc, int fr, int fq) const {
        if (never < 0) { f32x4 s = acc[0][0][0][0];
            EPI_LOOP_AM { s += acc[ai][0][m][0] + acc[ai][0][m][1] + acc[ai][1][m][0] + acc[ai][1][m][1]; }
            *(f32x4*)(sink + fr) = s; }
    }
};
#endif

typedef const i32x4 (&AccRefI)[2][2][4][2];
__device__ __forceinline__ f32x4 i2f(const i32x4 v, float s) { return (f32x4){(float)v[0] * s, (float)v[1] * s, (float)v[2] * s, (float)v[3] * s}; }
struct EpiZ8 {
    static constexpr bool PERM = true, MIDK = false, I8 = true;
    unsigned char* __restrict__ ws; const float* __restrict__ bg;
    __device__ __forceinline__ void operator()(AccRefI acc, const UnitPN& u, int wr, int wc, int fr_, int fq_) const {
        int fr = fr_, fq = fq_; asm volatile("" : "+v"(fr), "+v"(fq));
        const int row0 = u.pm * 256 + wr * 64 + fr, c0 = wc * 32 + 8 * fq;
        const float* SU = (const float*)(ws + WS_SU);
        const float sw = __uint_as_float(((const unsigned*)(ws + WS_CTL))[CW_WMAX]) * (1.0f / 127.0f);
        if (u.pn < 2) {
            bf16_t* O = (bf16_t*)(ws + (u.pn ? WS_KVL : WS_QL)); float* SS = (float*)(ws + (u.pn ? WS_SSQKV : WS_SSQQ));
            EPI_LOOP_AM { const int row = row0 + ai * 128 + m * 16; float s = 0.f; const float su_ = SU[row] * sw;
#pragma unroll
                for (int bj = 0; bj < 2; ++bj) { const f32x4 v0 = i2f(acc[ai][bj][m][0], su_), v1 = i2f(acc[ai][bj][m][1], su_);
                    s += (v0[0] * v0[0] + v0[1] * v0[1]) + (v0[2] * v0[2] + v0[3] * v0[3]) + (v1[0] * v1[0] + v1[1] * v1[1]) + (v1[2] * v1[2] + v1[3] * v1[3]);
                    EPI_ST(u32x4, O + (size_t)row * 256 + bj * 128 + c0, pack8(v0, v1)); }
                s += __shfl_xor(s, 16); s += __shfl_xor(s, 32);
                if (fq == 0) SS[(size_t)row * 4 + wc] = s; }
        } else if (u.pn < 10) {
            const int gc0 = (u.pn - 2) * 256 + c0;
#pragma unroll
            for (int bj = 0; bj < 2; ++bj) {
                const f32x4 bv0 = *(const f32x4*)(bg + gc0 + bj * 128), bv1 = *(const f32x4*)(bg + gc0 + bj * 128 + 4);
                EPI_LOOP_AM { const int row = row0 + ai * 128 + m * 16; const float su_ = SU[row] * sw;
                    const f32x4 v0 = i2f(acc[ai][bj][m][0], su_) + bv0, v1 = i2f(acc[ai][bj][m][1], su_) + bv1;
                    u32x2 w;
                    w.x = q8(v0[0]) | (q8(v0[1]) << 8) | (q8(v0[2]) << 16) | (q8(v0[3]) << 24); w.y = q8(v1[0]) | (q8(v1[1]) << 8) | (q8(v1[2]) << 16) | (q8(v1[3]) << 24);
                    EPI_ST(u32x2, ws + WS_GATE + gate_off(u.pm, (u.pn - 2) >> 2, (u.pn - 2) & 3, wr * 4 + wc, ai, bj, m, fq * 16 + fr), w); }
            }
        } else if (wc == 0) {
            f32x4 cs[2][4], sn[2][4];
            EPI_LOOP_AM { const int row = row0 + ai * 128 + m * 16; cs[ai][m] = *(const f32x4*)((const float*)(ws + WS_ROPEC) + (size_t)row * 16 + 4 * fq); sn[ai][m] = *(const f32x4*)((const float*)(ws + WS_ROPES) + (size_t)row * 16 + 4 * fq); }
            EPI_LOOP_AM { const int row = row0 + ai * 128 + m * 16; const int b = row >> 13, s = row & 8191; const float su_ = SU[row] * sw;
                const f32x4 x1 = i2f(acc[ai][0][m][0], su_), x2 = i2f(acc[ai][0][m][1], su_);
                const u32x2 p1 = pack4(x1 * cs[ai][m] - x2 * sn[ai][m]), p2 = pack4(x2 * cs[ai][m] + x1 * sn[ai][m]);
#pragma unroll
                for (int h = 0; h < 8; ++h) { bf16_t* kp = (bf16_t*)(ws + WS_K) + (((size_t)(b * 8 + h) * 128 + (s >> 6)) * 12 + 8 + (fq >> 1)) * 512 + (s & 63) * 8 + 4 * (fq & 1); EPI_ST(u32x2, kp, p1); EPI_ST(u32x2, kp + 1024, p2); } }
        }
    }
};
struct EpiF18 {
    static constexpr bool PERM = true, MIDK = false, I8 = true;
    unsigned char* __restrict__ ws;
    __device__ __forceinline__ void operator()(AccRefI acc, const UnitPN& u, int wr, int wc, int fr, int fq) const {
        const int b = u.pn >> 5, tt = u.pn & 31;
        const float* SU = (const float*)(ws + WS_SU); bf16_t* YT2 = (bf16_t*)(ws + WS_YT2);
        const float sw = __uint_as_float(((const unsigned*)(ws + WS_CTL))[CW_WMAX + 1]) * (1.0f / 127.0f);
#pragma unroll
        for (int bj = 0; bj < 2; ++bj) {
            float sc[8];
#pragma unroll
            for (int i = 0; i < 8; ++i) sc[i] = SU[(size_t)b * 8192 + (2 * tt + bj) + 64 * (wc * 32 + 8 * fq + i)] * sw;
            EPI_LOOP_AM { const int r = u.pm * 256 + ai * 128 + wr * 64 + m * 16 + fr; const int ri = r >> 9, gc = r & 511; const int sa = 2 * tt + bj, sb = wc * 32 + 8 * fq;
                const i32x4 a0 = acc[ai][bj][m][0], a1 = acc[ai][bj][m][1];
                const f32x4 v0 = {(float)a0[0] * sc[0], (float)a0[1] * sc[1], (float)a0[2] * sc[2], (float)a0[3] * sc[3]};
                const f32x4 v1 = {(float)a1[0] * sc[4], (float)a1[1] * sc[5], (float)a1[2] * sc[6], (float)a1[3] * sc[7]};
                EPI_ST(u32x4, YT2 + ((((size_t)b * 512 + gc) * 64 + sa) * 2 + ri) * 128 + sb, pack8(v0, v1)); }
        }
    }
};
struct EpiUp8 {
    static constexpr bool PERM = true, MIDK = false, I8 = true;
    unsigned char* __restrict__ ws;
    __device__ __forceinline__ void operator()(AccRefI acc, const MoeUnit& u, int wr, int wc, int fr, int fq) const {
        bf16_t* HID = (bf16_t*)(ws + WS_Q); const u32x2* list = (const u32x2*)(ws + WS_LIST);
        const float sw = __uint_as_float(((const unsigned*)(ws + WS_CTL))[CW_WMAX + 2 + u.e]) * (1.0f / 127.0f);
        float sr[2][4];
        EPI_LOOP_AM { const int li = u.row0 + ai * 128 + wr * 64 + m * 16 + fr; sr[ai][m] = __uint_as_float(list[(size_t)u.e * 65536 + (li < u.cnt ? li : 0)].y) * sw; }
        EPI_LOOP_AM { const int lr = ai * 128 + wr * 64 + m * 16 + fr; const int hh = u.pn * 128 + wc * 32 + 8 * fq;
            u32x2 w[2];
#pragma unroll
            for (int bj = 0; bj < 2; ++bj) { const f32x4 g = i2f(acc[ai][bj][m][0], sr[ai][m]), uu = i2f(acc[ai][bj][m][1], sr[ai][m]); f32x4 o;
#pragma unroll
                for (int j = 0; j < 4; ++j) o[j] = g[j] * sigmoidf_(g[j]) * uu[j];
                w[bj] = pack4(o); }
            EPI_ST(u32x4, HID + (size_t)(u.orow + lr) * 256 + hh, ((u32x4){w[0].x, w[0].y, w[1].x, w[1].y})); }
    }
};

namespace att {
constexpr int NW = 8, KVBLK = 64, NT = SEQ / KVBLK, UROWS = 512;
constexpr int KSLOT = 12288, VSLOT = 8192, NSK = 3, NSV = 4;
constexpr int L_K = 0, L_V = NSK * KSLOT, L_WS = L_V + NSV * VSLOT, L_Q = L_WS + NW * 64 * 4, L_OST = L_Q, BYTES = L_Q + NW * 6144;
#define SBAR() __builtin_amdgcn_sched_barrier(0)
typedef short v4i16_t __attribute__((ext_vector_type(4)));
__device__ __forceinline__ int crow(int r, int hi) { return (r & 3) + 8 * (r >> 2) + 4 * hi; }
__device__ __forceinline__ s16x4 vtr(const LAS unsigned char* p) { return __builtin_bit_cast(s16x4, __builtin_amdgcn_ds_read_tr16_b64_v4i16((LAS v4i16_t*)p)); }
#define MF(a, b, c) __builtin_amdgcn_mfma_f32_32x32x16_bf16(a, b, c, 0, 0, 0)

__device__ __forceinline__ void attn_unit(const bf16_t* __restrict__ Qb, const bf16_t* __restrict__ Kt, const bf16_t* __restrict__ Vt, bf16_t* __restrict__ Ob, LAS unsigned char* lds) {
    const int tid = threadIdx.x, lane = tid & 63, r32 = lane & 31, hi = lane >> 5; const int wid = __builtin_amdgcn_readfirstlane(tid >> 6);
    const bool late = false;
    LAS float* wsf = (LAS float*)(lds + L_WS) + wid * 64;
    const unsigned voff = (unsigned)lane * 16u; const unsigned ldsbase = (unsigned)(uintptr_t)lds;
    const char* kbA = (const char*)Kt + wid * 1024; const char* kbB = (const char*)Kt + (8 + (wid & 3)) * 1024; const char* vbs = (const char*)Vt + wid * 1024;
    const int kdA = L_K + wid * 1024, kdB = L_K + (8 + (wid & 3)) * 1024, vd = L_V + wid * 1024;
#define GLDS(base, ldsoff) do { unsigned keep_; asm volatile("s_mov_b32 %0, m0\n\ts_mov_b32 m0, %3\n\ts_nop 0\n\tglobal_load_lds_dwordx4 %1, %2\n\ts_mov_b32 m0, %0" \
        : "=&s"(keep_) : "v"(voff), "s"(base), "s"((unsigned)(ldsbase + (ldsoff))) : "memory"); } while (0)
#define DMA_K(t, s) do { const int t_ = (t) < NT ? (t) : NT - 1; GLDS(kbA + (size_t)t_ * 12288, kdA + (s) * KSLOT); GLDS(kbB + (size_t)t_ * 12288, kdB + (s) * KSLOT); } while (0)
#define DMA_V(t, s) do { const int t_ = (t) < NT ? (t) : NT - 1; GLDS(vbs + (size_t)t_ * 8192, vd + (s) * VSLOT); } while (0)
#define WAIT_BAR(N) do { asm volatile("s_waitcnt vmcnt(" #N ") lgkmcnt(0)" ::: "memory"); __builtin_amdgcn_s_barrier(); asm volatile("" ::: "memory"); } while (0)
    const LAS unsigned char* kp0 = lds + L_K + hi * 1024 + r32 * 16;
    const LAS unsigned char* vp0 = lds + L_V + ((lane >> 4) & 1) * 32 + (lane & 3) * 8 + (4 * hi + ((lane & 15) >> 2)) * 64;
    DMA_K(0, 0); DMA_V(0, 0); DMA_K(1, 1); DMA_V(1, 1);
    bf16x8 qa[6];
    const LAS unsigned char* qbp = lds + L_Q + wid * 6144 + hi * 512 + r32 * 16;
    { const bf16_t* Qw = Qb + (size_t)(wid * 64 + r32) * QC + hi * 8;
#pragma unroll
      for (int d0 = 0; d0 < 6; ++d0) { qa[d0] = *reinterpret_cast<const bf16x8*>(Qw + d0 * 16); const bf16x8 qv = *reinterpret_cast<const bf16x8*>(Qw + (size_t)32 * QC + d0 * 16);
          *(LAS bf16x8*)(lds + L_Q + wid * 6144 + hi * 512 + r32 * 16 + d0 * 1024) = qv; } }
    bf16x8 qb0, qb1, qb2, qb3, qb4, qb5;
    { const bf16_t* Qw = Qb + (size_t)(wid * 64 + 32 + r32) * QC + hi * 8; qb0 = *reinterpret_cast<const bf16x8*>(Qw); qb1 = *reinterpret_cast<const bf16x8*>(Qw + 16); qb2 = *reinterpret_cast<const bf16x8*>(Qw + 32); qb3 = *reinterpret_cast<const bf16x8*>(Qw + 48); qb4 = *reinterpret_cast<const bf16x8*>(Qw + 64); qb5 = *reinterpret_cast<const bf16x8*>(Qw + 80); }
    f32x16 oA0 = f32x16{}, oA1 = f32x16{}, oB0 = f32x16{}, oB1 = f32x16{};
    u32x4 pA0, pA1, pA2, pA3, pB0, pB1, pB2, pB3;
    float lA = 0.f, lB = 0.f;
    WAIT_BAR(0);
#define PKW(P, B) cvt_pk_bf16(P[B], P[B + 1])
#define PAF(w) __builtin_bit_cast(bf16x8, w)
#define EX4(X, B) do { X[B] = __builtin_amdgcn_exp2f(X[B]); X[B + 1] = __builtin_amdgcn_exp2f(X[B + 1]); X[B + 2] = __builtin_amdgcn_exp2f(X[B + 2]); X[B + 3] = __builtin_amdgcn_exp2f(X[B + 3]); } while (0)
#define EX16(X) do { EX4(X, 0); EX4(X, 4); EX4(X, 8); EX4(X, 12); } while (0)
#define SUM16(L, X) do { L += ((X[0] + X[1]) + (X[2] + X[3])) + ((X[4] + X[5]) + (X[6] + X[7])) + ((X[8] + X[9]) + (X[10] + X[11])) + ((X[12] + X[13]) + (X[14] + X[15])); } while (0)
#define PACK(W0, W1, X) do { W0 = (u32x4){PKW(X, 0), PKW(X, 2), PKW(X, 4), PKW(X, 6)}; W1 = (u32x4){PKW(X, 8), PKW(X, 10), PKW(X, 12), PKW(X, 14)}; } while (0)
#define KRD(d0) do { ka##d0 = *(const LAS bf16x8*)(kpn + (d0) * 2048); kb##d0 = *(const LAS bf16x8*)(kpn + (d0) * 2048 + 512); } while (0)
#define VRD(i) do { l##i = vtr(vp_ + (((i) >> 2) * 4096 + ((i) & 3) * 1024)); h##i = vtr(vp_ + (((i) >> 2) * 4096 + ((i) & 3) * 1024 + 512)); } while (0)
#define VFR(i) ((bf16x8){l##i[0], l##i[1], l##i[2], l##i[3], h##i[0], h##i[1], h##i[2], h##i[3]})
#define PV(vsl) do { const LAS unsigned char* vp_ = vp0 + (vsl) * VSLOT; s16x4 l0, h0, l1, h1, l2, h2, l3, h3, l4, h4, l5, h5, l6, h6, l7, h7; \
    VRD(0); VRD(4); VRD(1); __builtin_amdgcn_s_setprio(1); SBAR(); \
    oA0 = MF(PAF(pA0), VFR(0), oA0); oB0 = MF(PAF(pB0), VFR(0), oB0); VRD(5); SBAR(); \
    oA1 = MF(PAF(pA0), VFR(4), oA1); oB1 = MF(PAF(pB0), VFR(4), oB1); VRD(2); SBAR(); \
    oA0 = MF(PAF(pA1), VFR(1), oA0); oB0 = MF(PAF(pB1), VFR(1), oB0); VRD(6); SBAR(); \
    oA1 = MF(PAF(pA1), VFR(5), oA1); oB1 = MF(PAF(pB1), VFR(5), oB1); VRD(3); SBAR(); \
    oA0 = MF(PAF(pA2), VFR(2), oA0); oB0 = MF(PAF(pB2), VFR(2), oB0); VRD(7); SBAR(); \
    oA1 = MF(PAF(pA2), VFR(6), oA1); oB1 = MF(PAF(pB2), VFR(6), oB1); SBAR(); \
    oA0 = MF(PAF(pA3), VFR(3), oA0); oB0 = MF(PAF(pB3), VFR(3), oB0); SBAR(); \
    oA1 = MF(PAF(pA3), VFR(7), oA1); oB1 = MF(PAF(pB3), VFR(7), oB1); __builtin_amdgcn_s_setprio(0); SBAR(); } while (0)
#define STEP(t, ks, vs, HASP) do { \
    if (late && (HASP)) { PV(((vs) + 3) & 3); } \
    { const LAS unsigned char* kpn = kp0 + (ks) * KSLOT; bf16x8 ka0, kb0, ka1, kb1, ka2, kb2, ka3, kb3, ka4, kb4, ka5, kb5; \
      f32x16 sA0, sA1, sB0, sB1; const f32x16 z16 = f32x16{}; \
      KRD(0); KRD(1); __builtin_amdgcn_s_setprio(1); SBAR(); \
      sA0 = MF(ka0, qa[0], z16); sB0 = MF(ka0, qb0, z16); sA1 = MF(kb0, qa[0], z16); sB1 = MF(kb0, qb0, z16); KRD(2); SBAR(); \
      sA0 = MF(ka1, qa[1], sA0); sB0 = MF(ka1, qb1, sB0); sA1 = MF(kb1, qa[1], sA1); sB1 = MF(kb1, qb1, sB1); KRD(3); SBAR(); \
      sA0 = MF(ka2, qa[2], sA0); sB0 = MF(ka2, qb2, sB0); sA1 = MF(kb2, qa[2], sA1); sB1 = MF(kb2, qb2, sB1); KRD(4); SBAR(); \
      sA0 = MF(ka3, qa[3], sA0); sB0 = MF(ka3, qb3, sB0); sA1 = MF(kb3, qa[3], sA1); sB1 = MF(kb3, qb3, sB1); KRD(5); SBAR(); \
      sA0 = MF(ka4, qa[4], sA0); sB0 = MF(ka4, qb4, sB0); sA1 = MF(kb4, qa[4], sA1); sB1 = MF(kb4, qb4, sB1); SBAR(); \
      sA0 = MF(ka5, qa[5], sA0); sB0 = MF(ka5, qb5, sB0); sA1 = MF(kb5, qa[5], sA1); sB1 = MF(kb5, qb5, sB1); __builtin_amdgcn_s_setprio(0); SBAR(); \
      EX16(sA0); SUM16(lA, sA0); PACK(pA0, pA1, sA0); SBAR(); \
      EX16(sA1); SUM16(lA, sA1); PACK(pA2, pA3, sA1); SBAR(); \
      EX16(sB0); SUM16(lB, sB0); PACK(pB0, pB1, sB0); SBAR(); \
      EX16(sB1); SUM16(lB, sB1); PACK(pB2, pB3, sB1); SBAR(); } \
    if (!late) { PV(vs); } \
    DMA_V((t) + 2, ((vs) + 2) & 3); DMA_K((t) + 2, ((ks) == 0 ? 2 : (ks) - 1)); \
    WAIT_BAR(3); } while (0)
    int ks = 0, vs = 0;
#pragma unroll 1
    for (int t = 0; t < NT; ++t) {
        STEP(t, ks, vs, (t > 0));
        ks = (ks == 2) ? 0 : ks + 1; vs = (vs + 1) & 3;
    }
    if (late) { PV(3); }
    LAS bf16_t* stg = (LAS bf16_t*)(lds + L_OST) + wid * 2048;
#define OUT_BLOCK(O0, O1, L, blk) do { float l_ = (L); { auto rr = __builtin_amdgcn_permlane32_swap(__float_as_uint(l_), __float_as_uint(l_), false, false); l_ = __uint_as_float(rr[0]) + __uint_as_float(rr[1]); } \
    if (hi == 0) wsf[r32] = l_; \
    asm volatile("s_waitcnt lgkmcnt(0)" ::: "memory"); \
    _Pragma("unroll") for (int r = 0; r < 16; ++r) { const int orow = crow(r, hi); const float rl = __builtin_amdgcn_rcpf(wsf[orow]); \
        stg[orow * 64 + r32] = (bf16_t)(cvt_pk_bf16(O0[r] * rl, 0.f) & 0xffffu); stg[orow * 64 + 32 + r32] = (bf16_t)(cvt_pk_bf16(O1[r] * rl, 0.f) & 0xffffu); } \
    asm volatile("s_waitcnt lgkmcnt(0)" ::: "memory"); \
    { bf16_t* Ow = Ob + (size_t)(wid * 64 + (blk) * 32) * 512; \
      _Pragma("unroll") for (int i = 0; i < 4; ++i) { const int row = i * 8 + (lane >> 3), ch = lane & 7; const u32x4 v = *(const LAS u32x4*)(stg + row * 64 + ch * 8); *(u32x4*)(Ow + (size_t)row * 512 + ch * 8) = v; } } \
    asm volatile("s_waitcnt lgkmcnt(0)" ::: "memory"); } while (0)
    OUT_BLOCK(oA0, oA1, lA, 0);
    OUT_BLOCK(oB0, oB1, lB, 1);
    WAIT_BAR(0);
#undef GLDS
#undef DMA_K
#undef DMA_V
#undef WAIT_BAR
#undef PKW
#undef PAF
#undef EX16
#undef EX4
#undef SUM16
#undef PACK
#undef KRD
#undef VRD
#undef VFR
#undef PV
#undef STEP
#undef OUT_BLOCK
}
#undef SBAR
#undef MF
}

struct Args { const float* in[27]; float* out; unsigned char* ws; int ph_lo, ph_hi, li, pad; };
struct Frame {
    LAS unsigned char* lds; int tid, lane, wave, vcu, G;
};
__device__ __forceinline__ unsigned f2bf(float f) { unsigned u = __builtin_bit_cast(unsigned, f); return (u + 0x7fffu + ((u >> 16) & 1u)) >> 16; }
__device__ __forceinline__ unsigned pk2(float lo, float hi) { return f2bf(lo) | (f2bf(hi) << 16); }

__device__ __forceinline__ float wave_max(float v) {
#pragma unroll
    for (int o = 1; o < 64; o <<= 1) v = fmaxf(v, __shfl_xor(v, o));
    return v;
}
template <class RM>
__device__ __forceinline__ void tr_item(const float* __restrict__ W, int ldw, int k0, int n0, const float* __restrict__ kscale, bf16_t* WT, int Kdst, const RM& rm, LAS float* scr, int lane, unsigned* wmaxp = nullptr) {
    float amax = 0.f;
    float v[32];
    { const float* wp = W + (size_t)(k0 + (lane >> 5)) * ldw + n0 + (lane & 31);
#pragma unroll
      for (int i = 0; i < 32; ++i) v[i] = wp[(size_t)(2 * i) * ldw]; }
    if (kscale) {
#pragma unroll
        for (int i = 0; i < 32; ++i) v[i] *= kscale[k0 + 2 * i + (lane >> 5)]; }
    asm volatile("" ::: "memory");
#pragma unroll
    for (int i = 0; i < 32; ++i) { const int kk = 2 * i + (lane >> 5); scr[kk * 33 + (lane & 31)] = v[i]; amax = fmaxf(amax, fabsf(v[i])); }
    if (wmaxp) { amax = wave_max(amax); if (lane == 0) atomicMax(wmaxp, __float_as_uint(amax)); }
    LDS_WAIT(); asm volatile("" ::: "memory");
    const int c = lane & 7;
#pragma unroll
    for (int j = 0; j < 4; ++j) { const int n = (lane >> 3) + 8 * j; const LAS float* s = scr + (8 * c) * 33 + n;
        u32x4 o; o.x = pk2(s[0 * 33], s[1 * 33]); o.y = pk2(s[2 * 33], s[3 * 33]); o.z = pk2(s[4 * 33], s[5 * 33]); o.w = pk2(s[6 * 33], s[7 * 33]);
        *(u32x4*)(WT + (size_t)rm(n0 + n) * Kdst + k0 + 8 * c) = o; }
    LDS_WAIT(); asm volatile("" ::: "memory");
}
__device__ __forceinline__ int rope_pos(int i) { return 8 * ((i & 15) >> 2) + 4 * (i >> 4) + (i & 3); }
struct RmIdent { int off; __device__ __forceinline__ int operator()(int n) const { return n + off; } };
struct RmWin { __device__ __forceinline__ int operator()(int n) const { return n < 512 ? n : (n < 544 ? 2560 + rope_pos(n - 512) : 512 + (n - 1056)); } };
struct RmUq { __device__ __forceinline__ int operator()(int n) const { const int h = n / 96, d = n - 96 * h; return d < 64 ? n : 96 * h + 64 + rope_pos(d - 64); } };
struct RmGu { int up; __device__ __forceinline__ int operator()(int hh) const { return 256 * (hh >> 7) + 128 * ((hh >> 2) & 1) + 32 * ((hh >> 5) & 3) + 8 * ((hh >> 3) & 3) + (hh & 3) + 4 * up; } };

__device__ const double INVF[16] = {1.0, 0.5623413251903491, 0.31622776601683794, 0.1778279410038923, 0.1, 0.05623413251903491, 0.03162277660168379, 0.01778279410038923,
    0.01, 0.005623413251903491, 0.0031622776601683794, 0.0017782794100389228, 0.001, 0.0005623413251903491, 0.00031622776601683794, 0.00017782794100389227};

__device__ __forceinline__ void p0_prologue(const Frame& F, const Args& a) {
    unsigned char* ws = a.ws; unsigned* WMAX = (unsigned*)((gu32*)(ws + WS_CTL) + CW_WMAX);
    {
        LAS float* cact = (LAS float*)(F.lds);
        LAS float* red = (LAS float*)(F.lds + 32768);
        float* MODF = (float*)(ws + WS_MODF);
        const float* c = a.in[1];
        for (int i = F.tid; i < 8192; i += 512) { const int b = i >> 10, k = i & 1023; const float v = c[i]; cact[k * 8 + b] = v * sigmoidf_(v); }
        __syncthreads();
        for (int it = blockIdx.x; it < 128; it += F.G) {
            const int n = it * 64 + F.lane, kg = F.wave;
            const float* W = (n < 6144) ? (a.in[3] + n) : (a.in[24] + (n - 6144)); const int ldw = (n < 6144) ? 6144 : 2048;
            float acc[8];
#pragma unroll
            for (int b = 0; b < 8; ++b) acc[b] = 0.f;
#pragma unroll 8
            for (int k = kg * 128; k < kg * 128 + 128; ++k) { const float w = W[(size_t)k * ldw]; const f32x4 c0 = *(const LAS f32x4*)(cact + k * 8), c1 = *(const LAS f32x4*)(cact + k * 8 + 4);
                acc[0] += c0[0] * w; acc[1] += c0[1] * w; acc[2] += c0[2] * w; acc[3] += c0[3] * w; acc[4] += c1[0] * w; acc[5] += c1[1] * w; acc[6] += c1[2] * w; acc[7] += c1[3] * w; }
#pragma unroll
            for (int b = 0; b < 8; ++b) red[(kg * 8 + b) * 64 + F.lane] = acc[b];
            __syncthreads();
            { const int b = F.tid >> 6, cl = F.tid & 63, nn = it * 64 + cl; float s = 0.f;
#pragma unroll
              for (int q = 0; q < 8; ++q) s += red[(q * 8 + b) * 64 + cl];
              MODF[b * 8192 + nn] = s + (nn < 6144 ? a.in[4][nn] : a.in[25][nn - 6144]); }
            __syncthreads();
        }
        __syncthreads();
    }
    LAS float* scr = (LAS float*)(F.lds + F.wave * 16384);
    const int gw = F.vcu * NWAVES + F.wave, NGW = F.G * NWAVES;
    bf16_t* WIN = (bf16_t*)(ws + WS_WIN); bf16_t* WFY = (bf16_t*)(ws + WS_WFY); bf16_t* WUQ = (bf16_t*)(ws + WS_WUQ); bf16_t* WUKV = (bf16_t*)(ws + WS_WUKV);
    bf16_t* WBA = (bf16_t*)(ws + WS_WBA); bf16_t* WBF = (bf16_t*)(ws + WS_WBF); bf16_t* WOUT = (bf16_t*)(ws + WS_WOUT);
    bf16_t* WGU = (bf16_t*)(ws + WS_WGU); bf16_t* WDN = (bf16_t*)(ws + WS_WDN);
    constexpr int I_WIN = 81 * 16, I_UQ = 24 * 4, I_UK = 16 * 4, I_UV = 16 * 4, I_BA = 32 * 8, I_BF = 32 * 8, I_OUT = 32 * 16, I_G = 32 * 8 * 16, I_U = I_G, I_D = 32 * 32 * 4;
    constexpr int I_FY = 16 * 8 * 4;
    constexpr int NITEMS = I_WIN + I_UQ + I_UK + I_UV + I_BA + I_BF + I_OUT + I_G + I_U + I_D + I_FY;
    for (int it = gw; it < NITEMS; it += NGW) {
        int r = it;
        if (r < I_WIN) { const int kb = r / 81, nbi = r % 81; const int n0 = nbi < 17 ? nbi * 32 : 1056 + (nbi - 17) * 32;
            tr_item(a.in[6], 3104, kb * 64, n0, nullptr, WIN, 1024, RmWin{}, scr, F.lane, WMAX + 0); continue; } r -= I_WIN;
        if (r < I_UQ) { tr_item(a.in[9], 768, (r / 24) * 64, (r % 24) * 32, a.in[7], WUQ, 256, RmUq{}, scr, F.lane); continue; } r -= I_UQ;
        if (r < I_UK) { tr_item(a.in[10], 512, (r / 16) * 64, (r % 16) * 32, a.in[8], WUKV, 256, RmIdent{0}, scr, F.lane); continue; } r -= I_UK;
        if (r < I_UV) { tr_item(a.in[11], 512, (r / 16) * 64, (r % 16) * 32, a.in[8], WUKV, 256, RmIdent{512}, scr, F.lane); continue; } r -= I_UV;
        if (r < I_BA) { tr_item(a.in[12], 1024, (r / 32) * 64, (r % 32) * 32, nullptr, WBA, 1024, RmIdent{0}, scr, F.lane); continue; } r -= I_BA;
        if (r < I_BF) { tr_item(a.in[13], 1024, (r / 32) * 64, (r % 32) * 32, nullptr, WBA + 512, 1024, RmIdent{0}, scr, F.lane); continue; } r -= I_BF;
        if (r < I_OUT) { tr_item(a.in[15], 1024, (r / 32) * 64, (r % 32) * 32, nullptr, WOUT, 1024, RmIdent{0}, scr, F.lane); continue; } r -= I_OUT;
        if (r < I_G) { const int e = r / 128, q = r % 128; tr_item(a.in[21] + (size_t)e * 1024 * 256, 256, (q / 8) * 64, (q % 8) * 32, nullptr, WGU + (size_t)e * 512 * 1024, 1024, RmGu{0}, scr, F.lane, WMAX + 2 + e); continue; } r -= I_G;
        if (r < I_U) { const int e = r / 128, q = r % 128; tr_item(a.in[22] + (size_t)e * 1024 * 256, 256, (q / 8) * 64, (q % 8) * 32, nullptr, WGU + (size_t)e * 512 * 1024, 1024, RmGu{1}, scr, F.lane, WMAX + 2 + e); continue; } r -= I_U;
        if (r < I_D) { const int e = r / 128, q = r % 128; tr_item(a.in[23] + (size_t)e * 256 * 1024, 1024, (q / 32) * 64, (q % 32) * 32, nullptr, WDN + (size_t)e * 1024 * 256, 256, RmIdent{0}, scr, F.lane); continue; } r -= I_D;
        {
            const int kb = r >> 5, g = (r >> 2) & 7, jq = r & 3;
            const float* W = a.in[6] + (size_t)(kb * 64) * 3104 + 544 + 64 * g;
            { float wv[64];
#pragma unroll
              for (int kk = 0; kk < 64; ++kk) wv[kk] = W[(size_t)kk * 3104 + F.lane];
              asm volatile("" ::: "memory");
#pragma unroll
              for (int kk = 0; kk < 64; ++kk) scr[F.lane * 64 + kk] = wv[kk]; }
            LDS_WAIT(); asm volatile("" ::: "memory");
            float ar[16], ai_[16];
#pragma unroll
            for (int j = 0; j < 16; ++j) { ar[j] = 0.f; ai_[j] = 0.f; }
#pragma unroll 2
            for (int cI = 0; cI < 64; ++cI) { const float xv = scr[cI * 64 + F.lane];
#pragma unroll
                for (int j = 0; j < 16; ++j) { const float ph = (float)((cI * (jq * 16 + j)) & 63) * (1.0f / 64.0f);
                    ar[j] += xv * __builtin_amdgcn_cosf(ph); ai_[j] -= xv * __builtin_amdgcn_sinf(ph); } }
            float amax = 0.f;
#pragma unroll
            for (int j = 0; j < 16; ++j) { const int jj = jq * 16 + j; amax = fmaxf(amax, fmaxf(fabsf(ar[j]), fabsf(ai_[j])) * FNORM);
                WFY[(size_t)(g * 64 + jj) * 1024 + kb * 64 + F.lane] = (bf16_t)f2bf(ar[j] * FNORM);
                WFY[(size_t)(512 + g * 64 + jj) * 1024 + kb * 64 + F.lane] = (bf16_t)f2bf(ai_[j] * FNORM); }
            amax = wave_max(amax); if (F.lane == 0) atomicMax(WMAX + 1, __float_as_uint(amax));
            LDS_WAIT(); asm volatile("" ::: "memory");
        }
    }
    const int gt = F.vcu * 512 + F.tid, NGT = F.G * 512;
    { float* RC = (float*)(ws + WS_ROPEC); float* RS = (float*)(ws + WS_ROPES); const int* pos = (const int*)a.in[2];
        for (int i = gt; i < T * 16; i += NGT) { const int t = i >> 4, f = i & 15; const double rev = (double)pos[t] * INVF[f] * 0.15915494309189535; const float fr = (float)(rev - __builtin_floor(rev));
            RC[i] = __builtin_amdgcn_cosf(fr); RS[i] = __builtin_amdgcn_sinf(fr); } }
    { bf16_t* DFTA = (bf16_t*)(ws + WS_DFTA);
        for (int i = gt; i < 256 * 256; i += NGT) { const int r = i >> 8, cI = i & 255; const int rip = r >> 7, kb = r & 127, ri = cI >> 7, sb = cI & 127;
            const float ph = (float)((sb * kb) & 127) * (1.0f / 128.0f); const float cs = __builtin_amdgcn_cosf(ph), sn = __builtin_amdgcn_sinf(ph);
            const float v = (rip == ri) ? cs : (rip == 0 ? sn : -sn); DFTA[i] = (bf16_t)f2bf(v); } }
    { bf16_t* TB2 = (bf16_t*)(ws + WS_TB2);
        for (int i = gt; i < 64 * 128 * 256; i += NGT) { const int pair = i >> 15, r = (i >> 8) & 127, cI = i & 255; const int kbp = r >> 6, ka = r & 63, kbpp = cI >> 7, ri = (cI >> 6) & 1, sa = cI & 63;
            const int kbb = 2 * pair + kbp; const float ph = (float)((sa * (kbb + 128 * ka)) & 8191) * (1.0f / 8192.0f);
            const float v = (kbp == kbpp) ? (ri ? __builtin_amdgcn_sinf(ph) : __builtin_amdgcn_cosf(ph)) : 0.f; TB2[i] = (bf16_t)f2bf(v); } }
}

__device__ __forceinline__ unsigned q8s(float v) { return (unsigned)(int)fminf(fmaxf(__builtin_rintf(v), -127.f), 127.f) & 0xffu; }
__device__ __forceinline__ void p1_norm(const Frame& F, const Args& a) {
    unsigned char* ws = a.ws; const float* MODF = (const float*)(ws + WS_MODF);
    const unsigned* WMAX = (const unsigned*)((gu32*)(ws + WS_CTL) + CW_WMAX);
    {
        const bf16_t* WIN = (const bf16_t*)(ws + WS_WIN); const bf16_t* WFY = (const bf16_t*)(ws + WS_WFY); const bf16_t* WGU = (const bf16_t*)(ws + WS_WGU);
        u32x2* W8IN = (u32x2*)(ws + WS_W8IN); u32x2* W8FY = (u32x2*)(ws + WS_W8FY); u32x2* W8GU = (u32x2*)(ws + WS_W8GU);
        constexpr int C_IN = NWIN * 1024 / 8, C_FY = 1024 * 1024 / 8, C_GU = 32 * 512 * 1024 / 8;
        const int gt = F.vcu * 512 + F.tid, NGT = F.G * 512;
        for (int i = gt; i < C_IN + C_FY + C_GU; i += NGT) {
            const bf16_t* src; u32x2* dst; float wm;
            if (i < C_IN) { src = WIN + (size_t)i * 8; dst = W8IN + i; wm = __uint_as_float(WMAX[0]); }
            else if (i < C_IN + C_FY) { const int j = i - C_IN; src = WFY + (size_t)j * 8; dst = W8FY + j; wm = __uint_as_float(WMAX[1]); }
            else { const int j = i - C_IN - C_FY; src = WGU + (size_t)j * 8; dst = W8GU + j; wm = __uint_as_float(WMAX[2 + (j >> 16)]); }
            const float inv = wm > 0.f ? 127.0f / wm : 0.f;
            const u32x4 w = *(const u32x4*)src;
            u32x2 o;
            o.x = q8s(bf_lo(w.x) * inv) | (q8s(bf_hi(w.x) * inv) << 8) | (q8s(bf_lo(w.y) * inv) << 16) | (q8s(bf_hi(w.y) * inv) << 24);
            o.y = q8s(bf_lo(w.z) * inv) | (q8s(bf_hi(w.z) * inv) << 8) | (q8s(bf_lo(w.w) * inv) << 16) | (q8s(bf_hi(w.w) * inv) << 24);
            *dst = o; }
    }
    const float* x = a.in[0]; const float* g = a.in[5]; unsigned char* U8 = (unsigned char*)(ws + WS_R1); float* SU = (float*)(ws + WS_SU);
    const int gw = F.vcu * NWAVES + F.wave, NGW = F.G * NWAVES;
    for (int ch = gw; ch < T / 32; ch += NGW) {
        const int b = (ch * 32) >> 13;
        f32x4 Gv[4], Sv[4];
#pragma unroll
        for (int j = 0; j < 4; ++j) { const int k = 4 * F.lane + 256 * j; Gv[j] = *(const f32x4*)(g + k) * (*(const f32x4*)(MODF + b * 8192 + 1024 + k) + 1.0f); Sv[j] = *(const f32x4*)(MODF + b * 8192 + k); }
#pragma unroll 2
        for (int rr = 0; rr < 32; ++rr) { const size_t row = (size_t)ch * 32 + rr; const f32x4* xr = (const f32x4*)(x + row * 1024) + F.lane;
            f32x4 v[4]; float s = 0.f;
#pragma unroll
            for (int j = 0; j < 4; ++j) { v[j] = xr[64 * j]; s += (v[j][0] * v[j][0] + v[j][1] * v[j][1]) + (v[j][2] * v[j][2] + v[j][3] * v[j][3]); }
            const float rs = __builtin_amdgcn_rsqf(wave_sum(s) * (1.0f / 1024.0f) + EPS);
            float am = 0.f;
#pragma unroll
            for (int j = 0; j < 4; ++j) { v[j] = v[j] * rs * Gv[j] + Sv[j]; am = fmaxf(am, fmaxf(fmaxf(fabsf(v[j][0]), fabsf(v[j][1])), fmaxf(fabsf(v[j][2]), fabsf(v[j][3])))); }
            am = wave_max(am); const float inv = am > 0.f ? 127.0f / am : 0.f;
            unsigned* o4 = (unsigned*)(U8 + row * 1024) + F.lane;
#pragma unroll
            for (int j = 0; j < 4; ++j) o4[64 * j] = q8s(v[j][0] * inv) | (q8s(v[j][1] * inv) << 8) | (q8s(v[j][2] * inv) << 16) | (q8s(v[j][3] * inv) << 24);
            if (F.lane == 0) SU[row] = am * (1.0f / 127.0f); }
    }
}

__device__ __forceinline__ float wave_sum_dpp(float v) {
    int x = __float_as_int(v);
    x = __float_as_int(__int_as_float(x) + __int_as_float(__builtin_amdgcn_update_dpp(0, x, 0xB1, 0xF, 0xF, true)));
    x = __float_as_int(__int_as_float(x) + __int_as_float(__builtin_amdgcn_update_dpp(0, x, 0x4E, 0xF, 0xF, true)));
    x = __float_as_int(__int_as_float(x) + __int_as_float(__builtin_amdgcn_update_dpp(0, x, 0x141, 0xF, 0xF, true)));
    x = __float_as_int(__int_as_float(x) + __int_as_float(__builtin_amdgcn_update_dpp(0, x, 0x140, 0xF, 0xF, true)));
    x = __float_as_int(__int_as_float(x) + __int_as_float(__builtin_amdgcn_update_dpp(0, x, 0x142, 0xA, 0xF, false)));
    x = __float_as_int(__int_as_float(x) + __int_as_float(__builtin_amdgcn_update_dpp(0, x, 0x143, 0xC, 0xF, false)));
    return __int_as_float(__builtin_amdgcn_readlane(x, 63));
}
constexpr int RT_WPH = 0, RT_WPL = 74304, RT_LCNT = 148608, RT_LBASE = RT_LCNT + 128, RT_INFO = RT_LBASE + 128, RT_CVEC = RT_INFO + 4096, RT_STG = RT_CVEC + 256;
__device__ __forceinline__ int wp_off(int n, int k) { return n * 2064 + k * 2; }
__device__ __forceinline__ void p7_route(const Frame& F, const Args& a) {
    unsigned char* ws = a.ws; gu32* ctl = (gu32*)(ws + WS_CTL);
    const bf16_t* H = (const bf16_t*)(ws + WS_YT2); const float* MODF = (const float*)(ws + WS_MODF); const float* g = a.in[16];
    unsigned char* VM8 = (unsigned char*)(ws + WS_R1); u32x2* LIST = (u32x2*)(ws + WS_LIST); u32x4* TOKINFO = (u32x4*)(ws + WS_ROUTEW);
    LAS int* lcnt = (LAS int*)(F.lds + RT_LCNT); LAS int* lbase = (LAS int*)(F.lds + RT_LBASE); LAS unsigned* info = (LAS unsigned*)(F.lds + RT_INFO); LAS float* winfo = (LAS float*)(F.lds + RT_INFO + 1024); LAS float* sinfo = (LAS float*)(F.lds + RT_INFO + 3072);
    LAS float* cvec = (LAS float*)(F.lds + RT_CVEC); LAS float* stg = (LAS float*)(F.lds + RT_STG + F.wave * 1152);
    const int l16 = F.lane & 15, fq = F.lane >> 4;
    int wb = -1;
    for (int ch = F.vcu; ch < T / 256; ch += F.G) {
        const int b = (ch * 256) >> 13;
        if (b != wb) {
            __syncthreads();
            const float* Gm = MODF + b * 8192 + 4096; const float* Sm = MODF + b * 8192 + 3072;
            float pg = 0.f, pe = 0.f;
            for (int i = F.tid; i < 1024 * 4; i += 512) { const int k = i >> 2, n = i & 3; const float w0 = a.in[17][i]; pg += Sm[k] * w0; const float w = w0 * (g[k] * (Gm[k] + 1.0f)); const unsigned h16 = f2bf(w);
                *(LAS unsigned short*)(F.lds + RT_WPH + wp_off(n, k)) = (unsigned short)h16; *(LAS unsigned short*)(F.lds + RT_WPL + wp_off(n, k)) = (unsigned short)f2bf(w - __uint_as_float(h16 << 16)); }
            for (int i = F.tid; i < 1024 * 32; i += 512) { const int k = i >> 5, n = 4 + (i & 31); const float w0 = a.in[19][i]; pe += Sm[k] * w0; const float w = w0 * (g[k] * (Gm[k] + 1.0f)); const unsigned h16 = f2bf(w);
                *(LAS unsigned short*)(F.lds + RT_WPH + wp_off(n, k)) = (unsigned short)h16; *(LAS unsigned short*)(F.lds + RT_WPL + wp_off(n, k)) = (unsigned short)f2bf(w - __uint_as_float(h16 << 16)); }
            { LAS float* part = (LAS float*)(F.lds + RT_STG);
              part[(F.tid & 3) * 128 + (F.tid >> 2)] = pg; part[512 + (F.tid & 31) * 16 + (F.tid >> 5)] = pe;
              __syncthreads();
              if (F.tid < 36) { float d = 0.f;
                  if (F.tid < 4) { for (int j = 0; j < 128; ++j) d += part[F.tid * 128 + j]; d += a.in[18][F.tid]; }
                  else { for (int j = 0; j < 16; ++j) d += part[512 + (F.tid - 4) * 16 + j]; d += a.in[20][F.tid - 4]; }
                  cvec[F.tid] = d; } }
            wb = b;
        }
        if (F.tid < 32) lcnt[F.tid] = 0;
        __syncthreads();
        f32x4 Gv[4], Sv[4];
#pragma unroll
        for (int j = 0; j < 4; ++j) { const int k = 4 * F.lane + 256 * j; Gv[j] = *(const f32x4*)(g + k) * (*(const f32x4*)(MODF + b * 8192 + 4096 + k) + 1.0f); Sv[j] = *(const f32x4*)(MODF + b * 8192 + 3072 + k); }
#pragma unroll 1
        for (int bi = 0; bi < 2; ++bi) {
            const size_t R0 = (size_t)ch * 256 + F.wave * 32 + bi * 16;
            f32x4 acc0 = f32x4{}, acc1 = f32x4{}, acc2 = f32x4{};
            { const bf16_t* hp = H + (R0 + l16) * 1024 + fq * 8;
              const int n0 = l16, n1 = 16 + l16, n2 = (32 + l16) < 36 ? 32 + l16 : 35;
              bf16x8 av[2][8];
#pragma unroll
              for (int i = 0; i < 8; ++i) av[0][i] = *reinterpret_cast<const bf16x8*>(hp + i * 32);
#pragma unroll
              for (int kb = 0; kb < 4; ++kb) {
                  if (kb < 3) {
#pragma unroll
                      for (int i = 0; i < 8; ++i) av[(kb + 1) & 1][i] = *reinterpret_cast<const bf16x8*>(hp + ((kb + 1) * 8 + i) * 32); }
#pragma unroll
                  for (int i = 0; i < 8; ++i) { const int k = (kb * 8 + i) * 32 + fq * 8; const bf16x8 af = av[kb & 1][i];
                      const bf16x8 h0 = *(const LAS bf16x8*)(F.lds + RT_WPH + wp_off(n0, k)), h1 = *(const LAS bf16x8*)(F.lds + RT_WPH + wp_off(n1, k)), h2 = *(const LAS bf16x8*)(F.lds + RT_WPH + wp_off(n2, k));
                      const bf16x8 e0 = *(const LAS bf16x8*)(F.lds + RT_WPL + wp_off(n0, k)), e1 = *(const LAS bf16x8*)(F.lds + RT_WPL + wp_off(n1, k)), e2 = *(const LAS bf16x8*)(F.lds + RT_WPL + wp_off(n2, k));
                      acc0 = __builtin_amdgcn_mfma_f32_16x16x32_bf16(af, h0, acc0, 0, 0, 0); acc1 = __builtin_amdgcn_mfma_f32_16x16x32_bf16(af, h1, acc1, 0, 0, 0); acc2 = __builtin_amdgcn_mfma_f32_16x16x32_bf16(af, h2, acc2, 0, 0, 0);
                      acc0 = __builtin_amdgcn_mfma_f32_16x16x32_bf16(af, e0, acc0, 0, 0, 0); acc1 = __builtin_amdgcn_mfma_f32_16x16x32_bf16(af, e1, acc1, 0, 0, 0); acc2 = __builtin_amdgcn_mfma_f32_16x16x32_bf16(af, e2, acc2, 0, 0, 0); } }
            }
            u32x2 hn[4];
            { const u32x2* hr = (const u32x2*)(H + R0 * 1024) + F.lane;
#pragma unroll
              for (int j = 0; j < 4; ++j) hn[j] = hr[64 * j]; }
#pragma unroll 1
            for (int half = 0; half < 2; ++half) {
                if ((fq >> 1) == half) {
#pragma unroll
                    for (int r = 0; r < 4; ++r) { const int rl = (fq & 1) * 4 + r; stg[rl * 36 + l16] = acc0[r]; stg[rl * 36 + 16 + l16] = acc1[r]; if (l16 < 4) stg[rl * 36 + 32 + l16] = acc2[r]; } }
                LDS_WAIT(); asm volatile("" ::: "memory");
#pragma unroll 4
                for (int rr = 0; rr < 8; ++rr) { const int lr = F.wave * 32 + bi * 16 + half * 8 + rr; const size_t row = (size_t)ch * 256 + lr;
                    f32x4 v[4]; float s = 0.f;
                    u32x2 hc[4];
#pragma unroll
                    for (int j = 0; j < 4; ++j) hc[j] = hn[j];
                    { const u32x2* hr = (const u32x2*)(H + (row + ((half * 8 + rr) < 15 ? 1 : 0)) * 1024) + F.lane;
#pragma unroll
                      for (int j = 0; j < 4; ++j) hn[j] = hr[64 * j]; }
#pragma unroll
                    for (int j = 0; j < 4; ++j) { const u32x2 hw = hc[j]; v[j] = (f32x4){bf_lo(hw.x), bf_hi(hw.x), bf_lo(hw.y), bf_hi(hw.y)}; s += (v[j][0] * v[j][0] + v[j][1] * v[j][1]) + (v[j][2] * v[j][2] + v[j][3] * v[j][3]); }
                    const float rs = __builtin_amdgcn_rsqf(wave_sum_dpp(s) * (1.0f / 1024.0f) + EPS);
                    float am = 0.f;
#pragma unroll
                    for (int j = 0; j < 4; ++j) { v[j] = v[j] * rs * Gv[j] + Sv[j]; am = fmaxf(am, fmaxf(fmaxf(fabsf(v[j][0]), fabsf(v[j][1])), fmaxf(fabsf(v[j][2]), fabsf(v[j][3])))); }
                    am = wave_max(am); const float inv = am > 0.f ? 127.0f / am : 0.f;
                    { unsigned* o4 = (unsigned*)(VM8 + row * 1024) + F.lane;
#pragma unroll
                      for (int j = 0; j < 4; ++j) o4[64 * j] = q8s(v[j][0] * inv) | (q8s(v[j][1] * inv) << 8) | (q8s(v[j][2] * inv) << 16) | (q8s(v[j][3] * inv) << 24); }
                    const f32x4 graw = *(const LAS f32x4*)(stg + rr * 36), gc = *(const LAS f32x4*)cvec;
                    float gl[4];
#pragma unroll
                    for (int q = 0; q < 4; ++q) gl[q] = graw[q] * rs + gc[q];
                    int gs = 0; float gm = gl[0];
#pragma unroll
                    for (int q = 1; q < 4; ++q) if (gl[q] > gm) { gm = gl[q]; gs = q; }
                    gs = __builtin_amdgcn_readfirstlane(gs);
                    float gden = 0.f;
#pragma unroll
                    for (int q = 0; q < 4; ++q) gden += __expf(gl[q] - gm);
                    const float gp = 1.0f / gden;
                    const f32x4 er0 = *(const LAS f32x4*)(stg + rr * 36 + 4 + gs * 8), er1 = *(const LAS f32x4*)(stg + rr * 36 + 8 + gs * 8), ec0 = *(const LAS f32x4*)(cvec + 4 + gs * 8), ec1 = *(const LAS f32x4*)(cvec + 8 + gs * 8);
                    float b0 = -3.0e38f, b1 = -3.0e38f; int i0 = 0, i1 = 0;
#pragma unroll
                    for (int e = 0; e < 8; ++e) { const float el = (e < 4 ? er0[e & 3] : er1[e & 3]) * rs + (e < 4 ? ec0[e & 3] : ec1[e & 3]);
                        if (el > b0) { b1 = b0; i1 = i0; b0 = el; i0 = e; } else if (el > b1) { b1 = el; i1 = e; } }
                    const float w0 = 1.0f / (1.0f + __expf(b1 - b0)), w1 = 1.0f - w0;
                    if (F.lane == 0) { const int e0 = gs * 8 + i0, e1 = gs * 8 + i1;
                        const int rk0 = __hip_atomic_fetch_add(lcnt + e0, 1, __ATOMIC_RELAXED, __HIP_MEMORY_SCOPE_WORKGROUP);
                        const int rk1 = __hip_atomic_fetch_add(lcnt + e1, 1, __ATOMIC_RELAXED, __HIP_MEMORY_SCOPE_WORKGROUP);
                        info[lr] = (unsigned)e0 | ((unsigned)e1 << 5) | ((unsigned)rk0 << 10) | ((unsigned)rk1 << 20);
                        winfo[2 * lr] = gp * w0; winfo[2 * lr + 1] = gp * w1; sinfo[lr] = am * (1.0f / 127.0f); }
                }
                LDS_WAIT(); asm volatile("" ::: "memory");
            }
        }
        __syncthreads();
        if (F.tid < 32) lbase[F.tid] = (int)__hip_atomic_fetch_add((unsigned*)(ctl + CW_CNT) + F.tid, (unsigned)lcnt[F.tid], __ATOMIC_RELAXED, __HIP_MEMORY_SCOPE_AGENT);
        __syncthreads();
        if (F.tid < 256) { const unsigned w = info[F.tid]; const int e0 = w & 31, e1 = (w >> 5) & 31, rk0 = (w >> 10) & 1023, rk1 = (w >> 20) & 1023; const int t = ch * 256 + F.tid;
            const int p0 = lbase[e0] + rk0, p1 = lbase[e1] + rk1;
            const unsigned sb_ = __float_as_uint(sinfo[F.tid]);
            LIST[(size_t)e0 * 65536 + p0] = (u32x2){(unsigned)t, sb_}; LIST[(size_t)e1 * 65536 + p1] = (u32x2){(unsigned)t, sb_};
            TOKINFO[t] = (u32x4){((unsigned)e0 << 16) | (unsigned)p0, ((unsigned)e1 << 16) | (unsigned)p1, __float_as_uint(winfo[2 * F.tid]), __float_as_uint(winfo[2 * F.tid + 1])}; }
        __syncthreads();
    }
}

__device__ __forceinline__ void p10_final(const Frame& F, const Args& a) {
    unsigned char* ws = a.ws; const float* MODF = (const float*)(ws + WS_MODF); const float* g = a.in[26];
    const bf16_t* Y2 = (const bf16_t*)(ws + WS_GATE); const bf16_t* H = (const bf16_t*)(ws + WS_YT2); float* out = a.out; const u32x4* TOKINFO = (const u32x4*)(ws + WS_ROUTEW);
    LAS int* tst = (LAS int*)(F.lds + MISC_OFF + 256);
    { gu32* ctl = (gu32*)(ws + WS_CTL); LAS int* cntl = (LAS int*)(F.lds + MISC_OFF + 64);
      if (F.tid < 32) cntl[F.tid] = (int)__hip_atomic_load((unsigned*)(ctl + CW_CNT) + F.tid, __ATOMIC_RELAXED, __HIP_MEMORY_SCOPE_AGENT);
      __syncthreads();
      if (F.tid == 0) { int sacc = 0; for (int e = 0; e < 32; ++e) { tst[e] = sacc; sacc += (cntl[e] + 255) >> 8; } tst[32] = sacc; }
      __syncthreads(); }
    const int gw = F.vcu * NWAVES + F.wave, NGW = F.G * NWAVES;
    for (int ch = gw; ch < T / 32; ch += NGW) {
        const int b = (ch * 32) >> 13;
        f32x4 Gv[4], Sv[4], Tv[4];
#pragma unroll
        for (int j = 0; j < 4; ++j) { const int k = 4 * F.lane + 256 * j; Gv[j] = *(const f32x4*)(g + k) * (*(const f32x4*)(MODF + b * 8192 + 6144 + 1024 + k) + 1.0f); Sv[j] = *(const f32x4*)(MODF + b * 8192 + 6144 + k); Tv[j] = *(const f32x4*)(MODF + b * 8192 + 5120 + k); }
        unsigned my_r0, my_r1, my_w0, my_w1;
        { const u32x4 ti = TOKINFO[(size_t)ch * 32 + (F.lane & 31)];
          my_r0 = (unsigned)tst[ti.x >> 16] * 256u + (ti.x & 0xffffu); my_r1 = (unsigned)tst[ti.y >> 16] * 256u + (ti.y & 0xffffu); my_w0 = ti.z; my_w1 = ti.w; }
#pragma unroll 4
        for (int rr = 0; rr < 32; ++rr) { const size_t row = (size_t)ch * 32 + rr; f32x4* hr = (f32x4*)(out + row * 1024) + F.lane; const u32x2* hb = (const u32x2*)(H + row * 1024) + F.lane;
            const size_t r0 = (size_t)__builtin_amdgcn_readlane(my_r0, rr), r1 = (size_t)__builtin_amdgcn_readlane(my_r1, rr);
            const float w0 = __uint_as_float(__builtin_amdgcn_readlane(my_w0, rr)), w1 = __uint_as_float(__builtin_amdgcn_readlane(my_w1, rr));
            const u32x2* y0 = (const u32x2*)(Y2 + r0 * 1024) + F.lane; const u32x2* y1 = (const u32x2*)(Y2 + r1 * 1024) + F.lane;
            f32x4 v[4]; float s = 0.f;
#pragma unroll
            for (int j = 0; j < 4; ++j) { const u32x2 p = y0[64 * j], q = y1[64 * j], hw = hb[64 * j]; v[j] = (f32x4){bf_lo(hw.x), bf_hi(hw.x), bf_lo(hw.y), bf_hi(hw.y)};
                v[j][0] += Tv[j][0] * (w0 * bf_lo(p.x) + w1 * bf_lo(q.x)); v[j][1] += Tv[j][1] * (w0 * bf_hi(p.x) + w1 * bf_hi(q.x)); v[j][2] += Tv[j][2] * (w0 * bf_lo(p.y) + w1 * bf_lo(q.y)); v[j][3] += Tv[j][3] * (w0 * bf_hi(p.y) + w1 * bf_hi(q.y));
                s += (v[j][0] * v[j][0] + v[j][1] * v[j][1]) + (v[j][2] * v[j][2] + v[j][3] * v[j][3]); }
            const float rs = __builtin_amdgcn_rsqf(wave_sum(s) * (1.0f / 1024.0f) + EPS);
#pragma unroll
            for (int j = 0; j < 4; ++j) hr[64 * j] = v[j] * rs * Gv[j] + Sv[j]; }
    }
}

constexpr int N_PHASES = 11;
constexpr int MISC_BAR = MISC_OFF + 32, MISC_CNT = MISC_OFF + 64, MISC_TST = MISC_OFF + 256;

__global__ void __launch_bounds__(NWAVES * 64, 2) fwd(Args args) {
    extern __shared__ __attribute__((aligned(16))) unsigned char lds[];
    Frame F;
    F.lds = (LAS unsigned char*)lds;
    F.tid = threadIdx.x; F.lane = F.tid & 63; F.wave = __builtin_amdgcn_readfirstlane(F.tid >> 6);
    F.G = gridDim.x; { const int bx = blockIdx.x; F.vcu = (F.G % 8 == 0) ? (bx % 8) * (F.G / 8) + bx / 8 : bx; }
    unsigned char* ws = args.ws;
    gu32* ctl = (gu32*)(ws + WS_CTL);
    for (int u = F.tid; u < 1024 / 4; u += NWAVES * 64) ((LAS unsigned*)(F.lds + MISC_OFF))[u] = 0u;
    __syncthreads();
#if MK_PER_PHASE
#define GRID_BAR() do { } while (0)
#else
    XcdBarrier bar = xcd_barrier_post((unsigned*)(ctl + CW_BAR), (volatile LAS unsigned*)(F.lds + MISC_BAR));
#define GRID_BAR() xcd_barrier(bar)
#endif
#ifdef DBG_SYSFENCE
    __builtin_amdgcn_fence(__ATOMIC_ACQUIRE, ""); asm volatile("s_waitcnt vmcnt(0)" ::: "memory"); __syncthreads();
#endif
    const int lo = args.ph_lo, hi = args.ph_hi;
#ifndef PH_MASK
#define PH_MASK 0x7ff
#endif
#define IN(k) ((((PH_MASK) >> (k)) & 1) && lo <= (k) && (k) < hi)
#define BOTH(k) (IN(k) && IN((k) + 1))
    LAS unsigned char* ring = F.lds + RING_OFF;
#define REFRESH_F() do { int t_ = threadIdx.x; asm volatile("" : "+v"(t_)); F.tid = t_; F.lane = t_ & 63; } while (0)
    const int bx = (int)blockIdx.x;

    if (IN(0)) { REFRESH_F(); p0_prologue(F, args); if (BOTH(0)) GRID_BAR(); }
    if (IN(1)) { REFRESH_F(); p1_norm(F, args); if (BOTH(1)) GRID_BAR(); }
    if (IN(2)) {
#ifdef WG_STAGGER
        if (bx & 1) { for (int q = 0; q < WG_STAGGER; ++q) __builtin_amdgcn_s_sleep(127); }
#endif
#ifndef NO_G1M
        { pg8::PlainOrder8 S{(const char*)(ws + WS_R1), (const char*)(ws + WS_W8IN), 1024, T / 256, NWIN / 256, F.G, bx};
          EpiZ8 E{ws, args.in[14]};
          pg8::gemm_phase(ring, 1024, S, E); }
#endif
#ifdef PROBE_KLOOP
        { pg8::PlainOrder S{(const char*)(ws + WS_R1), (const char*)(ws + WS_WIN), 1024, T / 256, NWIN / 256, F.G, bx};
          EpiNull E{(float*)(ws + WS_SSQQ), args.ph_lo};
          pg8::gemm_phase(ring, 1024, S, E); }
#endif
#ifndef NO_G1F
        { F1Order8 S{(const char*)(ws + WS_W8FY), (const char*)(ws + WS_R1), F.G, bx};
          EpiF18 E{ws};
          pg8::gemm_phase(ring, 1024, S, E); }
#endif
        if (BOTH(2)) GRID_BAR();
    }
    if (IN(3)) {
#ifndef NO_P3A
        { pg8::PlainOrder S{(const char*)(ws + WS_QL), (const char*)(ws + WS_WUQ), 256, T / 256, 3, F.G, bx};
          EpiQ E{(bf16_t*)(ws + WS_Q), (const float*)(ws + WS_SSQQ), (const float*)(ws + WS_ROPEC), (const float*)(ws + WS_ROPES)};
          pg8::gemm_phase(ring, 256, S, E); }
#endif
#ifndef NO_P3B
        { pg8::PlainOrder S{(const char*)(ws + WS_KVL), (const char*)(ws + WS_WUKV), 256, T / 256, 4, F.G, bx};
          EpiKV E{(bf16_t*)(ws + WS_K), (bf16_t*)(ws + WS_V), (const float*)(ws + WS_SSQKV)};
          pg8::gemm_phase(ring, 256, S, E); }
#endif
#ifndef NO_P3C
        { pg8::PlainOrder S{(const char*)(ws + WS_DFTA), (const char*)(ws + WS_YT2), 256, 1, 1024, F.G, bx};
          EpiFA E{(bf16_t*)(ws + WS_R1)};
          pg8::gemm_phase(ring, 256, S, E); }
#endif
        if (BOTH(3)) GRID_BAR();
    }
    if (IN(4)) {
        { FBOrder S{(const char*)(ws + WS_TB2), (const char*)(ws + WS_R1), F.G, bx};
          EpiFB E{(bf16_t*)(ws + WS_YT2)};
          pg8::gemm_phase(ring, 256, S, E); }
        __syncthreads();
        { const bf16_t* Q = (const bf16_t*)(ws + WS_Q); const bf16_t* KB = (const bf16_t*)(ws + WS_K); const bf16_t* VB = (const bf16_t*)(ws + WS_V); bf16_t* O = (bf16_t*)(ws + WS_QL);
#define ATT_LOOP \
          for (int i = 0;; ++i) { const int unit = i * F.G + F.vcu; if (unit >= 1024) break; const int bh = unit >> 4, qb = unit & 15, b = bh >> 3, h = bh & 7; \
              att::attn_unit(Q + ((size_t)b * 8192 + qb * 512) * QC + h * 96, KB + (size_t)bh * 8192 * 96, VB + (size_t)bh * 8192 * 64, O + ((size_t)b * 8192 + qb * 512) * 512 + h * 64, ring); }
          ATT_LOOP
        }
        if (BOTH(4)) GRID_BAR();
    }
    if (IN(5)) {
        { MergeOrder S{(const char*)(ws + WS_QL), (const char*)(ws + WS_YT2), (const char*)(ws + WS_WBA), F.G, bx};
          EpiMerge2 E{(bf16_t*)(ws + WS_R1), (const unsigned char*)(ws + WS_GATE)};
          pg8::gemm_phase(ring, 1024, S, E); }
        if (BOTH(5)) GRID_BAR();
    }
    if (IN(6)) {
        { pg8::PlainOrder S{(const char*)(ws + WS_R1), (const char*)(ws + WS_WOUT), 1024, T / 256, 4, F.G, bx};
          EpiH E{args.in[0], (bf16_t*)(ws + WS_YT2), (const float*)(ws + WS_MODF)};
          pg8::gemm_phase(ring, 1024, S, E); }
        if (BOTH(6)) GRID_BAR();
    }
    if (IN(7)) { REFRESH_F(); p7_route(F, args); if (BOTH(7)) GRID_BAR(); }
    if (IN(8) || IN(9)) {
        REFRESH_F();
        LAS int* tst = (LAS int*)(F.lds + MISC_TST); LAS int* cntl = (LAS int*)(F.lds + MISC_CNT);
        if (F.tid < 32) cntl[F.tid] = (int)__hip_atomic_load((unsigned*)(ctl + CW_CNT) + F.tid, __ATOMIC_RELAXED, __HIP_MEMORY_SCOPE_AGENT);
        __syncthreads();
        if (F.tid == 0) { int s = 0; for (int e = 0; e < 32; ++e) { tst[e] = s; s += (cntl[e] + 255) >> 8; } tst[32] = s; }
        __syncthreads();
        { LAS unsigned char* texp = (LAS unsigned char*)(tst + 40); const int e = F.tid >> 4; if (F.tid < 512) for (int tl = tst[e] + (F.tid & 15); tl < tst[e + 1]; tl += 16) texp[tl] = (unsigned char)e; }
        __syncthreads();
        if (IN(8)) {
            MoeUpOrder8 S{(const char*)(ws + WS_R1), (const char*)(ws + WS_W8GU), (const u32x2*)(ws + WS_LIST), tst, cntl, F.G, bx};
            EpiUp8 E{ws};
            pg8::gemm_phase(ring, 1024, S, E);
            if (BOTH(8)) GRID_BAR();
        }
        if (IN(9)) {
            MoeDownOrder S{(const char*)(ws + WS_Q), (const char*)(ws + WS_WDN), tst, cntl, F.G, bx};
            EpiDown E{(bf16_t*)(ws + WS_GATE)};
            pg8::gemm_phase(ring, 256, S, E);
            if (BOTH(9)) GRID_BAR();
        }
    }
    if (IN(10)) { REFRESH_F(); p10_final(F, args); }
#ifdef DBG_SYSFENCE
    asm volatile("s_waitcnt vmcnt(0)" ::: "memory"); __syncthreads(); __builtin_amdgcn_fence(__ATOMIC_RELEASE, ""); asm volatile("s_waitcnt vmcnt(0)" ::: "memory");
#endif
#undef IN
#undef BOTH
}

extern "C" void kernel_launch(void* const* d_in, const int* in_sizes, int n_in, void* d_out, int out_size, void* d_ws, size_t ws_size, hipStream_t stream) {
    static int grid = 0;
    if (grid == 0) {
        if (n_in != 27 || in_sizes[0] != T * D || out_size != T * D || ws_size < WS_END) { fprintf(stderr, "kernel_launch: shape/workspace mismatch: n_in %d in0 %d out %d ws %zu (need %zu)\n", n_in, n_in > 0 ? in_sizes[0] : -1, out_size, ws_size, (size_t)WS_END); grid = -1; return; }
        int dev = 0, cus = 0;
        if (hipGetDevice(&dev) != hipSuccess || hipDeviceGetAttribute(&cus, hipDeviceAttributeMultiprocessorCount, dev) != hipSuccess) { fprintf(stderr, "kernel_launch: device query failed\n"); grid = -1; return; }
        if (hipFuncSetAttribute((const void*)fwd, hipFuncAttributeMaxDynamicSharedMemorySize, LDS_BYTES) != hipSuccess) { fprintf(stderr, "kernel_launch: hipFuncSetAttribute failed\n"); grid = -1; return; }
        int per_cu = 0;
        if (hipOccupancyMaxActiveBlocksPerMultiprocessor(&per_cu, (const void*)fwd, NWAVES * 64, LDS_BYTES) != hipSuccess || per_cu < 1) fprintf(stderr, "kernel_launch: note: occupancy query reports %d workgroups per CU\n", per_cu);
        (void)hipGetLastError();
        grid = cus;
    }
    if (grid < 0) return;
    if (hipMemsetAsync((char*)d_ws + WS_CTL, 0, CTL_ZERO_BYTES, stream) != hipSuccess) { fprintf(stderr, "kernel_launch: memset failed\n"); return; }
    Args a{};
    for (int i = 0; i < 27; ++i) a.in[i] = (const float*)d_in[i];
    a.out = (float*)d_out; a.ws = (unsigned char*)d_ws;
#if MK_PER_PHASE
    for (int p = 0; p < N_PHASES; ++p) { a.ph_lo = p; a.ph_hi = p + 1; a.li = p;
        hipLaunchKernelGGL(fwd, dim3(grid), dim3(NWAVES * 64), LDS_BYTES, stream, a);
        const hipError_t le = hipPeekAtLastError(); if (le != hipSuccess) { fprintf(stderr, "kernel_launch: launch %d failed: %s\n", p, hipGetErrorName(le)); break; } }
#else
#ifdef PROBE_MASK
    { bool first = true;
      for (int k = 0; k < N_PHASES; ++k) for (int rep = 0; rep < (((PROBE_MASK) >> k) & 1 ? 2 : 1); ++rep) { a.ph_lo = k; a.ph_hi = k + 1; a.li = 0;
        if (!first) (void)hipMemsetAsync((char*)d_ws + WS_CTL + CW_BAR * 4, 0, XCD_BAR_WORDS * 4, stream);
        first = false;
        hipLaunchKernelGGL(fwd, dim3(grid), dim3(NWAVES * 64), LDS_BYTES, stream, a); } }
#else
    a.ph_lo = 0; a.ph_hi = N_PHASES; a.li = 0;
    hipLaunchKernelGGL(fwd, dim3(grid), dim3(NWAVES * 64), LDS_BYTES, stream, a);
    { const hipError_t le = hipPeekAtLastError(); if (le != hipSuccess) fprintf(stderr, "kernel_launch: launch failed: %s\n", hipGetErrorName(le)); }
#endif
#endif
}
```
